# Optimizing an MI355X kernel written in HIP

```python
import jax, jax.numpy as jnp
from jax import lax
import numpy as np


D_MODEL = 2048
BATCH = 8
SEQ = 2048
DEPTH = 2

GRID_W = 64
CTX_LEN = 256

HD = 64
H_A = 8
D_A = H_A * HD
H_B = 12
HKV_B = 4
D_B = H_B * HD
KV_B = HKV_B * HD
H_C = 6
NOPE_C = 128
ROPE_DIM = 64
QK_C = NOPE_C + ROPE_DIM
V_C = 128
D_C = H_C * V_C
Q_LORA = 768
KV_LORA = 512
D_MIX = D_A + D_B + D_C
N_IN = 3 * D_A + D_B + 2 * KV_B + Q_LORA + KV_LORA + ROPE_DIM + D_MIX

NA_ROWS = 8
NA_COLS = 16
SW_WINDOW = 128
SW_BLOCK = 128
Q_BLOCK = 128

ROPE_BASE = 10000.0
ADA_SCALE = 0.5
EPS = 1e-6
NEG_INF = -1e30

kernel_name = "hymba_grid_hybrid_dit_block"


def rms(x, w):
    xf = x.astype(jnp.float32)
    y = xf * lax.rsqrt(jnp.mean(xf * xf, axis=-1, keepdims=True) + EPS)
    return (y * w.astype(jnp.float32)).astype(x.dtype)


def axial_rope(L, dim, dtype):
    t = jnp.arange(L)
    row = (t // GRID_W).astype(jnp.float32)
    col = (t % GRID_W).astype(jnp.float32)
    n_freq = dim // 4
    inv = ROPE_BASE ** (-jnp.arange(n_freq, dtype=jnp.float32) / n_freq)
    ar = row[:, None] * inv
    ac = col[:, None] * inv
    ang = jnp.concatenate([ar, ar, ac, ac], axis=-1)
    return jnp.cos(ang).astype(dtype), jnp.sin(ang).astype(dtype)


def apply_rope2d(x, cos, sin):
    x1, x2, x3, x4 = jnp.split(x, 4, axis=-1)
    rot = jnp.concatenate([-x2, x1, -x4, x3], axis=-1)
    return x * cos[None, :, None, :] + rot * sin[None, :, None, :]


def split_points():
    sizes = (D_A, D_A, D_A, D_B, KV_B, KV_B, Q_LORA, KV_LORA, ROPE_DIM, D_MIX)
    return [int(p) for p in np.cumsum(sizes)[:-1]]


def project_stream(h, w_in, qn_a, kn_a, qn_b, kn_b, qa_norm, kva_norm, w_qb, w_kvb, qn_c, kn_c, rope):
    B, L, _ = h.shape
    u = h @ w_in
    qa, ka, va, qb, kb, vb, cq, ckv, kpe, z = jnp.split(u, split_points(), axis=-1)

    def heads(t, n):
        return t.reshape(B, L, n, -1)

    qa = rms(heads(qa, H_A), qn_a)
    ka = rms(heads(ka, H_A), kn_a)
    va = heads(va, H_A)
    qb = rms(heads(qb, H_B), qn_b)
    kb = rms(heads(kb, HKV_B), kn_b)
    vb = heads(vb, HKV_B)
    qc = rms(heads(rms(cq, qa_norm) @ w_qb, H_C), qn_c)
    kvc = heads(rms(ckv, kva_norm) @ w_kvb, H_C)
    kc = jnp.concatenate(
        [kvc[..., :NOPE_C], jnp.broadcast_to(kpe[:, :, None, :], (B, L, H_C, ROPE_DIM))], axis=-1)
    kc = rms(kc, kn_c)
    vc = kvc[..., NOPE_C:]
    if rope is not None:
        cos, sin = rope
        qb = apply_rope2d(qb, cos, sin)
        kb = apply_rope2d(kb, cos, sin)
        qc = jnp.concatenate([qc[..., :NOPE_C], apply_rope2d(qc[..., NOPE_C:], cos, sin)], axis=-1)
        kc = jnp.concatenate([kc[..., :NOPE_C], apply_rope2d(kc[..., NOPE_C:], cos, sin)], axis=-1)
    return (qa, ka, va, qb, kb, vb, qc, kc, vc, z)


def natten_latent(q, k, v, kc, vc, rpb):
    B, L, H, D = q.shape
    rows = L // GRID_W
    wr = min(NA_ROWS, rows)
    ncb = GRID_W // NA_COLS
    span = 2 * NA_COLS
    cb = np.arange(ncb)
    kcol = np.clip(cb * NA_COLS - NA_COLS // 2, 0, GRID_W - span)[:, None] + np.arange(span)
    qcol = cb[:, None] * NA_COLS + np.arange(NA_COLS)
    qstart = np.clip(qcol - NA_COLS // 2, 0, GRID_W - NA_COLS)
    col_ok = (kcol[:, None, :] >= qstart[:, :, None]) & (kcol[:, None, :] < qstart[:, :, None] + NA_COLS)
    dc_idx = (np.clip(kcol[:, None, :] - qcol[:, :, None], -(NA_COLS - 1), NA_COLS - 1)
              + NA_COLS - 1).astype(np.int32)
    qg = q.reshape(B, rows, ncb, NA_COLS, H, D)
    kg = k.reshape(B, rows, GRID_W, H, D)[:, :, kcol]
    vg = v.reshape(B, rows, GRID_W, H, D)[:, :, kcol]
    scale = D ** -0.5
    n_loc = wr * span

    def row_fn(r):
        rs = jnp.clip(r - wr // 2, 0, rows - wr)
        qr = lax.dynamic_index_in_dim(qg, r, axis=1, keepdims=False)
        kr = lax.dynamic_slice_in_dim(kg, rs, wr, axis=1)
        vr = lax.dynamic_slice_in_dim(vg, rs, wr, axis=1)
        dr_idx = rs + jnp.arange(wr) - r + NA_ROWS - 1
        bias = rpb[:, dr_idx[None, None, :, None], dc_idx[:, :, None, :]]
        s_loc = jnp.einsum('bnqhd,brnkhd->bhnqrk', qr, kr,
                           preferred_element_type=jnp.float32) * scale + bias
        s_loc = jnp.where(col_ok[:, :, None, :], s_loc, NEG_INF)
        s_ctx = jnp.einsum('bnqhd,bchd->bhnqc', qr, kc, preferred_element_type=jnp.float32) * scale
        s = jnp.concatenate([s_loc.reshape(B, H, ncb, NA_COLS, n_loc), s_ctx], axis=-1)
        p = jax.nn.softmax(s, axis=-1).astype(v.dtype)
        p_loc = p[..., :n_loc].reshape(B, H, ncb, NA_COLS, wr, span)
        o = (jnp.einsum('bhnqrk,brnkhd->bnqhd', p_loc, vr)
             + jnp.einsum('bhnqc,bchd->bnqhd', p[..., n_loc:], vc))
        return o.reshape(B, GRID_W, H, D)

    o = lax.map(row_fn, jnp.arange(rows))
    return o.transpose(1, 0, 2, 3, 4).reshape(B, L, H, D)


def swa_latent(q, k, v, kc, vc, sink):
    B, L, H, D = q.shape
    Hkv = k.shape[2]
    G = H // Hkv
    Lc = kc.shape[1]
    nb = L // SW_BLOCK
    span = SW_BLOCK + 2 * SW_WINDOW
    pad = ((0, 0), (SW_WINDOW, SW_WINDOW), (0, 0), (0, 0))
    kp = jnp.pad(k, pad)
    vp = jnp.pad(v, pad)
    qb = q.reshape(B, nb, SW_BLOCK, Hkv, G, D).transpose(1, 0, 2, 3, 4, 5)
    snk = sink.reshape(Hkv, G).astype(jnp.float32)[None, :, :, None, None]
    scale = D ** -0.5

    def blk(args):
        i, qi = args
        k0 = i * SW_BLOCK
        ki = lax.dynamic_slice_in_dim(kp, k0, span, axis=1)
        vi = lax.dynamic_slice_in_dim(vp, k0, span, axis=1)
        qpos = k0 + jnp.arange(SW_BLOCK)
        kpos = k0 - SW_WINDOW + jnp.arange(span)
        ok = (kpos >= 0) & (kpos < L) & (jnp.abs(qpos[:, None] - kpos[None, :]) <= SW_WINDOW)
        s_loc = jnp.einsum('bqkgd,bjkd->bkgqj', qi, ki, preferred_element_type=jnp.float32) * scale
        s_loc = jnp.where(ok, s_loc, NEG_INF)
        s_ctx = jnp.einsum('bqkgd,bckd->bkgqc', qi, kc, preferred_element_type=jnp.float32) * scale
        s = jnp.concatenate([s_loc, s_ctx, jnp.broadcast_to(snk, s_loc.shape[:-1] + (1,))], axis=-1)
        p = jax.nn.softmax(s, axis=-1).astype(v.dtype)
        o = (jnp.einsum('bkgqj,bjkd->bqkgd', p[..., :span], vi)
             + jnp.einsum('bkgqc,bckd->bqkgd', p[..., span:span + Lc], vc))
        return o.reshape(B, SW_BLOCK, H, D)

    o = lax.map(blk, (jnp.arange(nb), qb))
    return o.transpose(1, 0, 2, 3, 4).reshape(B, L, H, D)


def mla_latent(q, k, v, kc, vc):
    B, L, H, D = q.shape
    Dv = v.shape[-1]
    nb = L // Q_BLOCK
    k_all = jnp.concatenate([kc, k], axis=1)
    v_all = jnp.concatenate([vc, v], axis=1)
    qb = q.reshape(B, nb, Q_BLOCK, H, D).transpose(1, 0, 2, 3, 4)
    scale = D ** -0.5

    def blk(qi):
        s = jnp.einsum('bqhd,bkhd->bhqk', qi, k_all, preferred_element_type=jnp.float32) * scale
        p = jax.nn.softmax(s, axis=-1).astype(v.dtype)
        return jnp.einsum('bhqk,bkhd->bqhd', p, v_all)

    o = lax.map(blk, qb)
    return o.transpose(1, 0, 2, 3, 4).reshape(B, L, H, Dv)


def ctx_attn(q, k, v, sink=None):
    B, Lc, H, D = q.shape
    Hkv = k.shape[2]
    G = H // Hkv
    qg = q.reshape(B, Lc, Hkv, G, D)
    s = jnp.einsum('bqkgd,bckd->bkgqc', qg, k, preferred_element_type=jnp.float32) * (D ** -0.5)
    if sink is not None:
        snk = sink.reshape(Hkv, G).astype(jnp.float32)[None, :, :, None, None]
        s = jnp.concatenate([s, jnp.broadcast_to(snk, s.shape[:-1] + (1,))], axis=-1)
    p = jax.nn.softmax(s, axis=-1)[..., :Lc].astype(v.dtype)
    return jnp.einsum('bkgqc,bckd->bqkgd', p, v).reshape(B, Lc, H, v.shape[-1])


def merge_out(o_a, o_b, o_c, z, w_out):
    B, L = o_a.shape[:2]
    y = jnp.concatenate([o_a.reshape(B, L, -1), o_b.reshape(B, L, -1), o_c.reshape(B, L, -1)], axis=-1)
    return (y * jax.nn.silu(z)) @ w_out


def setup_inputs(seed: int = 0) -> dict:
    key = jax.random.key(seed)
    ks = jax.random.split(key, 21)
    f32 = jnp.float32

    def nrm(k, shape, s):
        return jax.random.normal(k, shape, f32) * s

    def gain(k, shape):
        return 1.0 + 0.02 * jax.random.normal(k, shape, f32)

    return {
        "x": nrm(ks[0], (BATCH, SEQ, D_MODEL), 1.0),
        "c": nrm(ks[1], (BATCH, D_MODEL), 1.0),
        "ctx": nrm(ks[2], (BATCH, CTX_LEN, D_MODEL), 1.0),
        "c_ctx": nrm(ks[3], (D_MODEL,), 1.0),
        "norm_w": gain(ks[4], (DEPTH, D_MODEL)),
        "w_ada": nrm(ks[5], (DEPTH, D_MODEL, 3 * D_MODEL), ADA_SCALE * D_MODEL ** -0.5),
        "b_ada": nrm(ks[6], (DEPTH, 3 * D_MODEL), 0.01),
        "w_in": nrm(ks[7], (DEPTH, D_MODEL, N_IN), D_MODEL ** -0.5),
        "qn_a": gain(ks[8], (DEPTH, HD)),
        "kn_a": gain(ks[9], (DEPTH, HD)),
        "rpb_a": nrm(ks[10], (DEPTH, H_A, 2 * NA_ROWS - 1, 2 * NA_COLS - 1), 0.1),
        "qn_b": gain(ks[11], (DEPTH, HD)),
        "kn_b": gain(ks[12], (DEPTH, HD)),
        "sink_b": nrm(ks[13], (DEPTH, H_B), 0.5),
        "qa_norm": gain(ks[14], (DEPTH, Q_LORA)),
        "kva_norm": gain(ks[15], (DEPTH, KV_LORA)),
        "w_qb": nrm(ks[16], (DEPTH, Q_LORA, H_C * QK_C), Q_LORA ** -0.5),
        "w_kvb": nrm(ks[17], (DEPTH, KV_LORA, H_C * (NOPE_C + V_C)), KV_LORA ** -0.5),
        "qn_c": gain(ks[18], (DEPTH, QK_C)),
        "kn_c": gain(ks[19], (DEPTH, QK_C)),
        "w_out": nrm(ks[20], (DEPTH, D_MIX, D_MODEL), D_MIX ** -0.5),
    }


def reference(x, c, ctx, c_ctx, norm_w, w_ada, b_ada, w_in, qn_a, kn_a, rpb_a, qn_b, kn_b, sink_b,
              qa_norm, kva_norm, w_qb, w_kvb, qn_c, kn_c, w_out):
    B, L, _ = x.shape
    cos, sin = axial_rope(L, ROPE_DIM, x.dtype)
    sc = jax.nn.silu(c)
    scc = jax.nn.silu(c_ctx)
    xc = ctx
    for l in range(DEPTH):
        last = l == DEPTH - 1
        shift, scale, gate = jnp.split(sc @ w_ada[l] + b_ada[l], 3, axis=-1)
        shift_c, scale_c, gate_c = jnp.split(scc @ w_ada[l] + b_ada[l], 3, axis=-1)
        h = rms(x, norm_w[l]) * (1.0 + scale[:, None]) + shift[:, None]
        hc = rms(xc, norm_w[l]) * (1.0 + scale_c) + shift_c
        weights = (w_in[l], qn_a[l], kn_a[l], qn_b[l], kn_b[l], qa_norm[l], kva_norm[l],
                   w_qb[l], w_kvb[l], qn_c[l], kn_c[l])
        qa, ka, va, qb, kb, vb, qc, kc, vc, z = project_stream(h, *weights, rope=(cos, sin))
        qa_c, ka_c, va_c, qb_c, kb_c, vb_c, qc_c, kc_c, vc_c, z_c = project_stream(hc, *weights, rope=None)
        o_a = natten_latent(qa, ka, va, ka_c, va_c, rpb_a[l])
        o_b = swa_latent(qb, kb, vb, kb_c, vb_c, sink_b[l])
        o_c = mla_latent(qc, kc, vc, kc_c, vc_c)
        x = x + gate[:, None] * merge_out(o_a, o_b, o_c, z, w_out[l])
        if not last:
            oa_c = ctx_attn(qa_c, ka_c, va_c)
            ob_c = ctx_attn(qb_c, kb_c, vb_c, sink_b[l])
            oc_c = ctx_attn(qc_c, kc_c, vc_c)
            xc = xc + gate_c * merge_out(oa_c, ob_c, oc_c, z_c, w_out[l])
    return x
```

```cpp
#include <hip/hip_runtime.h>
#include <hip/hip_bf16.h>
#include <cstdio>
#include <cstdint>

#ifndef MK_N_LAUNCHES
#define MK_N_LAUNCHES 1
#endif

constexpr int BATCH = 8, SEQ = 2048, DM = 2048, LC = 256, DEPTH = 2;
constexpr int NLAT = BATCH * SEQ;
constexpr int NCTX = BATCH * LC;
constexpr int MTOT = NLAT + NCTX;
constexpr int N_IN = 6208, NT_IN = 25;
constexpr int HA = 8, HB = 12, HKVB = 4, HC = 6;
constexpr int QLORA = 768, KVLORA = 512;
constexpr float EPS = 1e-6f;
constexpr float LOG2E = 1.4426950408889634f;
constexpr float C2_64 = 0.125f * LOG2E;
constexpr float C2_192 = 0.07216878364870323f * LOG2E;

constexpr size_t al256(size_t x) { return (x + 255) / 256 * 256; }
constexpr size_t WS_CTL = 0, CTL_ZERO_BYTES = 1u << 20;
constexpr size_t CTL_SSQ_OFF = 65536;
constexpr size_t WS_MOD = CTL_ZERO_BYTES;
constexpr size_t WS_ROPE = WS_MOD + al256((size_t)2 * 9 * 6144 * 4);
constexpr size_t WS_WIN = WS_ROPE + (size_t)2048 * 64 * 4;
constexpr size_t WS_WOUT = WS_WIN + (size_t)2 * 6400 * 2048 * 2;
constexpr size_t WS_WQB = WS_WOUT + (size_t)2 * 2048 * 2048 * 2;
constexpr size_t WS_WKVB = WS_WQB + (size_t)2 * 1536 * 768 * 2;
constexpr size_t WS_XN = WS_WKVB + (size_t)2 * 1536 * 512 * 2;
constexpr size_t WS_QA = WS_XN + (size_t)MTOT * 2048 * 2;
constexpr size_t WS_KA = WS_QA + (size_t)MTOT * 512 * 2;
constexpr size_t WS_VA = WS_KA + (size_t)MTOT * 512 * 2;
constexpr size_t WS_QB = WS_VA + (size_t)MTOT * 512 * 2;
constexpr size_t WS_KB = WS_QB + (size_t)MTOT * 768 * 2;
constexpr size_t WS_VB = WS_KB + (size_t)MTOT * 256 * 2;
constexpr size_t WS_CQ = WS_VB + (size_t)MTOT * 256 * 2;
constexpr size_t WS_CKV = WS_CQ + (size_t)MTOT * 768 * 2;
constexpr size_t WS_KPE = WS_CKV + (size_t)MTOT * 512 * 2;
constexpr size_t WS_SSQK = WS_KPE + (size_t)MTOT * 64 * 4;
constexpr size_t WS_ZS = WS_SSQK + al256((size_t)MTOT * 4);
constexpr size_t WS_QC = WS_ZS + (size_t)MTOT * 2048 * 2;
constexpr size_t WS_KC = WS_QC + (size_t)MTOT * 1152 * 2;
constexpr size_t WS_VC = WS_KC + (size_t)MTOT * 1152 * 2;
constexpr size_t WS_XC1 = WS_VC + (size_t)MTOT * 768 * 2;
constexpr size_t WS_END = WS_XC1 + (size_t)NCTX * 2048 * 4;
constexpr int CW_TMO = 0, CW_QUEUE = 64  , CW_BAR = 4096;

constexpr int RING_BYTES = 131072;
constexpr int LDSCTL_OFF = RING_BYTES;
constexpr int XCH_OFF = RING_BYTES + 512;
constexpr int LDS_BYTES = 147456;

#define GAS __attribute__((address_space(1)))
#define LAS __attribute__((address_space(3)))
typedef unsigned short bf16_t;
typedef short bf16x8 __attribute__((ext_vector_type(8)));
typedef short s16x4 __attribute__((ext_vector_type(4)));
typedef float f32x4 __attribute__((ext_vector_type(4)));
typedef float f32x16 __attribute__((ext_vector_type(16)));
typedef unsigned u32x4 __attribute__((ext_vector_type(4)));
typedef unsigned u32x2 __attribute__((ext_vector_type(2)));

__device__ __forceinline__ int tid_opaque() { int t = threadIdx.x; asm volatile("" : "+v"(t)); return t; }
__device__ __forceinline__ unsigned cvt_pk_bf16(float lo, float hi) { unsigned r; asm volatile("v_cvt_pk_bf16_f32 %0, %1, %2" : "=v"(r) : "v"(lo), "v"(hi)); return r; }
__device__ __forceinline__ float bf2f(unsigned short b) { return __uint_as_float(((unsigned)b) << 16); }
__device__ __forceinline__ float silu_f(float v) { return v * __builtin_amdgcn_rcpf(1.0f + __builtin_amdgcn_exp2f(-v * LOG2E)); }

namespace pg8 {
#define PG8_LAS __attribute__((address_space(3)))
constexpr int BM = 256, BK = 64, HALF = 128, HTB = HALF * BK * 2, STAGE_BYTES = 8 * HTB, NXCD = 8, WGM = 8;
__host__ __device__ __forceinline__ int lds_byte(int r, int c) { const int st = (r >> 4) * 2 + (c >> 5), rr = r & 15, cc = c & 31, ob = rr * 64 + cc * 2; return st * 1024 + (ob ^ (((ob >> 9) & 1) << 5)); }
__host__ __device__ __forceinline__ void stage_rc(int b, int& R, int& C) { const int st = b / 1024, sb = b % 1024, swz = sb ^ (((sb >> 9) & 1) << 5); R = (st >> 1) * 16 + swz / 64; C = (st & 1) * 32 + (swz % 64) / 2; }
__host__ __device__ __forceinline__ int perm32(int rho) { const int n = rho >> 4, i = rho & 15; return 8 * (i >> 2) + 4 * n + (i & 3); }
struct Unit { int pm, pn; };
struct Gemm { const bf16_t* A; const bf16_t* Bt; int M, N, K; };

__host__ __device__ __forceinline__ int ctx_pn(int j) { return j < 4 ? 2 + j : (j < 6 ? 5 + j : 8 + j); }
__host__ __device__ __forceinline__ void grid_map(int L, int nM, int nN, int& pm, int& pn) {
    const int nwg = nM * nN; int wgid = L; { const int q = nwg / NXCD, r = nwg % NXCD, xcd = wgid % NXCD, off = wgid / NXCD; wgid = (xcd < r ? xcd * (q + 1) : r * (q + 1) + (xcd - r) * q) + off; }
    const int nig = WGM * nN, gid = wgid / nig, fm = gid * WGM, gsz = (nM - fm) < WGM ? (nM - fm) : WGM;
    pm = fm + ((wgid % nig) % gsz); pn = (wgid % nig) / gsz;
}
struct Sched2 {
    int nM1, nN1, nM2, nN2, pm2, G, c;
    __device__ __forceinline__ bool next(int i, Unit& u) const {
        const int L = i * G + c, n1 = nM1 * nN1, n2 = nM2 * nN2;
        if (L < n1) { grid_map(L, nM1, nN1, u.pm, u.pn); return true; }
        if (L < n1 + n2) { int pm, pj; grid_map(L - n1, nM2, nN2, pm, pj); u.pm = pm2 + pm; u.pn = ctx_pn(pj); return true; }
        return false;
    }
    __device__ __forceinline__ void a_ready(const Unit&) const {}
    __device__ __forceinline__ void done(const Unit&) const {}
};

template <class Epi, class Sched, bool ALIGN_EPI = false, bool SP2 = false>
__device__ __forceinline__ void gemm_phase(PG8_LAS unsigned char* lds, const Gemm g, const Sched& S, const Epi& E) {
    const int tid = tid_opaque(), wid = __builtin_amdgcn_readfirstlane(tid >> 6), lane = tid & 63, wr = wid >> 2, wc = wid & 3, fr = lane & 15, fq = lane >> 4;
    const int K = g.K, nt = K / BK;
    unsigned voffA[2], voffB[2];
#pragma unroll
    for (int i = 0; i < 2; ++i) { int R, C; stage_rc(tid * 16 + i * 8192, R, C); const int Rb = Epi::PERM ? ((R & ~31) + perm32(R & 31)) : R;
        voffA[i] = (unsigned)(R * K + C) * 2u; voffB[i] = (unsigned)(Rb * K + C) * 2u; }
    const size_t kstep = (size_t)(BK * 2);
    const size_t hstep = (size_t)HALF * K * 2;
    const size_t tstep = 2 * hstep;
    const unsigned ldsw = (unsigned)wid * 1024u;
    const int aoff = lds_byte(wr * 64 + fr, fq * 8), boff = lds_byte(wc * 32 + fr, fq * 8);
#define PG8_SA(b, h) (((b) * 2 + (h)) * HTB)
#define PG8_SB(b, h) ((4 + (b) * 2 + (h)) * HTB)
#define PG8_STAGE(bufoff, gbase, voff) do { _Pragma("unroll") for (int _i = 0; _i < 2; ++_i) \
        __builtin_amdgcn_global_load_lds((const unsigned*)((const char*)(gbase) + (voff)[_i]), (PG8_LAS unsigned*)(lds + (bufoff) + ldsw + _i * 8192), 16, 0, 0); } while (0)
#define PG8_LDA(dst, b, h) do { _Pragma("unroll") for (int m = 0; m < 4; ++m) _Pragma("unroll") for (int k = 0; k < 2; ++k) dst[m][k] = *(const PG8_LAS bf16x8*)(lds + PG8_SA(b, h) + aoff + m * 2048 + k * 1024); } while (0)
#define PG8_LDB(dst, b, h) do { _Pragma("unroll") for (int n = 0; n < 2; ++n) _Pragma("unroll") for (int k = 0; k < 2; ++k) dst[n][k] = *(const PG8_LAS bf16x8*)(lds + PG8_SB(b, h) + boff + n * 2048 + k * 1024); } while (0)
#define PG8_MMA(ai, bj, At, Bt) do { __builtin_amdgcn_s_setprio(1); _Pragma("unroll") for (int m = 0; m < 4; ++m) _Pragma("unroll") for (int n = 0; n < 2; ++n) _Pragma("unroll") for (int k = 0; k < 2; ++k) \
        acc[ai][bj][m][n] = __builtin_amdgcn_mfma_f32_16x16x32_bf16(Bt[n][k], At[m][k], acc[ai][bj][m][n], 0, 0, 0); __builtin_amdgcn_s_setprio(0); } while (0)
#define PG8_WAIT_V(n) asm volatile("s_waitcnt vmcnt(" #n ")" ::: "memory")
#define PG8_WAIT_L(n) asm volatile("s_waitcnt lgkmcnt(" #n ")" ::: "memory")
#define PG8_BAR __builtin_amdgcn_s_barrier()
#define PG8_SCHED __builtin_amdgcn_sched_barrier(0)
    Unit cur, nxt; int ui = 0;
    if (!S.next(0, cur)) return;
    f32x4 acc[2][2][4][2];
#pragma unroll
    for (int a = 0; a < 2; ++a)
#pragma unroll
        for (int b = 0; b < 2; ++b)
#pragma unroll
            for (int m = 0; m < 4; ++m)
#pragma unroll
                for (int n = 0; n < 2; ++n) acc[a][b][m][n] = (f32x4){0.f, 0.f, 0.f, 0.f};
    bf16x8 At[4][2], B0[2][2], B1[2][2];
    const char* cA = (const char*)g.A + (size_t)cur.pm * tstep; const char* cB = (const char*)g.Bt + (size_t)cur.pn * tstep;
    S.a_ready(cur);
    if constexpr (SP2) {
        PG8_STAGE(PG8_SB(0, 0), cB, voffB); PG8_STAGE(PG8_SB(0, 1), cB + hstep, voffB); PG8_STAGE(PG8_SA(0, 0), cA, voffA); PG8_STAGE(PG8_SA(0, 1), cA + hstep, voffA);
        if (wr == 1) PG8_BAR;
        PG8_WAIT_V(2); PG8_BAR;
        PG8_STAGE(PG8_SB(1, 0), cB + kstep, voffB); PG8_STAGE(PG8_SA(1, 0), cA + kstep, voffA); PG8_STAGE(PG8_SB(1, 1), cB + hstep + kstep, voffB);
        PG8_WAIT_V(6); PG8_BAR;
    } else {
        PG8_STAGE(PG8_SB(0, 0), cB, voffB); PG8_STAGE(PG8_SA(0, 0), cA, voffA); PG8_STAGE(PG8_SB(0, 1), cB + hstep, voffB); PG8_STAGE(PG8_SA(0, 1), cA + hstep, voffA);
        if (wr == 1) PG8_BAR;
        PG8_WAIT_V(4); PG8_BAR;
        PG8_STAGE(PG8_SB(1, 0), cB + kstep, voffB); PG8_STAGE(PG8_SA(1, 0), cA + kstep, voffA); PG8_STAGE(PG8_SB(1, 1), cB + hstep + kstep, voffB);
        PG8_WAIT_V(6); PG8_BAR;
    }
    for (;;) {
        const bool has_next = S.next(ui + 1, nxt);
        const char* nA = has_next ? (const char*)g.A + (size_t)nxt.pm * tstep : cA; const char* nB = has_next ? (const char*)g.Bt + (size_t)nxt.pn * tstep : cB;
        for (int t = 0; t < nt; t += 2) {
            const bool last = (t == nt - 2);
            const char* a1 = cA + (size_t)(t + 1) * kstep;
            const char* a2 = last ? nA : cA + (size_t)(t + 2) * kstep; const char* b2 = last ? nB : cB + (size_t)(t + 2) * kstep;
            const char* a3 = a2 + kstep; const char* b3 = b2 + kstep;
            if (last && has_next) S.a_ready(nxt);
            if constexpr (SP2) {
            PG8_LDB(B0, 0, 0); PG8_LDB(B1, 0, 1); PG8_SCHED; PG8_LDA(At, 0, 0); PG8_STAGE(PG8_SA(1, 1), a1 + hstep, voffA);
            PG8_WAIT_V(8); PG8_WAIT_L(0); PG8_BAR; PG8_MMA(0, 0, At, B0); PG8_MMA(0, 1, At, B1); PG8_BAR; PG8_SCHED;
            PG8_LDA(At, 0, 1); PG8_STAGE(PG8_SB(0, 0), b2, voffB); PG8_STAGE(PG8_SB(0, 1), b2 + hstep, voffB); PG8_STAGE(PG8_SA(0, 0), a2, voffA);
            PG8_WAIT_V(8); PG8_WAIT_L(0); PG8_BAR; PG8_MMA(1, 0, At, B0); PG8_MMA(1, 1, At, B1); PG8_BAR; PG8_SCHED;
            PG8_LDB(B0, 1, 0); PG8_LDB(B1, 1, 1); PG8_SCHED; PG8_LDA(At, 1, 0); PG8_STAGE(PG8_SA(0, 1), a2 + hstep, voffA);
            PG8_WAIT_V(8); PG8_WAIT_L(0); PG8_BAR; PG8_MMA(0, 0, At, B0); PG8_MMA(0, 1, At, B1); PG8_BAR; PG8_SCHED;
            PG8_LDA(At, 1, 1); PG8_STAGE(PG8_SB(1, 0), b3, voffB); PG8_STAGE(PG8_SB(1, 1), b3 + hstep, voffB); PG8_STAGE(PG8_SA(1, 0), a3, voffA);
            PG8_WAIT_V(8); PG8_WAIT_L(0); PG8_BAR; PG8_MMA(1, 0, At, B0); PG8_MMA(1, 1, At, B1); PG8_BAR; PG8_SCHED;
            } else {
            PG8_LDB(B0, 0, 0); PG8_SCHED; PG8_LDA(At, 0, 0); PG8_STAGE(PG8_SA(1, 1), a1 + hstep, voffA);
            PG8_WAIT_L(8); PG8_BAR; PG8_WAIT_L(0); PG8_MMA(0, 0, At, B0); PG8_BAR; PG8_SCHED;
            PG8_LDB(B1, 0, 1); PG8_STAGE(PG8_SB(0, 0), b2, voffB);
            PG8_BAR; PG8_WAIT_L(0); PG8_MMA(0, 1, At, B1); PG8_BAR;
            PG8_LDA(At, 0, 1); PG8_STAGE(PG8_SA(0, 0), a2, voffA);
            PG8_BAR; PG8_WAIT_L(0); PG8_MMA(1, 0, At, B0); PG8_BAR; PG8_SCHED;
            PG8_STAGE(PG8_SB(0, 1), b2 + hstep, voffB);
            PG8_WAIT_V(6); PG8_BAR; PG8_MMA(1, 1, At, B1); PG8_BAR;
            PG8_LDB(B0, 1, 0); PG8_SCHED; PG8_LDA(At, 1, 0); PG8_STAGE(PG8_SA(0, 1), a2 + hstep, voffA);
            PG8_WAIT_L(8); PG8_BAR; PG8_WAIT_L(0); PG8_MMA(0, 0, At, B0); PG8_BAR; PG8_SCHED;
            PG8_LDB(B1, 1, 1); PG8_STAGE(PG8_SB(1, 0), b3, voffB);
            PG8_BAR; PG8_WAIT_L(0); PG8_MMA(0, 1, At, B1); PG8_BAR;
            PG8_LDA(At, 1, 1); PG8_STAGE(PG8_SA(1, 0), a3, voffA);
            PG8_BAR; PG8_WAIT_L(0); PG8_MMA(1, 0, At, B0); PG8_BAR; PG8_SCHED;
            PG8_STAGE(PG8_SB(1, 1), b3 + hstep, voffB);
            PG8_WAIT_V(6); PG8_BAR; PG8_MMA(1, 1, At, B1); PG8_BAR;
            }
        }
        if constexpr (ALIGN_EPI) { if (wr == 0) PG8_BAR; }
        E(acc, cur, wr, wc, fr, fq); S.done(cur);
        if (!has_next) break;
#pragma unroll
        for (int a = 0; a < 2; ++a)
#pragma unroll
            for (int b = 0; b < 2; ++b)
#pragma unroll
                for (int m = 0; m < 4; ++m)
#pragma unroll
                    for (int n = 0; n < 2; ++n) acc[a][b][m][n] = (f32x4){0.f, 0.f, 0.f, 0.f};
        cur = nxt; cA = nA; cB = nB; ++ui;
        if constexpr (ALIGN_EPI) { if (wr == 1) PG8_BAR; }
    }
    PG8_WAIT_V(0);
    if constexpr (!ALIGN_EPI) { if (wr == 0) PG8_BAR; }
    PG8_BAR;
#undef PG8_SA
#undef PG8_SB
#undef PG8_STAGE
#undef PG8_LDA
#undef PG8_LDB
#undef PG8_MMA
#undef PG8_WAIT_V
#undef PG8_WAIT_L
#undef PG8_BAR
#undef PG8_SCHED
}
}

typedef f32x4 Acc[2][2][4][2];
extern __shared__ __attribute__((aligned(16))) unsigned char lds_[];
__device__ __forceinline__ LAS float* xch_ptr() { return (LAS float*)((LAS unsigned char*)lds_ + XCH_OFF); }

__device__ __forceinline__ void rope16(float (&y)[16], const float* cs, int fq) {
#pragma unroll
    for (int bj = 0; bj < 2; ++bj)
#pragma unroll
        for (int n = 0; n < 2; ++n) {
            const f32x4 c = *(const f32x4*)(cs + bj * 16 + 8 * (fq & 1) + 4 * n), s = *(const f32x4*)(cs + 32 + bj * 16 + 8 * (fq & 1) + 4 * n);
#pragma unroll
            for (int t = 0; t < 4; ++t) { const int i = bj * 8 + n * 4 + t; const float p = __shfl_xor(y[i], 32); const float rot = (fq < 2) ? -p : p; y[i] = y[i] * c[t] + rot * s[t]; }
        }
}
__device__ __forceinline__ void store16_bf16(bf16_t* rowp  , const float (&y)[16], int fq) {
#pragma unroll
    for (int bj = 0; bj < 2; ++bj) { u32x4 w; w.x = cvt_pk_bf16(y[bj * 8 + 0], y[bj * 8 + 1]); w.y = cvt_pk_bf16(y[bj * 8 + 2], y[bj * 8 + 3]); w.z = cvt_pk_bf16(y[bj * 8 + 4], y[bj * 8 + 5]); w.w = cvt_pk_bf16(y[bj * 8 + 6], y[bj * 8 + 7]);
        *(u32x4*)(rowp + bj * 32 + fq * 8) = w; }
}
__device__ __forceinline__ float quad_sum(float s) { s += __shfl_xor(s, 16); s += __shfl_xor(s, 32); return s; }

struct EpiIn {
    static constexpr bool PERM = true;
    unsigned char* ws; const float *qn_a, *kn_a, *qn_b, *kn_b; int l;
    __device__ __forceinline__ void operator()(const Acc& acc, const pg8::Unit& u, int wr, int wc, int fr, int fq) const {
        const int pn = u.pn, row0 = u.pm * 256 + wr * 64 + fr; const bool lat = u.pm < NLAT / 256;
        if (pn < 4 || (pn >= 6 && pn <= 9)) {
            const float* nw; bf16_t* dst; int ld, head; float osc = 1.f; bool rp = false;
            if (pn < 2) { nw = qn_a; dst = (bf16_t*)(ws + WS_QA); ld = 512; head = pn * 4 + wc; osc = C2_64; }
            else if (pn < 4) { nw = kn_a; dst = (bf16_t*)(ws + WS_KA); ld = 512; head = (pn - 2) * 4 + wc; }
            else if (pn < 9) { nw = qn_b; dst = (bf16_t*)(ws + WS_QB); ld = 768; head = (pn - 6) * 4 + wc; osc = C2_64; rp = lat; }
            else { nw = kn_b; dst = (bf16_t*)(ws + WS_KB); ld = 256; head = wc; rp = lat; }
            float w[16];
#pragma unroll
            for (int bj = 0; bj < 2; ++bj)
#pragma unroll
                for (int n = 0; n < 2; ++n) { const f32x4 t4 = *(const f32x4*)(nw + bj * 32 + fq * 8 + n * 4); w[bj * 8 + n * 4 + 0] = t4[0] * osc; w[bj * 8 + n * 4 + 1] = t4[1] * osc; w[bj * 8 + n * 4 + 2] = t4[2] * osc; w[bj * 8 + n * 4 + 3] = t4[3] * osc; }
#pragma unroll
            for (int ai = 0; ai < 2; ++ai)
#pragma unroll
                for (int m = 0; m < 4; ++m) {
                    const int row = row0 + ai * 128 + m * 16; float y[16]; float s = 0.f;
#pragma unroll
                    for (int bj = 0; bj < 2; ++bj)
#pragma unroll
                        for (int n = 0; n < 2; ++n)
#pragma unroll
                            for (int t = 0; t < 4; ++t) { const float v = acc[ai][bj][m][n][t]; y[bj * 8 + n * 4 + t] = v; s += v * v; }
                    s = quad_sum(s); const float rinv = __builtin_amdgcn_rsqf(s * (1.0f / 64.0f) + EPS);
#pragma unroll
                    for (int i = 0; i < 16; ++i) y[i] = y[i] * rinv * w[i];
                    if (rp) rope16(y, (const float*)(ws + WS_ROPE) + (size_t)(row & (SEQ - 1)) * 64, fq);
                    store16_bf16(dst + (size_t)row * ld + head * 64, y, fq);
                    asm volatile("" ::: "memory");
                }
            return;
        }
        if (pn == 16) {
            if (wc != 0) return;
#pragma unroll
            for (int ai = 0; ai < 2; ++ai)
#pragma unroll
                for (int m = 0; m < 4; ++m) {
                    const int row = row0 + ai * 128 + m * 16; float s = 0.f;
#pragma unroll
                    for (int bj = 0; bj < 2; ++bj)
#pragma unroll
                        for (int n = 0; n < 2; ++n) { const f32x4 v = acc[ai][bj][m][n]; s += (v[0] * v[0] + v[1] * v[1]) + (v[2] * v[2] + v[3] * v[3]); *(f32x4*)((float*)(ws + WS_KPE) + (size_t)row * 64 + bj * 32 + fq * 8 + n * 4) = v; }
                    s = quad_sum(s); if (fq == 0) ((float*)(ws + WS_SSQK))[row] = s;
                }
            return;
        }
        bf16_t* dst; int ld, col0; float* ssq = nullptr; const bool act = pn >= 17;
        if (pn < 6) { dst = (bf16_t*)(ws + WS_VA); ld = 512; col0 = (pn - 4) * 256; }
        else if (pn == 10) { dst = (bf16_t*)(ws + WS_VB); ld = 256; col0 = 0; }
        else if (pn < 14) { dst = (bf16_t*)(ws + WS_CQ); ld = 768; col0 = (pn - 11) * 256; ssq = (float*)(ws + CTL_SSQ_OFF) + (size_t)l * MTOT; }
        else if (pn < 16) { dst = (bf16_t*)(ws + WS_CKV); ld = 512; col0 = (pn - 14) * 256; ssq = (float*)(ws + CTL_SSQ_OFF) + (size_t)(2 + l) * MTOT; }
        else { dst = (bf16_t*)(ws + WS_ZS); ld = 2048; col0 = (pn - 17) * 256; }
#pragma unroll
        for (int ai = 0; ai < 2; ++ai)
#pragma unroll
            for (int m = 0; m < 4; ++m) {
                const int row = row0 + ai * 128 + m * 16; float y[16]; float s = 0.f;
#pragma unroll
                for (int bj = 0; bj < 2; ++bj)
#pragma unroll
                    for (int n = 0; n < 2; ++n)
#pragma unroll
                        for (int t = 0; t < 4; ++t) { float v = acc[ai][bj][m][n][t]; s += v * v; if (act) v = silu_f(v); y[bj * 8 + n * 4 + t] = v; }
                store16_bf16(dst + (size_t)row * ld + col0 + wc * 64, y, fq);
                if (ssq) { s = quad_sum(s); if (fq == 0) atomicAdd(ssq + row, s); }
                asm volatile("" ::: "memory");
            }
    }
};

struct EpiQC {
    static constexpr bool PERM = true;
    unsigned char* ws; const float* qn_c; int l;
    __device__ __forceinline__ void operator()(const Acc& acc, const pg8::Unit& u, int wr, int wc, int fr, int fq) const {
        const int hc = u.pn, row0 = u.pm * 256 + wr * 64 + fr; const bool lat = u.pm < NLAT / 256;
        const float* ssq_cq = (const float*)(ws + CTL_SSQ_OFF) + (size_t)l * MTOT; LAS float* xch = xch_ptr();
#pragma unroll
        for (int ai = 0; ai < 2; ++ai)
#pragma unroll
            for (int m = 0; m < 4; ++m) {
                const int row = row0 + ai * 128 + m * 16; const float r1 = __builtin_amdgcn_rsqf(ssq_cq[row] * (1.0f / 768.0f) + EPS); float s = 0.f;
#pragma unroll
                for (int bj = 0; bj < 2; ++bj)
#pragma unroll
                    for (int n = 0; n < 2; ++n) { const f32x4 v = acc[ai][bj][m][n] * r1; s += (v[0] * v[0] + v[1] * v[1]) + (v[2] * v[2] + v[3] * v[3]); }
                s = quad_sum(s); if (fq == 0) xch[(wr * 64 + ai * 128 + m * 16 + fr) * 4 + wc] = s;
            }
        asm volatile("s_waitcnt lgkmcnt(0)" ::: "memory"); __builtin_amdgcn_s_barrier(); asm volatile("" ::: "memory");
        if (wc == 3) return;
        float w[16];
#pragma unroll
        for (int bj = 0; bj < 2; ++bj)
#pragma unroll
            for (int n = 0; n < 2; ++n) { const f32x4 t4 = *(const f32x4*)(qn_c + wc * 64 + bj * 32 + fq * 8 + n * 4); w[bj * 8 + n * 4 + 0] = t4[0] * C2_192; w[bj * 8 + n * 4 + 1] = t4[1] * C2_192; w[bj * 8 + n * 4 + 2] = t4[2] * C2_192; w[bj * 8 + n * 4 + 3] = t4[3] * C2_192; }
#pragma unroll
        for (int ai = 0; ai < 2; ++ai)
#pragma unroll
            for (int m = 0; m < 4; ++m) {
                const int row = row0 + ai * 128 + m * 16; const f32x4 ps = *(const LAS f32x4*)(xch + (wr * 64 + ai * 128 + m * 16 + fr) * 4);
                const float r1 = __builtin_amdgcn_rsqf(ssq_cq[row] * (1.0f / 768.0f) + EPS);
                const float r2 = __builtin_amdgcn_rsqf(((ps[0] + ps[1]) + (ps[2] + ps[3])) * (1.0f / 192.0f) + EPS) * r1; float y[16];
#pragma unroll
                for (int bj = 0; bj < 2; ++bj)
#pragma unroll
                    for (int n = 0; n < 2; ++n)
#pragma unroll
                        for (int t = 0; t < 4; ++t) y[bj * 8 + n * 4 + t] = acc[ai][bj][m][n][t] * r2 * w[bj * 8 + n * 4 + t];
                if (wc == 2 && lat) rope16(y, (const float*)(ws + WS_ROPE) + (size_t)(row & (SEQ - 1)) * 64, fq);
                store16_bf16((bf16_t*)(ws + WS_QC) + (size_t)row * 1152 + hc * 192 + wc * 64, y, fq);
                asm volatile("" ::: "memory");
            }
    }
};
struct EpiKVC {
    static constexpr bool PERM = true;
    unsigned char* ws; const float* kn_c; int l;
    __device__ __forceinline__ void operator()(const Acc& acc, const pg8::Unit& u, int wr, int wc, int fr, int fq) const {
        const int hc = u.pn, row0 = u.pm * 256 + wr * 64 + fr; const bool lat = u.pm < NLAT / 256;
        const float* ssq_ckv = (const float*)(ws + CTL_SSQ_OFF) + (size_t)(2 + l) * MTOT; LAS float* xch = xch_ptr();
        if (wc < 2) {
#pragma unroll
        for (int ai = 0; ai < 2; ++ai)
#pragma unroll
            for (int m = 0; m < 4; ++m) {
                const int row = row0 + ai * 128 + m * 16; const float r1 = __builtin_amdgcn_rsqf(ssq_ckv[row] * (1.0f / 512.0f) + EPS);
                { float s = 0.f;
#pragma unroll
                    for (int bj = 0; bj < 2; ++bj)
#pragma unroll
                        for (int n = 0; n < 2; ++n) { const f32x4 v = acc[ai][bj][m][n] * r1; s += (v[0] * v[0] + v[1] * v[1]) + (v[2] * v[2] + v[3] * v[3]); }
                    s = quad_sum(s); if (fq == 0) xch[(wr * 64 + ai * 128 + m * 16 + fr) * 4 + wc] = s; }
            }
        }
        asm volatile("s_waitcnt lgkmcnt(0)" ::: "memory"); __builtin_amdgcn_s_barrier(); asm volatile("" ::: "memory");
        if (wc == 3) {
#pragma unroll
            for (int ai = 0; ai < 2; ++ai)
#pragma unroll
                for (int m = 0; m < 4; ++m) { const int row = row0 + ai * 128 + m * 16; float y[16]; const float r1 = __builtin_amdgcn_rsqf(ssq_ckv[row] * (1.0f / 512.0f) + EPS);
#pragma unroll
                    for (int bj = 0; bj < 2; ++bj)
#pragma unroll
                        for (int n = 0; n < 2; ++n)
#pragma unroll
                            for (int t = 0; t < 4; ++t) y[bj * 8 + n * 4 + t] = acc[ai][bj][m][n][t] * r1;
                    store16_bf16((bf16_t*)(ws + WS_VC) + (size_t)row * 768 + hc * 128 + 64, y, fq); asm volatile("" ::: "memory"); }
            return;
        }
        float w[16];
#pragma unroll
        for (int bj = 0; bj < 2; ++bj)
#pragma unroll
            for (int n = 0; n < 2; ++n) { const f32x4 t4 = *(const f32x4*)(kn_c + wc * 64 + bj * 32 + fq * 8 + n * 4); w[bj * 8 + n * 4 + 0] = t4[0]; w[bj * 8 + n * 4 + 1] = t4[1]; w[bj * 8 + n * 4 + 2] = t4[2]; w[bj * 8 + n * 4 + 3] = t4[3]; }
#pragma unroll
        for (int ai = 0; ai < 2; ++ai)
#pragma unroll
            for (int m = 0; m < 4; ++m) {
                const int row = row0 + ai * 128 + m * 16; const f32x4 ps = *(const LAS f32x4*)(xch + (wr * 64 + ai * 128 + m * 16 + fr) * 4);
                const float rk = __builtin_amdgcn_rsqf((ps[0] + ps[1] + ((const float*)(ws + WS_SSQK))[row]) * (1.0f / 192.0f) + EPS); float y[16];
                const float r1 = __builtin_amdgcn_rsqf(ssq_ckv[row] * (1.0f / 512.0f) + EPS);
                if (wc < 2) {
#pragma unroll
                    for (int bj = 0; bj < 2; ++bj)
#pragma unroll
                        for (int n = 0; n < 2; ++n)
#pragma unroll
                            for (int t = 0; t < 4; ++t) y[bj * 8 + n * 4 + t] = acc[ai][bj][m][n][t] * (r1 * rk) * w[bj * 8 + n * 4 + t];
                    store16_bf16((bf16_t*)(ws + WS_KC) + (size_t)row * 1152 + hc * 192 + wc * 64, y, fq);
                } else {
#pragma unroll
                    for (int bj = 0; bj < 2; ++bj)
#pragma unroll
                        for (int n = 0; n < 2; ++n)
#pragma unroll
                            for (int t = 0; t < 4; ++t) y[bj * 8 + n * 4 + t] = acc[ai][bj][m][n][t] * r1;
                    store16_bf16((bf16_t*)(ws + WS_VC) + (size_t)row * 768 + hc * 128, y, fq);
#pragma unroll
                    for (int bj = 0; bj < 2; ++bj)
#pragma unroll
                        for (int n = 0; n < 2; ++n) { const f32x4 kp = *(const f32x4*)((const float*)(ws + WS_KPE) + (size_t)row * 64 + bj * 32 + fq * 8 + n * 4);
#pragma unroll
                            for (int t = 0; t < 4; ++t) y[bj * 8 + n * 4 + t] = kp[t] * rk * w[bj * 8 + n * 4 + t]; }
                    if (lat) rope16(y, (const float*)(ws + WS_ROPE) + (size_t)(row & (SEQ - 1)) * 64, fq);
                    store16_bf16((bf16_t*)(ws + WS_KC) + (size_t)row * 1152 + hc * 192 + 128, y, fq);
                }
                asm volatile("" ::: "memory");
            }
    }
};
struct EpiOut {
    static constexpr bool PERM = true;
    unsigned char* ws; const float *xin, *cin; float* xout; int l;
    __device__ __forceinline__ void operator()(const Acc& acc, const pg8::Unit& u, int wr, int wc, int fr, int fq) const {
        const bool lat = u.pm < NLAT / 256; const int rowt = u.pm * 256 + wr * 64 + fr; const int b = lat ? (u.pm >> 3) : 8;
        const float* src = lat ? xin : cin; float* dst = lat ? xout : (float*)(ws + WS_XC1); const float* modl = (const float*)(ws + WS_MOD) + (size_t)l * 9 * 6144; const int rbase = lat ? rowt : rowt - NLAT;
        const int col0 = u.pn * 256 + wc * 64 + fq * 8; const float* gp = modl + (size_t)b * 6144 + 4096 + col0;
        f32x4 g[2][2];
#pragma unroll
        for (int bj = 0; bj < 2; ++bj)
#pragma unroll
            for (int n = 0; n < 2; ++n) g[bj][n] = *(const f32x4*)(gp + bj * 32 + n * 4);
#pragma unroll
        for (int ai = 0; ai < 2; ++ai)
#pragma unroll
            for (int m = 0; m < 4; ++m) { const size_t off = (size_t)(rbase + ai * 128 + m * 16) * 2048 + col0;
#pragma unroll
                for (int bj = 0; bj < 2; ++bj)
#pragma unroll
                    for (int n = 0; n < 2; ++n) { const f32x4 xo = *(const f32x4*)(src + off + bj * 32 + n * 4); *(f32x4*)(dst + off + bj * 32 + n * 4) = xo + g[bj][n] * acc[ai][bj][m][n]; } }
    }
};

__device__ __forceinline__ int crow(int r, int hi) { return (r & 3) + 8 * (r >> 2) + 4 * hi; }
template <int OFF> __device__ __forceinline__ s16x4 tr_read(int vb) { s16x4 r; asm volatile("ds_read_b64_tr_b16 %0, %1 offset:%2" : "=&v"(r) : "v"(vb), "i"(OFF) : "memory"); return r; }
__device__ __forceinline__ int v_rd_base(int lane) { return ((lane & 3) << 3) | (((lane >> 2) & 3) << 6) | (((lane >> 4) & 1) << 5) | (((lane >> 5) & 1) << 8); }
template <int DV> __device__ __forceinline__ int v_st(int k, int c) { const int kk = (k & ~0xC) | ((k & 4) << 1) | ((k & 8) >> 1); return ((kk >> 3) * (DV / 32) + (c >> 5)) * 512 + ((kk & 7) * 32 + (c & 31)) * 2; }
template <int DV, int D0> __device__ __forceinline__ void pv_one(f32x16& od, int vb, bf16x8 pa0, bf16x8 pa1, bf16x8 pa2, bf16x8 pa3) {
    constexpr int KS = (DV / 32) * 1024, HF = (DV / 32) * 512;
    const s16x4 l0 = tr_read<D0 * 512 + 0 * KS>(vb), h0 = tr_read<D0 * 512 + 0 * KS + HF>(vb), l1 = tr_read<D0 * 512 + 1 * KS>(vb), h1 = tr_read<D0 * 512 + 1 * KS + HF>(vb);
    const s16x4 l2 = tr_read<D0 * 512 + 2 * KS>(vb), h2 = tr_read<D0 * 512 + 2 * KS + HF>(vb), l3 = tr_read<D0 * 512 + 3 * KS>(vb), h3 = tr_read<D0 * 512 + 3 * KS + HF>(vb);
    asm volatile("s_waitcnt lgkmcnt(0)" ::: "memory"); __builtin_amdgcn_sched_barrier(0);
#define PK(L, H) (bf16x8){L[0], L[1], L[2], L[3], H[0], H[1], H[2], H[3]}
    od = __builtin_amdgcn_mfma_f32_32x32x16_bf16(pa0, PK(l0, h0), od, 0, 0, 0);
    od = __builtin_amdgcn_mfma_f32_32x32x16_bf16(pa1, PK(l1, h1), od, 0, 0, 0);
    od = __builtin_amdgcn_mfma_f32_32x32x16_bf16(pa2, PK(l2, h2), od, 0, 0, 0);
    od = __builtin_amdgcn_mfma_f32_32x32x16_bf16(pa3, PK(l3, h3), od, 0, 0, 0);
#undef PK
}

enum { MK_NONE = 0, MK_NA = 1, MK_SWA = 2 };
struct AttnDesc {
    const bf16_t *Q, *Kc, *Vc, *Kl, *Vl;
    int ldq, ldk, ldv;
    int lt0, nlt;
    int mask;
    int q0;
    float m0, l0;
    const float* bias;
    const bf16_t* Z; bf16_t* Y;
};
constexpr float THRL = 8.0f;

template <int DQK, int DV>
__device__ __forceinline__ void attn_unit(const AttnDesc& d, LAS unsigned char* lds) {
    constexpr int KB_BYTES = 64 * DQK * 2, VB_BYTES = 64 * DV * 2, KCH = DQK / 8, VCH = DV / 8, NKL = KCH * 64 / 512, NVL = VCH * 64 / 512, ND0 = DQK / 16, NDV = DV / 32;
    constexpr int OFF_V = 2 * KB_BYTES, OFF_WS = OFF_V + 2 * VB_BYTES, OFF_BIAS = OFF_WS + 8 * 64 * 4;
    static_assert(OFF_BIAS + 2048 <= RING_BYTES, "attention LDS");
    const int tid = tid_opaque(), lane = tid & 63, r32 = lane & 31, hi = lane >> 5; const int wid = __builtin_amdgcn_readfirstlane(tid >> 6);
    LAS float* wsf = (LAS float*)(lds + OFF_WS) + wid * 64;
    LAS float* biasl = (LAS float*)(lds + OFF_BIAS);
    const int NT = 4 + d.nlt;
    int wlo = 0, whi = 0x7fffffff, wrow = 0;
    if (d.mask == MK_NA) { wrow = (d.q0 >> 6) + (wid >> 1); int rs = wrow - 4; rs = rs < 0 ? 0 : (rs > 24 ? 24 : rs); wlo = rs; whi = rs + 7; }
    else if (d.mask == MK_SWA) { const int qw = d.q0 + 32 * wid; wlo = (qw - 128) >> 6; whi = (qw + 31 + 128) >> 6; }
    if (d.mask == MK_NA) { for (int i = tid; i < 15 * 31; i += 512) biasl[i] = d.bias[i] * LOG2E; }
    bf16x8 qr[ND0];
    { const bf16_t* qp = d.Q + (size_t)(wid * 32 + r32) * d.ldq + hi * 8;
#pragma unroll
      for (int d0 = 0; d0 < ND0; ++d0) qr[d0] = *(const bf16x8*)(qp + d0 * 16); }
    float m_reg = d.m0, l_reg = d.l0; f32x16 o[NDV];
#pragma unroll
    for (int i = 0; i < NDV; ++i) o[i] = f32x16{};
    bf16x8 ks[NKL], vs[NVL];
    const int vb0 = (int)(unsigned)(size_t)(lds + OFF_V) + v_rd_base(lane);
#define TILE_K(t) ((t) < 4 ? d.Kc + (size_t)((t) * 64) * d.ldk : d.Kl + (size_t)((d.lt0 + (t) - 4) * 64) * d.ldk)
#define TILE_V(t) ((t) < 4 ? d.Vc + (size_t)((t) * 64) * d.ldv : d.Vl + (size_t)((d.lt0 + (t) - 4) * 64) * d.ldv)
#define SLOADK(t) do { const bf16_t* kp_ = TILE_K(t); \
      _Pragma("unroll") for (int i_ = 0; i_ < NKL; ++i_) { const int c_ = tid + 512 * i_; ks[i_] = *(const bf16x8*)(kp_ + (size_t)(c_ / KCH) * d.ldk + (c_ % KCH) * 8); } } while (0)
#define SLOADV(t) do { const bf16_t* vp_ = TILE_V(t); \
      _Pragma("unroll") for (int i_ = 0; i_ < NVL; ++i_) { const int c_ = tid + 512 * i_; vs[i_] = *(const bf16x8*)(vp_ + (size_t)(c_ / VCH) * d.ldv + (c_ % VCH) * 8); } } while (0)
#define SWRITEK(b) do { \
      _Pragma("unroll") for (int i_ = 0; i_ < NKL; ++i_) { const int c_ = tid + 512 * i_, row_ = c_ / KCH, ch_ = c_ % KCH; *(LAS bf16x8*)(lds + (b) * KB_BYTES + row_ * (DQK * 2) + ((ch_ * 16) ^ (((row_ >> 1) & 7) << 4))) = ks[i_]; } } while (0)
#define SWRITEV(b) do { \
      _Pragma("unroll") for (int i_ = 0; i_ < NVL; ++i_) { const int c_ = tid + 512 * i_; *(LAS bf16x8*)(lds + OFF_V + (b) * VB_BYTES + v_st<DV>(c_ / VCH, (c_ % VCH) * 8)) = vs[i_]; } } while (0)
    SLOADK(0); SLOADV(0); SWRITEK(0); SWRITEV(0); __syncthreads();
    for (int t = 0; t < NT; ++t) {
        const int buf = t & 1;
        if (t + 1 < NT) SLOADK(t + 1);
        const int lt = d.lt0 + t - 4;
        const bool active = (t < 4) || (lt >= wlo && lt <= whi);
        f32x16 p0 = f32x16{}, p1 = f32x16{};
        if (active) {
            { const LAS unsigned char* kb = lds + buf * KB_BYTES;
              const int sw = ((r32 >> 1) & 7) << 4;
#pragma unroll
              for (int d0 = 0; d0 < ND0; ++d0) { const int cb = (d0 * 16 + hi * 8) * 2;
                  const bf16x8 b0 = *(const LAS bf16x8*)(kb + r32 * (DQK * 2) + (cb ^ sw));
                  const bf16x8 b1 = *(const LAS bf16x8*)(kb + (32 + r32) * (DQK * 2) + (cb ^ sw));
                  p0 = __builtin_amdgcn_mfma_f32_32x32x16_bf16(b0, qr[d0], p0, 0, 0, 0);
                  p1 = __builtin_amdgcn_mfma_f32_32x32x16_bf16(b1, qr[d0], p1, 0, 0, 0); } }
        }
        if (t + 1 < NT) { SWRITEK(buf ^ 1); SLOADV(t + 1); }
        if (active) {
            if (t >= 4) {
                if (d.mask == MK_NA) {
                    const int c = (wid & 1) * 32 + r32; int qs = c - 8; qs = qs < 0 ? 0 : (qs > 48 ? 48 : qs);
                    const LAS float* brow = biasl + (lt - wrow + 7) * 31 + (15 - c);
#pragma unroll
                    for (int r = 0; r < 16; ++r) { const int k0 = crow(r, hi), k1 = k0 + 32;
                        p0[r] = (k0 >= qs && k0 < qs + 16) ? p0[r] + brow[k0] : -INFINITY;
                        p1[r] = (k1 >= qs && k1 < qs + 16) ? p1[r] + brow[k1] : -INFINITY; }
                } else if (d.mask == MK_SWA) {
                    const int qi = d.q0 + 32 * wid + r32, kbse = lt * 64;
#pragma unroll
                    for (int r = 0; r < 16; ++r) { const int k0 = kbse + crow(r, hi), k1 = k0 + 32; const int d0_ = qi - k0, d1_ = qi - k1;
                        if (d0_ > 128 || d0_ < -128) p0[r] = -INFINITY; if (d1_ > 128 || d1_ < -128) p1[r] = -INFINITY; }
                }
            }
            float pmax = p0[0];
#pragma unroll
            for (int r = 1; r < 16; ++r) pmax = fmaxf(pmax, p0[r]);
#pragma unroll
            for (int r = 0; r < 16; ++r) pmax = fmaxf(pmax, p1[r]);
            { auto rr = __builtin_amdgcn_permlane32_swap(__float_as_uint(pmax), __float_as_uint(pmax), false, false); pmax = fmaxf(__uint_as_float(rr[0]), __uint_as_float(rr[1])); }
            float alpha = 1.f;
            if (!__all(pmax - m_reg <= THRL)) { const float mn = fmaxf(m_reg, pmax); alpha = __builtin_amdgcn_exp2f(m_reg - mn); m_reg = mn;
                if (hi == 0) wsf[r32] = alpha; asm volatile("s_waitcnt lgkmcnt(0)" ::: "memory");
#pragma unroll
                for (int dd = 0; dd < NDV; ++dd)
#pragma unroll
                    for (int r = 0; r < 16; ++r) o[dd][r] *= wsf[crow(r, hi)]; }
            float ps = 0.f;
#pragma unroll
            for (int r = 0; r < 16; ++r) { p0[r] = __builtin_amdgcn_exp2f(p0[r] - m_reg); p1[r] = __builtin_amdgcn_exp2f(p1[r] - m_reg); ps += p0[r] + p1[r]; }
            { auto rr = __builtin_amdgcn_permlane32_swap(__float_as_uint(ps), __float_as_uint(ps), false, false); ps = __uint_as_float(rr[0]) + __uint_as_float(rr[1]); }
            l_reg = l_reg * alpha + ps;
            bf16x8 pa0, pa1, pa2, pa3;
#define PK4(P, BASE, OUT) do { unsigned a0 = cvt_pk_bf16(P[BASE + 0], P[BASE + 1]), a1 = cvt_pk_bf16(P[BASE + 2], P[BASE + 3]); \
    unsigned b0_ = cvt_pk_bf16(P[BASE + 4], P[BASE + 5]), b1_ = cvt_pk_bf16(P[BASE + 6], P[BASE + 7]); \
    auto r0 = __builtin_amdgcn_permlane32_swap(a0, b0_, false, false); auto r1 = __builtin_amdgcn_permlane32_swap(a1, b1_, false, false); \
    u32x4 w_ = {r0[0], r1[0], r0[1], r1[1]}; OUT = __builtin_bit_cast(bf16x8, w_); } while (0)
            PK4(p0, 0, pa0); PK4(p0, 8, pa1); PK4(p1, 0, pa2); PK4(p1, 8, pa3);
#undef PK4
            const int vb = vb0 + buf * VB_BYTES;
            pv_one<DV, 0>(o[0], vb, pa0, pa1, pa2, pa3); pv_one<DV, 1>(o[1], vb, pa0, pa1, pa2, pa3);
            if constexpr (NDV == 4) { pv_one<DV, 2>(o[2], vb, pa0, pa1, pa2, pa3); pv_one<DV, 3>(o[3], vb, pa0, pa1, pa2, pa3); }
        }
        if (t + 1 < NT) SWRITEV(buf ^ 1);
        __syncthreads();
    }
    if (hi == 0) wsf[r32] = l_reg; asm volatile("s_waitcnt lgkmcnt(0)" ::: "memory");
    float rli[16];
#pragma unroll
    for (int r = 0; r < 16; ++r) rli[r] = __builtin_amdgcn_rcpf(wsf[crow(r, hi)]);
#pragma unroll
    for (int r = 0; r < 16; ++r) { const size_t off = (size_t)(wid * 32 + crow(r, hi)) * 2048 + r32;
#pragma unroll
        for (int dd = 0; dd < NDV; ++dd) { const float z = bf2f(d.Z[off + dd * 32]); const float v = o[dd][r] * rli[r] * z; d.Y[off + dd * 32] = (bf16_t)(cvt_pk_bf16(v, v) & 0xffffu); } }
    __syncthreads();
#undef TILE_K
#undef TILE_V
#undef SLOADK
#undef SLOADV
#undef SWRITEK
#undef SWRITEV
}

typedef GAS unsigned gu32;
#define RLX_AGENT __ATOMIC_RELAXED, __HIP_MEMORY_SCOPE_AGENT
#define LDS_WAIT() asm volatile("s_waitcnt lgkmcnt(0)" ::: "memory")
#define XB_TMO      128
#define XB_XCNT(j)  (256  + 64 * (j))
#define XB_XSUB(j)  (1280 + 64 * (j))
#define XB_XGEN(j)  (2304 + 64 * (j))
#define XB_TOP      3328
#define XB_TOPGEN   3392
#define XCD_BAR_WORDS 3456
#define XB_SPIN_CAP (1u << 22)
__device__ __forceinline__ unsigned xb_ld(unsigned* p)              { return __hip_atomic_load(p, __ATOMIC_RELAXED, __HIP_MEMORY_SCOPE_AGENT); }
__device__ __forceinline__ unsigned xb_add(unsigned* p, unsigned v) { return __hip_atomic_fetch_add(p, v, __ATOMIC_RELAXED, __HIP_MEMORY_SCOPE_AGENT); }
__device__ __forceinline__ unsigned xb_xcc_id() { return (unsigned)__builtin_amdgcn_s_getreg((3 << 11) | 20) & 0xFu; }
#define XB_SPIN(cond, bar) do { unsigned _sp = 0; while (cond) { __builtin_amdgcn_s_sleep(1); \
    if ((++_sp & 255u) == 0u) { if (xb_ld(&(bar)[XB_TMO])) break; if (_sp > XB_SPIN_CAP) { atomicAdd(&(bar)[XB_TMO], 1u); break; } } } } while (0)
struct XcdBarrier { unsigned* bar; unsigned x; volatile LAS unsigned* st; };
__device__ __forceinline__ XcdBarrier xcd_barrier_post(unsigned* bar, volatile LAS unsigned* st) {
    XcdBarrier b; b.bar = bar; b.x = xb_xcc_id(); b.st = st;
    if (threadIdx.x == 0) (void)xb_add(&bar[XB_XCNT(b.x)], 1u);
    return b;
}
__device__ __forceinline__ void xcd_barrier_complete(unsigned* bar, unsigned x, unsigned& nloc, unsigned& nx) {
    const unsigned G = gridDim.x * gridDim.y * gridDim.z;
    unsigned sum, cnt, mine, sp = 0u;
    for (;;) {
        sum = 0u; cnt = 0u; mine = 0u;
#pragma unroll
        for (unsigned j = 0; j < 16; ++j) { const unsigned c = xb_ld(&bar[XB_XCNT(j)]); sum += c; cnt += (c > 0u) ? 1u : 0u; mine = (j == x) ? c : mine; }
        if (sum == G) break;
        __builtin_amdgcn_s_sleep(1);
        if ((++sp & 255u) == 0u) { if (xb_ld(&bar[XB_TMO])) break; if (sp > XB_SPIN_CAP) { atomicAdd(&bar[XB_TMO], 1u); break; } }
    }
    nloc = mine > 0u ? mine : 1u; nx = cnt > 0u ? cnt : 1u;
}
template <bool FIRST> __device__ __forceinline__ void xcd_barrier(const XcdBarrier& b) {
    asm volatile("s_waitcnt vmcnt(0)" ::: "memory");
    __syncthreads();
    if (threadIdx.x == 0) {
        unsigned* bar = b.bar;
        __builtin_amdgcn_s_waitcnt(0);
        unsigned nloc = b.st[0], nx = b.st[1];
        if constexpr (FIRST) { if (nloc == 0u) { xcd_barrier_complete(bar, b.x, nloc, nx); b.st[0] = nloc; b.st[1] = nx; } }
        else { nloc = nloc ? nloc : 1u; nx = nx ? nx : 1u; }
        const unsigned old = xb_add(&bar[XB_XSUB(b.x)], 1u);
        const unsigned gen = old / nloc;
        if (old + 1u == (gen + 1u) * nloc) {
            __builtin_amdgcn_fence(__ATOMIC_RELEASE, "agent");
            asm volatile("s_waitcnt vmcnt(0)" ::: "memory");
            const unsigned og = xb_add(&bar[XB_TOP], 1u);
            const unsigned tg = og / nx;
            if (og + 1u == (tg + 1u) * nx) xb_add(&bar[XB_TOPGEN], 1u);
            else XB_SPIN(xb_ld(&bar[XB_TOPGEN]) == tg, bar);
            __builtin_amdgcn_fence(__ATOMIC_ACQUIRE, "agent");
            xb_add(&bar[XB_XGEN(b.x)], 1u);
            asm volatile("s_waitcnt vmcnt(0)" ::: "memory");
        } else {
            XB_SPIN(xb_ld(&bar[XB_XGEN(b.x)]) == gen, bar);
            __builtin_amdgcn_fence(__ATOMIC_ACQUIRE, "agent");
            asm volatile("s_waitcnt vmcnt(0)" ::: "memory");
        }
    }
    __syncthreads();
}

struct Args { const float* in[21]; float* out; unsigned char* ws; int ph_lo, ph_hi; };

__device__ __forceinline__ float wave_sum(float v) {
#pragma unroll
    for (int o = 1; o < 64; o <<= 1) v += __shfl_xor(v, o);
    return v;
}
__device__ __forceinline__ unsigned f2bf(float f) { unsigned u = __builtin_bit_cast(unsigned, f); return (u + 0x7fffu + ((u >> 16) & 1u)) >> 16; }
__device__ __forceinline__ unsigned pk2(float lo, float hi) { return f2bf(lo) | (f2bf(hi) << 16); }

__device__ __forceinline__ void transpose_item(const float* W, int ldw, int c0, const float* sc, bf16_t* WT, int K, int r0, int kb, LAS float* scr, int lane) {
    const int k0 = 64 * kb;
    if (W) {
#pragma unroll 8
        for (int i = 0; i < 32; ++i) { const int kk = 2 * i + (lane >> 5); float v = W[(size_t)(k0 + kk) * ldw + c0 + (lane & 31)]; if (sc) v *= sc[k0 + kk]; scr[kk * 33 + (lane & 31)] = v; }
    } else {
#pragma unroll 8
        for (int i = 0; i < 32; ++i) { const int kk = 2 * i + (lane >> 5); scr[kk * 33 + (lane & 31)] = 0.f; }
    }
    LDS_WAIT(); asm volatile("" ::: "memory");
    const int c = lane & 7;
#pragma unroll
    for (int j = 0; j < 4; ++j) { const int n = (lane >> 3) + 8 * j; const LAS float* s = scr + (8 * c) * 33 + n;
        u32x4 o; o.x = pk2(s[0 * 33], s[1 * 33]); o.y = pk2(s[2 * 33], s[3 * 33]); o.z = pk2(s[4 * 33], s[5 * 33]); o.w = pk2(s[6 * 33], s[7 * 33]);
        *(u32x4*)(WT + (size_t)(r0 + n) * K + k0 + 8 * c) = o; }
    LDS_WAIT(); asm volatile("" ::: "memory");
}
__device__ __forceinline__ void blk_feat(int nb, int& t, int& f0) { t = nb >> 3; const int j8 = nb & 7; f0 = 64 * (j8 & 3) + 32 * (j8 >> 2); }

__global__ void __launch_bounds__(512, 2) hymba_fwd(Args args) {
    LAS unsigned char* lds = (LAS unsigned char*)lds_;
    volatile LAS unsigned* MISC = (volatile LAS unsigned*)(lds + LDSCTL_OFF);
    const int tid = threadIdx.x, lane = tid & 63, wave = __builtin_amdgcn_readfirstlane(tid >> 6);
    const int G = gridDim.x, bx = blockIdx.x;
    const int vcu = (G % 8 == 0) ? (bx % 8) * (G / 8) + bx / 8 : bx;
    unsigned char* ws0 = args.ws;
    gu32* ctl = (gu32*)(ws0 + WS_CTL);
    for (int u = tid; u < 128; u += 512) MISC[u] = 0u;
    __syncthreads();
    XcdBarrier bar; bar.bar = (unsigned*)ctl + CW_BAR; bar.x = 0; bar.st = nullptr;
    if (MK_N_LAUNCHES == 1) bar = xcd_barrier_post((unsigned*)ctl + CW_BAR, MISC + 8);
    const int lo = args.ph_lo, hi_ph = args.ph_hi;
#ifndef PH_MASK
#define PH_MASK 0x3f
#endif
#define KEN(j) (((PH_MASK) >> (j)) & 1)
#define IN(k) (lo <= (k) && (k) < hi_ph)
#define SEAM(k) do { if (IN(k) && IN((k) + 1)) xcd_barrier<false>(bar); } while (0)
#define PHASE_WS GAS unsigned char* wsg_ = (GAS unsigned char*)args.ws; asm volatile("" : "+s"(wsg_)); unsigned char* ws = (unsigned char*)wsg_;
#define modp ((float*)(ws + WS_MOD))
#define ropep ((float*)(ws + WS_ROPE))
#define XN ((bf16_t*)(ws + WS_XN))
#define YG ((bf16_t*)(ws + WS_XN))
#define QA ((bf16_t*)(ws + WS_QA))
#define KA ((bf16_t*)(ws + WS_KA))
#define VA ((bf16_t*)(ws + WS_VA))
#define QB ((bf16_t*)(ws + WS_QB))
#define KB ((bf16_t*)(ws + WS_KB))
#define VB ((bf16_t*)(ws + WS_VB))
#define CQ ((bf16_t*)(ws + WS_CQ))
#define CKV ((bf16_t*)(ws + WS_CKV))
#define ZS ((bf16_t*)(ws + WS_ZS))
#define QC ((bf16_t*)(ws + WS_QC))
#define KC ((bf16_t*)(ws + WS_KC))
#define VC ((bf16_t*)(ws + WS_VC))
#define KPE ((float*)(ws + WS_KPE))
#define SSQK ((float*)(ws + WS_SSQK))
#define XC1 ((float*)(ws + WS_XC1))
    const float* x_in = args.in[0]; const float* ctx_in = args.in[2];
    const int gw = vcu * 8 + wave, NGW = G * 8;

    if (KEN(0) && IN(0)) { PHASE_WS
        if (bx < 192) {
            const int l = bx / 96, cg = bx % 96, col = cg * 64 + lane;
            LAS float* sl = (LAS float*)lds + wave * (9 * 256);
            LAS float* red = (LAS float*)(lds + 8 * 9 * 256 * 4);
#pragma unroll
            for (int r = 0; r < 9; ++r)
#pragma unroll
                for (int j = 0; j < 4; ++j) { const int k = 256 * wave + 64 * j + lane; const float v = (r < 8) ? args.in[1][r * 2048 + k] : args.in[3][k]; sl[r * 256 + 64 * j + lane] = v / (1.0f + __expf(-v)); }
            LDS_WAIT();
            float acc[9];
#pragma unroll
            for (int r = 0; r < 9; ++r) acc[r] = 0.f;
            const float* wp = args.in[5] + (size_t)l * 2048 * 6144 + (size_t)(256 * wave) * 6144 + col;
            for (int kk = 0; kk < 256; kk += 16) {
                float wv[16];
#pragma unroll
                for (int uu = 0; uu < 16; ++uu) wv[uu] = wp[(size_t)(kk + uu) * 6144];
#pragma unroll
                for (int uu = 0; uu < 16; ++uu)
#pragma unroll
                    for (int r = 0; r < 9; ++r) acc[r] += sl[r * 256 + kk + uu] * wv[uu];
            }
#pragma unroll
            for (int r = 0; r < 9; ++r) red[(wave * 9 + r) * 64 + lane] = acc[r];
            __syncthreads();
            for (int o = tid; o < 576; o += 512) { const int r = o >> 6, cl = o & 63; float s = 0.f;
#pragma unroll
                for (int w8 = 0; w8 < 8; ++w8) s += red[(w8 * 9 + r) * 64 + cl];
                modp[((size_t)l * 9 + r) * 6144 + cg * 64 + cl] = s + args.in[6][l * 6144 + cg * 64 + cl]; }
            __syncthreads();
        }
        {
            LAS float* scr = (LAS float*)(lds + wave * 16384);
            constexpr int I_IN = 200 * 32, I_OUT = 64 * 32, I_QB = 48 * 12, I_KVB = 48 * 8, I_L = I_IN + I_OUT + I_QB + I_KVB;
            for (int it = gw; it < 2 * I_L; it += NGW) {
                const int l = it / I_L; int r = it % I_L; int t, f0;
                if (r < I_IN) { const int nb = r / 32, kb = r % 32; blk_feat(nb, t, f0); const bool valid = !(t == 16 && f0 >= 64); const int src = (t <= 16 ? 256 * t : 4160 + 256 * (t - 17)) + f0;
                    transpose_item(valid ? args.in[7] + (size_t)l * 2048 * N_IN : nullptr, N_IN, src, nullptr, (bf16_t*)(ws + WS_WIN) + (size_t)l * 6400 * 2048, 2048, nb * 32, kb, scr, lane); continue; }
                r -= I_IN;
                if (r < I_OUT) { const int nb = r / 32, kb = r % 32; blk_feat(nb, t, f0);
                    transpose_item(args.in[20] + (size_t)l * 2048 * 2048, 2048, 256 * t + f0, nullptr, (bf16_t*)(ws + WS_WOUT) + (size_t)l * 2048 * 2048, 2048, nb * 32, kb, scr, lane); continue; }
                r -= I_OUT;
                if (r < I_QB) { const int nb = r / 12, kb = r % 12; blk_feat(nb, t, f0); const bool valid = f0 < 192;
                    transpose_item(valid ? args.in[16] + (size_t)l * 768 * 1152 : nullptr, 1152, 192 * t + f0, args.in[14] + l * 768, (bf16_t*)(ws + WS_WQB) + (size_t)l * 1536 * 768, 768, nb * 32, kb, scr, lane); continue; }
                r -= I_QB;
                { const int nb = r / 8, kb = r % 8; blk_feat(nb, t, f0);
                    transpose_item(args.in[17] + (size_t)l * 512 * 1536, 1536, 256 * t + f0, args.in[15] + l * 512, (bf16_t*)(ws + WS_WKVB) + (size_t)l * 1536 * 512, 512, nb * 32, kb, scr, lane); }
            }
        }
        for (int i = gw * 64 + lane; i < 2048 * 32; i += NGW * 64) { const int pos = i >> 5, j = i & 31; const float inv = powf(10000.0f, -(float)(j & 15) * (1.0f / 16.0f));
            const float ang = (float)(j < 16 ? (pos >> 6) : (pos & 63)) * inv; ropep[pos * 64 + j] = cosf(ang); ropep[pos * 64 + 32 + j] = sinf(ang); }
    }
    if (IN(0) && IN(1)) xcd_barrier<true>(bar);

#pragma unroll 1
    for (int l = 0; l < DEPTH; ++l) {
        const int P = 1 + 5 * l;
        if (KEN(1) && IN(P)) { PHASE_WS
            const float* modl = modp + (size_t)l * 9 * 6144; (void)modl;
            const float* xl = (l == 0) ? x_in : args.out; (void)xl;
            const float* xcl = (l == 0) ? ctx_in : XC1; (void)xcl;
            float* ssq_cq = (float*)(ws + CTL_SSQ_OFF) + (size_t)l * MTOT; (void)ssq_cq;
            float* ssq_ckv = (float*)(ws + CTL_SSQ_OFF) + (size_t)(2 + l) * MTOT; (void)ssq_ckv;
            const float* nw = args.in[4] + l * 2048; const int lane = tid_opaque() & 63;
            for (int row = gw; row < MTOT; row += NGW) {
                const bool lat = row < NLAT; const float* xr = lat ? xl + (size_t)row * 2048 : xcl + (size_t)(row - NLAT) * 2048; const int b = lat ? (row >> 11) : 8;
                const float* sh = modl + (size_t)b * 6144; const float* scp = sh + 2048;
                f32x4 v[8]; float s = 0.f;
#pragma unroll
                for (int j = 0; j < 8; ++j) { v[j] = *(const f32x4*)(xr + 4 * lane + 256 * j); s += (v[j][0] * v[j][0] + v[j][1] * v[j][1]) + (v[j][2] * v[j][2] + v[j][3] * v[j][3]); }
                const float rinv = __builtin_amdgcn_rsqf(wave_sum(s) * (1.0f / 2048.0f) + EPS);
#pragma unroll
                for (int j = 0; j < 8; ++j) { const int k = 4 * lane + 256 * j; const f32x4 w4 = *(const f32x4*)(nw + k), s4 = *(const f32x4*)(scp + k), h4 = *(const f32x4*)(sh + k);
                    const f32x4 y = v[j] * rinv * w4 * (s4 + 1.0f) + h4; u32x2 o; o.x = cvt_pk_bf16(y[0], y[1]); o.y = cvt_pk_bf16(y[2], y[3]); *(u32x2*)(XN + (size_t)row * 2048 + k) = o; }
            }
        }
        SEAM(P);
        if (KEN(2) && IN(P + 1)) { PHASE_WS
            const float* modl = modp + (size_t)l * 9 * 6144; (void)modl;
            const float* xl = (l == 0) ? x_in : args.out; (void)xl;
            const float* xcl = (l == 0) ? ctx_in : XC1; (void)xcl;
            float* ssq_cq = (float*)(ws + CTL_SSQ_OFF) + (size_t)l * MTOT; (void)ssq_cq;
            float* ssq_ckv = (float*)(ws + CTL_SSQ_OFF) + (size_t)(2 + l) * MTOT; (void)ssq_ckv;
            pg8::Gemm g{XN, (const bf16_t*)(ws + WS_WIN) + (size_t)l * 6400 * 2048, MTOT, 6400, 2048};
            pg8::Sched2 S; S.G = G; S.c = bx; S.nN1 = NT_IN; S.pm2 = 64; S.nN2 = 9;
            if (l == DEPTH - 1) { S.nM1 = 64; S.nM2 = 8; } else { S.nM1 = 72; S.nM2 = 0; }
            EpiIn E{ws, args.in[8] + l * 64, args.in[9] + l * 64, args.in[11] + l * 64, args.in[12] + l * 64, l};
            pg8::gemm_phase<EpiIn, pg8::Sched2, true, true>(lds, g, S, E);
        }
        SEAM(P + 1);
        if (KEN(3) && IN(P + 2)) { PHASE_WS
            const float* modl = modp + (size_t)l * 9 * 6144; (void)modl;
            const float* xl = (l == 0) ? x_in : args.out; (void)xl;
            const float* xcl = (l == 0) ? ctx_in : XC1; (void)xcl;
            float* ssq_cq = (float*)(ws + CTL_SSQ_OFF) + (size_t)l * MTOT; (void)ssq_cq;
            float* ssq_ckv = (float*)(ws + CTL_SSQ_OFF) + (size_t)(2 + l) * MTOT; (void)ssq_ckv;
            { pg8::Gemm g{CQ, (const bf16_t*)(ws + WS_WQB) + (size_t)l * 1536 * 768, MTOT, 1536, 768};
              pg8::Sched2 S; S.G = G; S.c = bx; S.nN1 = 6; S.nM1 = (l == DEPTH - 1) ? 64 : 72; S.nM2 = 0; S.nN2 = 0; S.pm2 = 0;
              EpiQC E{ws, args.in[18] + l * 192, l};
              pg8::gemm_phase<EpiQC, pg8::Sched2, true, true>(lds, g, S, E); }
            { pg8::Gemm g{CKV, (const bf16_t*)(ws + WS_WKVB) + (size_t)l * 1536 * 512, MTOT, 1536, 512};
              pg8::Sched2 S; S.G = G; S.c = bx; S.nN1 = 6; S.nM1 = 72; S.nM2 = 0; S.nN2 = 0; S.pm2 = 0;
              EpiKVC E{ws, args.in[19] + l * 192, l};
              pg8::gemm_phase<EpiKVC, pg8::Sched2, true, true>(lds, g, S, E); }
        }
        SEAM(P + 2);
        if (KEN(4) && IN(P + 3)) { PHASE_WS
            const float* modl = modp + (size_t)l * 9 * 6144; (void)modl;
            const float* xl = (l == 0) ? x_in : args.out; (void)xl;
            const float* xcl = (l == 0) ? ctx_in : XC1; (void)xcl;
            float* ssq_cq = (float*)(ws + CTL_SSQ_OFF) + (size_t)l * MTOT; (void)ssq_cq;
            float* ssq_ckv = (float*)(ws + CTL_SSQ_OFF) + (size_t)(2 + l) * MTOT; (void)ssq_ckv;
            const int NU_C = BATCH * HC * 8, NU_B = BATCH * HB * 8, NU_A = BATCH * HA * 8;
            const int NU_CC = (l == DEPTH - 1) ? 0 : BATCH * HC, NU_CB = (l == DEPTH - 1) ? 0 : BATCH * HB, NU_CA = (l == DEPTH - 1) ? 0 : BATCH * HA;
            const int NU = NU_C + NU_B + NU_A + NU_CC + NU_CB + NU_CA;
            for (;;) {
                if (tid == 0) MISC[16] = atomicAdd((unsigned*)ctl + CW_QUEUE + 64 * l, 1u);
                __syncthreads();
                int u = (int)MISC[16];
                __syncthreads();
                if (u >= NU) break;
                bool big = false; AttnDesc d; d.m0 = -1e30f; d.l0 = 0.f; d.bias = nullptr; d.mask = MK_NONE; d.lt0 = 0; d.nlt = 0; d.q0 = 0;
                if (u < NU_C) {
                    const int qb = u & 7, hc = (u >> 3) % HC, b = u / (8 * HC); const size_t r0 = (size_t)b * SEQ + qb * 256, rc = (size_t)NLAT + b * LC;
                    d.Q = QC + r0 * 1152 + hc * 192; d.Kc = KC + rc * 1152 + hc * 192; d.Vc = VC + rc * 768 + hc * 128; d.Kl = KC + (size_t)b * SEQ * 1152 + hc * 192; d.Vl = VC + (size_t)b * SEQ * 768 + hc * 128;
                    d.ldq = 1152; d.ldk = 1152; d.ldv = 768; d.nlt = 32; d.Z = ZS + r0 * 2048 + 1280 + hc * 128; d.Y = YG + r0 * 2048 + 1280 + hc * 128; big = true; }
                else if ((u -= NU_C) < NU_B) {
                    const int qb = u & 7, hb = (u >> 3) % HB, b = u / (8 * HB), kv = hb / 3; const size_t r0 = (size_t)b * SEQ + qb * 256, rc = (size_t)NLAT + b * LC;
                    d.Q = QB + r0 * 768 + hb * 64; d.Kc = KB + rc * 256 + kv * 64; d.Vc = VB + rc * 256 + kv * 64; d.Kl = KB + (size_t)b * SEQ * 256 + kv * 64; d.Vl = VB + (size_t)b * SEQ * 256 + kv * 64;
                    d.ldq = 768; d.ldk = 256; d.ldv = 256; const int t0 = qb * 4 - 2 < 0 ? 0 : qb * 4 - 2, t1 = qb * 4 + 5 > 31 ? 31 : qb * 4 + 5; d.lt0 = t0; d.nlt = t1 - t0 + 1;
                    d.mask = MK_SWA; d.q0 = qb * 256; d.m0 = args.in[13][l * HB + hb] * LOG2E; d.l0 = 1.0f;
                    d.Z = ZS + r0 * 2048 + 512 + hb * 64; d.Y = YG + r0 * 2048 + 512 + hb * 64; }
                else if ((u -= NU_B) < NU_A) {
                    const int g4 = u & 7, ha = (u >> 3) % HA, b = u / (8 * HA); const size_t r0 = (size_t)b * SEQ + g4 * 256, rc = (size_t)NLAT + b * LC;
                    d.Q = QA + r0 * 512 + ha * 64; d.Kc = KA + rc * 512 + ha * 64; d.Vc = VA + rc * 512 + ha * 64; d.Kl = KA + (size_t)b * SEQ * 512 + ha * 64; d.Vl = VA + (size_t)b * SEQ * 512 + ha * 64;
                    d.ldq = 512; d.ldk = 512; d.ldv = 512; int ra = 4 * g4 - 4; ra = ra < 0 ? 0 : (ra > 24 ? 24 : ra); int rb = 4 * g4 + 3 - 4; rb = rb < 0 ? 0 : (rb > 24 ? 24 : rb); d.lt0 = ra; d.nlt = rb + 8 - ra;
                    d.mask = MK_NA; d.q0 = g4 * 256; d.bias = args.in[10] + ((size_t)l * HA + ha) * (15 * 31);
                    d.Z = ZS + r0 * 2048 + ha * 64; d.Y = YG + r0 * 2048 + ha * 64; }
                else if ((u -= NU_A) < NU_CC) {
                    const int hc = u % HC, b = u / HC; const size_t rc = (size_t)NLAT + b * LC;
                    d.Q = QC + rc * 1152 + hc * 192; d.Kc = KC + rc * 1152 + hc * 192; d.Vc = VC + rc * 768 + hc * 128; d.Kl = d.Kc; d.Vl = d.Vc; d.ldq = 1152; d.ldk = 1152; d.ldv = 768;
                    d.Z = ZS + rc * 2048 + 1280 + hc * 128; d.Y = YG + rc * 2048 + 1280 + hc * 128; big = true; }
                else if ((u -= NU_CC) < NU_CB) {
                    const int hb = u % HB, b = u / HB, kv = hb / 3; const size_t rc = (size_t)NLAT + b * LC;
                    d.Q = QB + rc * 768 + hb * 64; d.Kc = KB + rc * 256 + kv * 64; d.Vc = VB + rc * 256 + kv * 64; d.Kl = d.Kc; d.Vl = d.Vc; d.ldq = 768; d.ldk = 256; d.ldv = 256;
                    d.m0 = args.in[13][l * HB + hb] * LOG2E; d.l0 = 1.0f;
                    d.Z = ZS + rc * 2048 + 512 + hb * 64; d.Y = YG + rc * 2048 + 512 + hb * 64; }
                else { u -= NU_CB;
                    const int ha = u % HA, b = u / HA; const size_t rc = (size_t)NLAT + b * LC;
                    d.Q = QA + rc * 512 + ha * 64; d.Kc = KA + rc * 512 + ha * 64; d.Vc = VA + rc * 512 + ha * 64; d.Kl = d.Kc; d.Vl = d.Vc; d.ldq = 512; d.ldk = 512; d.ldv = 512;
                    d.Z = ZS + rc * 2048 + ha * 64; d.Y = YG + rc * 2048 + ha * 64; }
                if (big) attn_unit<192, 128>(d, lds); else attn_unit<64, 64>(d, lds);
            }
        }
        SEAM(P + 3);
        if (KEN(5) && IN(P + 4)) { PHASE_WS
            const float* modl = modp + (size_t)l * 9 * 6144; (void)modl;
            const float* xl = (l == 0) ? x_in : args.out; (void)xl;
            const float* xcl = (l == 0) ? ctx_in : XC1; (void)xcl;
            float* ssq_cq = (float*)(ws + CTL_SSQ_OFF) + (size_t)l * MTOT; (void)ssq_cq;
            float* ssq_ckv = (float*)(ws + CTL_SSQ_OFF) + (size_t)(2 + l) * MTOT; (void)ssq_ckv;
            pg8::Gemm g{YG, (const bf16_t*)(ws + WS_WOUT) + (size_t)l * 2048 * 2048, MTOT, 2048, 2048};
            pg8::Sched2 S; S.G = G; S.c = bx; S.nN1 = 8; S.nM1 = (l == DEPTH - 1) ? 64 : 72; S.nM2 = 0; S.nN2 = 0; S.pm2 = 0;
            EpiOut E{ws, xl, xcl, args.out, l};
            pg8::gemm_phase<EpiOut, pg8::Sched2, true, true>(lds, g, S, E);
        }
        if (l + 1 < DEPTH) SEAM(P + 4);
    }
#undef IN
#undef SEAM
}

extern "C" void kernel_launch(void* const* d_in, const int* in_sizes, int n_in, void* d_out, int out_size, void* d_ws, size_t ws_size, hipStream_t stream) {
    static int grid = 0;
    if (grid == 0) {
        if (n_in != 21 || in_sizes[0] != NLAT * DM || out_size != NLAT * DM || ws_size < WS_END) {
            fprintf(stderr, "kernel_launch: shape/workspace mismatch: n_in %d in0 %d out %d ws %zu (need %zu)\n", n_in, n_in > 0 ? in_sizes[0] : -1, out_size, ws_size, (size_t)WS_END); grid = -1; return; }
        int dev = 0, cus = 0, per_cu = 0;
        if (hipGetDevice(&dev) != hipSuccess || hipDeviceGetAttribute(&cus, hipDeviceAttributeMultiprocessorCount, dev) != hipSuccess) { grid = -1; return; }
        if (hipFuncSetAttribute((const void*)hymba_fwd, hipFuncAttributeMaxDynamicSharedMemorySize, LDS_BYTES) != hipSuccess) { fprintf(stderr, "kernel_launch: hipFuncSetAttribute failed\n"); grid = -1; return; }
        if (hipOccupancyMaxActiveBlocksPerMultiprocessor(&per_cu, (const void*)hymba_fwd, 512, LDS_BYTES) != hipSuccess || per_cu < 1) { fprintf(stderr, "kernel_launch: occupancy query says %d blocks per CU\n", per_cu); }
        (void)hipGetLastError();
        grid = cus;
    }
    if (grid < 0) return;
    (void)hipMemsetAsync((char*)d_ws + WS_CTL, 0, CTL_ZERO_BYTES, stream);
    Args a{};
    for (int i = 0; i < 21; ++i) a.in[i] = (const float*)d_in[i];
    a.out = (float*)d_out; a.ws = (unsigned char*)d_ws;
    if (MK_N_LAUNCHES == 1) { a.ph_lo = 0; a.ph_hi = 11; hipLaunchKernelGGL(hymba_fwd, dim3(grid), dim3(512), LDS_BYTES, stream, a); }
    else { for (int p = 0; p < 11; ++p) { a.ph_lo = p; a.ph_hi = p + 1; hipLaunchKernelGGL(hymba_fwd, dim3(grid), dim3(512), LDS_BYTES, stream, a); } }
    const hipError_t le = hipPeekAtLastError();
    if (le != hipSuccess) fprintf(stderr, "kernel_launch: launch failed: %s\n", hipGetErrorName(le));
}
```

```cpp
#include <hip/hip_runtime.h>
#include <hip/hip_bf16.h>
#include <cstdio>
#include <cstdint>

#ifndef LAUNDER_EPI_WS
#define LAUNDER_EPI_WS 1
#endif
#ifndef LAUNDER_LDS
#define LAUNDER_LDS 0
#endif
#ifndef P0_ADA_SHARE
#define P0_ADA_SHARE 0
#endif
#ifndef PREP_A
#define PREP_A 5184
#endif
#ifndef PREP_B
#define PREP_B 2304
#endif
#ifndef EARLY_Q
#define EARLY_Q 0
#endif
#ifndef P3_FLOW
#define P3_FLOW 1
#endif
#ifndef ATT_NPRE
#define ATT_NPRE 512
#endif
#ifndef MK_N_LAUNCHES
#define MK_N_LAUNCHES 1
#endif

constexpr int BATCH = 8, SEQ = 2048, DM = 2048, LC = 256, DEPTH = 2;
constexpr int NLAT = BATCH * SEQ;
constexpr int NCTX = BATCH * LC;
constexpr int MTOT = NLAT + NCTX;
constexpr int N_IN = 6208, NT_IN = 25;
constexpr int HA = 8, HB = 12, HKVB = 4, HC = 6;
constexpr int QLORA = 768, KVLORA = 512;
constexpr float EPS = 1e-6f;
constexpr float LOG2E = 1.4426950408889634f;
constexpr float C2_64 = 0.125f * LOG2E;
constexpr float C2_192 = 0.07216878364870323f * LOG2E;

constexpr size_t al256(size_t x) { return (x + 255) / 256 * 256; }
constexpr size_t WS_CTL = 0, CTL_ZERO_BYTES = 1u << 20;
constexpr size_t CTL_SSQ_OFF = 65536;
constexpr size_t WS_MOD = CTL_ZERO_BYTES;
constexpr size_t WS_ROPE = WS_MOD + al256((size_t)2 * 9 * 6144 * 4);
constexpr size_t WS_WIN = WS_ROPE + (size_t)2048 * 64 * 4;
constexpr size_t WS_WOUT = WS_WIN + (size_t)2 * 6400 * 2048 * 2;
constexpr size_t WS_WQB = WS_WOUT + (size_t)2 * 2048 * 2048 * 2;
constexpr size_t WS_WKVB = WS_WQB + (size_t)2 * 1536 * 768 * 2;
constexpr size_t WS_XN = WS_WKVB + (size_t)2 * 1536 * 512 * 2;
constexpr size_t WS_QA = WS_XN + (size_t)MTOT * 2048 * 2;
constexpr size_t WS_KA = WS_QA + (size_t)MTOT * 512 * 2;
constexpr size_t WS_VA = WS_KA + (size_t)MTOT * 512 * 2;
constexpr size_t WS_QB = WS_VA + (size_t)MTOT * 512 * 2;
constexpr size_t WS_KB = WS_QB + (size_t)MTOT * 768 * 2;
constexpr size_t WS_VB = WS_KB + (size_t)MTOT * 256 * 2;
constexpr size_t WS_CQ = WS_VB + (size_t)MTOT * 256 * 2;
constexpr size_t WS_CKV = WS_CQ + (size_t)MTOT * 768 * 2;
constexpr size_t WS_KPE = WS_CKV + (size_t)MTOT * 512 * 2;
constexpr size_t WS_SSQK = WS_KPE + (size_t)MTOT * 64 * 4;
constexpr size_t WS_ZS = WS_SSQK + al256((size_t)MTOT * 4);
constexpr size_t WS_QC = WS_ZS + (size_t)MTOT * 2048 * 2;
constexpr size_t WS_KC = WS_QC + (size_t)MTOT * 1152 * 2;
constexpr size_t WS_VC = WS_KC + (size_t)MTOT * 1152 * 2;
constexpr size_t WS_XC1 = WS_VC + (size_t)MTOT * 768 * 2;
constexpr size_t WS_KPR = WS_XC1 + (size_t)NCTX * 2048 * 4;
constexpr size_t WS_END = WS_KPR + (size_t)MTOT * 64 * 2;
static_assert(WS_END + (1u << 20) <= 536870912ull, "workspace map must fit 512 MiB");
static_assert(CTL_SSQ_OFF + (size_t)4 * MTOT * 4 <= (size_t)98304 * 4 && ((size_t)98304 + 11 * 3456) * 4 <= CTL_ZERO_BYTES, "control-word map");
constexpr int CW_TMO = 0, CW_QUEUE = 64  , CW_MB = 256  , CW_Q_CVT = 320  , CW_Q_ADA1 = 512  , CW_Q_P1 = 576  , CW_CTXOUT = 1216  , CW_ADA0 = 1152  , CW_P3DONE = 1024  , CW_P2DONE = 896  , CW_P3IN = 768  , CW_CQDONE = 704  , CW_CTXTICKET = 640  , CW_BAR = 98304  ;

constexpr int RING_BYTES = 131072;
constexpr int LDS_BYTES = 147456;
constexpr int LDSCTL_OFF = LDS_BYTES - 1024;
constexpr int XCH_OFF = LDS_BYTES - 1024 - 4096;
constexpr int ATT_LDS_END = XCH_OFF;


#define GAS __attribute__((address_space(1)))
#define LAS __attribute__((address_space(3)))
typedef unsigned short bf16_t;
typedef short bf16x8 __attribute__((ext_vector_type(8)));
typedef short s16x4 __attribute__((ext_vector_type(4)));
typedef float f32x4 __attribute__((ext_vector_type(4)));
typedef float f32x16 __attribute__((ext_vector_type(16)));
typedef unsigned u32x4 __attribute__((ext_vector_type(4)));
typedef unsigned u32x2 __attribute__((ext_vector_type(2)));

__device__ __forceinline__ int launder_s(int x) { asm volatile("" : "+s"(x)); return x; }
__device__ __forceinline__ int tid_opaque() { int t = threadIdx.x; asm volatile("" : "+v"(t)); return t; }
typedef float f32x2_t __attribute__((ext_vector_type(2))); typedef __bf16 bf16x2_t __attribute__((ext_vector_type(2)));
__device__ __forceinline__ unsigned cvt_pk_bf16(float lo, float hi) { const f32x2_t v = {lo, hi}; return __builtin_bit_cast(unsigned, __builtin_convertvector(v, bf16x2_t)); }
__device__ __forceinline__ float bf2f(unsigned short b) { return __uint_as_float(((unsigned)b) << 16); }
__device__ __forceinline__ float silu_f(float v) { return v * __builtin_amdgcn_rcpf(1.0f + __builtin_amdgcn_exp2f(-v * LOG2E)); }

extern __shared__ __attribute__((aligned(16))) unsigned char lds_[];
__device__ __forceinline__ LAS unsigned char* lds_base() { return (LAS unsigned char*)lds_; }
namespace pg8 {
#define PG8_LAS __attribute__((address_space(3)))
constexpr int BM = 256, BK = 64, HALF = 128, HTB = HALF * BK * 2, STAGE_BYTES = 8 * HTB, NXCD = 8, WGM = 8;
__host__ __device__ __forceinline__ int lds_byte(int r, int c) { const int st = (r >> 4) * 2 + (c >> 5), rr = r & 15, cc = c & 31, ob = rr * 64 + cc * 2; return st * 1024 + (ob ^ (((ob >> 9) & 1) << 5)); }
__host__ __device__ __forceinline__ void stage_rc(int b, int& R, int& C) { const int st = b / 1024, sb = b % 1024, swz = sb ^ (((sb >> 9) & 1) << 5); R = (st >> 1) * 16 + swz / 64; C = (st & 1) * 32 + (swz % 64) / 2; }
__host__ __device__ __forceinline__ int perm32(int rho) { const int n = rho >> 4, i = rho & 15; return 8 * (i >> 2) + 4 * n + (i & 3); }
struct Unit { int pm, pn; };
struct Gemm { const bf16_t* A; const bf16_t* Bt; int M, N, K; };

__host__ __device__ __forceinline__ int ctx_pn(int j) { return j < 4 ? 2 + j : (j < 6 ? 5 + j : 8 + j); }
__host__ __device__ __forceinline__ void grid_map(int L, int nM, int nN, int& pm, int& pn) {
    const int nwg = nM * nN; int wgid = L; { const int q = nwg / NXCD, r = nwg % NXCD, xcd = wgid % NXCD, off = wgid / NXCD; wgid = (xcd < r ? xcd * (q + 1) : r * (q + 1) + (xcd - r) * q) + off; }
    const int nig = WGM * nN, gid = wgid / nig, fm = gid * WGM, gsz = (nM - fm) < WGM ? (nM - fm) : WGM;
    pm = fm + ((wgid % nig) % gsz); pn = (wgid % nig) / gsz;
}
struct Sched2 {
    int nM1, nN1, nM2, nN2, pm2, G, c; bool id2 = false;
    unsigned* sig = nullptr; int sig_pm = -1, sig_pn = -1;
    int rk_idle = 0, rk_off3 = 0;
    int twoA = 0;
    int cut = 0x7fffffff; bool swap8 = false;
    __device__ __forceinline__ bool next(int i, Unit& u) const {
        if (rk_idle > 0) {
            const int n = nM1 * nN1; int L;
            if (i == 0) L = c; else if (i == 1) L = c < rk_idle ? G + c : n; else if (i == 2) L = (c >= rk_off3 && c < rk_idle) ? G + rk_idle + (c - rk_off3) : n; else L = n;
            if (L >= n) return false;
            grid_map(L, nM1, nN1, u.pm, u.pn); return true;
        }
        if (twoA > 0) {
            const int a1 = nM1 * 6, a2 = nM2 * 3, b1 = nM1 * 19, b2 = nM2 * 6; int L = i * G + c, j;
            if (L >= cut) return false;
            if (L < a1) { grid_map(L, nM1, 6, u.pm, j); u.pn = 11 + j; return true; }
            L -= a1;
            if (L < a2) { int pm; grid_map(L, nM2, 3, pm, j); u.pm = pm2 + pm; u.pn = 14 + j; return true; }
            L -= a2;
            if (L < b1) { grid_map(L, nM1, 19, u.pm, j); if (swap8 && j == 18 && u.pm >= 64) grid_map(b1 - 8 + (u.pm - 64), nM1, 19, u.pm, j); u.pn = j < 11 ? j : j + 6; return true; }
            L -= b1;
            if (L < b2) { int pm; grid_map(L, nM2, 6, pm, j); u.pm = pm2 + pm; u.pn = j < 4 ? 2 + j : 5 + j; return true; }
            return false;
        }
        const int L = i * G + c, n1 = nM1 * nN1, n2 = nM2 * nN2;
        if (L >= cut) return false;
        if (L < n1) { grid_map(L, nM1, nN1, u.pm, u.pn); if (swap8 && u.pn == nN1 - 1 && u.pm >= 64) grid_map(cut + (u.pm - 64), nM1, nN1, u.pm, u.pn); return true; }
        if (L < n1 + n2) { int pm, pj; grid_map(L - n1, nM2, nN2, pm, pj); u.pm = pm2 + pm; u.pn = id2 ? pj : ctx_pn(pj); return true; }
        return false;
    }
    __device__ __forceinline__ void a_ready(const Unit&) const {}
    __device__ __forceinline__ void done(const Unit& u) const {
        if (sig != nullptr && u.pm == sig_pm && u.pn == sig_pn) { asm volatile("s_waitcnt vmcnt(0)" ::: "memory");
            if ((tid_opaque() & 63) == 0) { LAS unsigned* wc_ = (LAS unsigned*)(lds_base() + LDSCTL_OFF) + 20;
                if (__hip_atomic_fetch_add(wc_, 1u, __ATOMIC_RELAXED, __HIP_MEMORY_SCOPE_WORKGROUP) == 7u) { *wc_ = 0u; (void)__hip_atomic_fetch_add(sig, 1u, __ATOMIC_RELAXED, __HIP_MEMORY_SCOPE_AGENT); } } }
    }
};

struct SchedOne {
    int pm, pn;
    __device__ __forceinline__ bool next(int i, Unit& u) const { if (i == 0) { u.pm = pm; u.pn = pn; return true; } return false; }
    __device__ __forceinline__ void a_ready(const Unit&) const {}
    __device__ __forceinline__ void done(const Unit&) const {}
};

template <class Epi, class Sched, bool ALIGN_EPI = false, bool SP2 = false>
__device__ __forceinline__ void gemm_phase(PG8_LAS unsigned char* lds, const Gemm g, const Sched& S, const Epi& E) {
    const int tid = tid_opaque(), wid = __builtin_amdgcn_readfirstlane(tid >> 6), lane = tid & 63, wr = wid >> 2, wc = wid & 3, fr = lane & 15, fq = lane >> 4;
    const int K = g.K, nt = K / BK;
    unsigned voffA[2], voffB[2];
#pragma unroll
    for (int i = 0; i < 2; ++i) { int R, C; stage_rc(tid * 16 + i * 8192, R, C); const int Rb = Epi::PERM ? ((R & ~31) + perm32(R & 31)) : R;
        voffA[i] = (unsigned)(R * K + C) * 2u; voffB[i] = (unsigned)(Rb * K + C) * 2u; }
    const size_t kstep = (size_t)(BK * 2);
    const size_t hstep = (size_t)HALF * K * 2;
    const size_t tstep = 2 * hstep;
    const unsigned ldsw = (unsigned)wid * 1024u;
    const int aoff = lds_byte(wr * 64 + fr, fq * 8), boff = lds_byte(wc * 32 + fr, fq * 8);
#define PG8_SA(b, h) (((b) * 2 + (h)) * HTB)
#define PG8_SB(b, h) ((4 + (b) * 2 + (h)) * HTB)
#define PG8_STAGE(bufoff, gbase, voff) do { _Pragma("unroll") for (int _i = 0; _i < 2; ++_i) \
        __builtin_amdgcn_global_load_lds((const unsigned*)((const char*)(gbase) + (voff)[_i]), (PG8_LAS unsigned*)(lds + (bufoff) + ldsw + _i * 8192), 16, 0, 0); } while (0)
#define PG8_LDA(dst, b, h) do { _Pragma("unroll") for (int m = 0; m < 4; ++m) _Pragma("unroll") for (int k = 0; k < 2; ++k) dst[m][k] = *(const PG8_LAS bf16x8*)(lds + PG8_SA(b, h) + aoff + m * 2048 + k * 1024); } while (0)
#define PG8_LDB(dst, b, h) do { _Pragma("unroll") for (int n = 0; n < 2; ++n) _Pragma("unroll") for (int k = 0; k < 2; ++k) dst[n][k] = *(const PG8_LAS bf16x8*)(lds + PG8_SB(b, h) + boff + n * 2048 + k * 1024); } while (0)
#define PG8_MMA(ai, bj, At, Bt) do { __builtin_amdgcn_s_setprio(1); _Pragma("unroll") for (int m = 0; m < 4; ++m) _Pragma("unroll") for (int n = 0; n < 2; ++n) _Pragma("unroll") for (int k = 0; k < 2; ++k) \
        acc[ai][bj][m][n] = __builtin_amdgcn_mfma_f32_16x16x32_bf16(Bt[n][k], At[m][k], acc[ai][bj][m][n], 0, 0, 0); __builtin_amdgcn_s_setprio(0); } while (0)
#define PG8_WAIT_V(n) asm volatile("s_waitcnt vmcnt(" #n ")" ::: "memory")
#define PG8_WAIT_L(n) asm volatile("s_waitcnt lgkmcnt(" #n ")" ::: "memory")
#define PG8_BAR __builtin_amdgcn_s_barrier()
#define PG8_SCHED __builtin_amdgcn_sched_barrier(0)
    Unit cur, nxt; int ui = 0;
    if (!S.next(0, cur)) return;
    f32x4 acc[2][2][4][2];
#pragma unroll
    for (int a = 0; a < 2; ++a)
#pragma unroll
        for (int b = 0; b < 2; ++b)
#pragma unroll
            for (int m = 0; m < 4; ++m)
#pragma unroll
                for (int n = 0; n < 2; ++n) acc[a][b][m][n] = (f32x4){0.f, 0.f, 0.f, 0.f};
    bf16x8 At[4][2], B0[2][2], B1[2][2];
    const char* cA = (const char*)g.A + (size_t)cur.pm * tstep; const char* cB = (const char*)g.Bt + (size_t)cur.pn * tstep;
    S.a_ready(cur);
    if constexpr (SP2) {
        PG8_STAGE(PG8_SB(0, 0), cB, voffB); PG8_STAGE(PG8_SB(0, 1), cB + hstep, voffB); PG8_STAGE(PG8_SA(0, 0), cA, voffA); PG8_STAGE(PG8_SA(0, 1), cA + hstep, voffA);
        if (wr == 1) PG8_BAR;
        PG8_WAIT_V(2); PG8_BAR;
        PG8_STAGE(PG8_SB(1, 0), cB + kstep, voffB); PG8_STAGE(PG8_SA(1, 0), cA + kstep, voffA); PG8_STAGE(PG8_SB(1, 1), cB + hstep + kstep, voffB);
        PG8_WAIT_V(6); PG8_BAR;
    } else {
        PG8_STAGE(PG8_SB(0, 0), cB, voffB); PG8_STAGE(PG8_SA(0, 0), cA, voffA); PG8_STAGE(PG8_SB(0, 1), cB + hstep, voffB); PG8_STAGE(PG8_SA(0, 1), cA + hstep, voffA);
        if (wr == 1) PG8_BAR;
        PG8_WAIT_V(4); PG8_BAR;
        PG8_STAGE(PG8_SB(1, 0), cB + kstep, voffB); PG8_STAGE(PG8_SA(1, 0), cA + kstep, voffA); PG8_STAGE(PG8_SB(1, 1), cB + hstep + kstep, voffB);
        PG8_WAIT_V(6); PG8_BAR;
    }
    for (;;) {
        const bool has_next = S.next(ui + 1, nxt);
        const char* nA = has_next ? (const char*)g.A + (size_t)nxt.pm * tstep : cA; const char* nB = has_next ? (const char*)g.Bt + (size_t)nxt.pn * tstep : cB;
        for (int t = 0; t < nt; t += 2) {
            const bool last = (t == nt - 2);
            const char* a1 = cA + (size_t)(t + 1) * kstep;
            const char* a2 = last ? nA : cA + (size_t)(t + 2) * kstep; const char* b2 = last ? nB : cB + (size_t)(t + 2) * kstep;
            const char* a3 = a2 + kstep; const char* b3 = b2 + kstep;
            if (last && has_next) S.a_ready(nxt);
            if constexpr (SP2) {
            PG8_LDB(B0, 0, 0); PG8_LDB(B1, 0, 1); PG8_SCHED; PG8_LDA(At, 0, 0); PG8_STAGE(PG8_SA(1, 1), a1 + hstep, voffA);
            PG8_WAIT_V(8); PG8_WAIT_L(0); PG8_BAR; PG8_MMA(0, 0, At, B0); PG8_MMA(0, 1, At, B1); PG8_BAR; PG8_SCHED;
            PG8_LDA(At, 0, 1); PG8_STAGE(PG8_SB(0, 0), b2, voffB); PG8_STAGE(PG8_SB(0, 1), b2 + hstep, voffB); PG8_STAGE(PG8_SA(0, 0), a2, voffA);
            PG8_WAIT_V(8); PG8_WAIT_L(0); PG8_BAR; PG8_MMA(1, 0, At, B0); PG8_MMA(1, 1, At, B1); PG8_BAR; PG8_SCHED;
            PG8_LDB(B0, 1, 0); PG8_LDB(B1, 1, 1); PG8_SCHED; PG8_LDA(At, 1, 0); PG8_STAGE(PG8_SA(0, 1), a2 + hstep, voffA);
            PG8_WAIT_V(8); PG8_WAIT_L(0); PG8_BAR; PG8_MMA(0, 0, At, B0); PG8_MMA(0, 1, At, B1); PG8_BAR; PG8_SCHED;
            PG8_LDA(At, 1, 1); PG8_STAGE(PG8_SB(1, 0), b3, voffB); PG8_STAGE(PG8_SB(1, 1), b3 + hstep, voffB); PG8_STAGE(PG8_SA(1, 0), a3, voffA);
            PG8_WAIT_V(8); PG8_WAIT_L(0); PG8_BAR; PG8_MMA(1, 0, At, B0); PG8_MMA(1, 1, At, B1); PG8_BAR; PG8_SCHED;
            } else {
            PG8_LDB(B0, 0, 0); PG8_SCHED; PG8_LDA(At, 0, 0); PG8_STAGE(PG8_SA(1, 1), a1 + hstep, voffA);
            PG8_WAIT_L(8); PG8_BAR; PG8_WAIT_L(0); PG8_MMA(0, 0, At, B0); PG8_BAR; PG8_SCHED;
            PG8_LDB(B1, 0, 1); PG8_STAGE(PG8_SB(0, 0), b2, voffB);
            PG8_BAR; PG8_WAIT_L(0); PG8_MMA(0, 1, At, B1); PG8_BAR;
            PG8_LDA(At, 0, 1); PG8_STAGE(PG8_SA(0, 0), a2, voffA);
            PG8_BAR; PG8_WAIT_L(0); PG8_MMA(1, 0, At, B0); PG8_BAR; PG8_SCHED;
            PG8_STAGE(PG8_SB(0, 1), b2 + hstep, voffB);
            PG8_WAIT_V(6); PG8_BAR; PG8_MMA(1, 1, At, B1); PG8_BAR;
            PG8_LDB(B0, 1, 0); PG8_SCHED; PG8_LDA(At, 1, 0); PG8_STAGE(PG8_SA(0, 1), a2 + hstep, voffA);
            PG8_WAIT_L(8); PG8_BAR; PG8_WAIT_L(0); PG8_MMA(0, 0, At, B0); PG8_BAR; PG8_SCHED;
            PG8_LDB(B1, 1, 1); PG8_STAGE(PG8_SB(1, 0), b3, voffB);
            PG8_BAR; PG8_WAIT_L(0); PG8_MMA(0, 1, At, B1); PG8_BAR;
            PG8_LDA(At, 1, 1); PG8_STAGE(PG8_SA(1, 0), a3, voffA);
            PG8_BAR; PG8_WAIT_L(0); PG8_MMA(1, 0, At, B0); PG8_BAR; PG8_SCHED;
            PG8_STAGE(PG8_SB(1, 1), b3 + hstep, voffB);
            PG8_WAIT_V(6); PG8_BAR; PG8_MMA(1, 1, At, B1); PG8_BAR;
            }
        }
        if constexpr (ALIGN_EPI) { if (wr == 0) PG8_BAR; }
        E(acc, cur, wr, wc, fr, fq); S.done(cur);
        if (!has_next) break;
#pragma unroll
        for (int a = 0; a < 2; ++a)
#pragma unroll
            for (int b = 0; b < 2; ++b)
#pragma unroll
                for (int m = 0; m < 4; ++m)
#pragma unroll
                    for (int n = 0; n < 2; ++n) acc[a][b][m][n] = (f32x4){0.f, 0.f, 0.f, 0.f};
        cur = nxt; cA = nA; cB = nB; ++ui;
        if constexpr (ALIGN_EPI) { if (wr == 1) PG8_BAR; }
    }
    PG8_WAIT_V(0);
    if constexpr (!ALIGN_EPI) { if (wr == 0) PG8_BAR; }
    PG8_BAR;
#undef PG8_SA
#undef PG8_SB
#undef PG8_STAGE
#undef PG8_LDA
#undef PG8_LDB
#undef PG8_MMA
#undef PG8_WAIT_V
#undef PG8_WAIT_L
#undef PG8_BAR
#undef PG8_SCHED
}
}

typedef f32x4 Acc[2][2][4][2];
extern __shared__ __attribute__((aligned(16))) unsigned char lds_[];
__device__ __forceinline__ LAS float* xch_ptr() { return (LAS float*)((LAS unsigned char*)lds_ + XCH_OFF); }

struct RopeFreq { float inv[8]; };
__device__ __forceinline__ RopeFreq rope_freq(int fq) { RopeFreq f;
#pragma unroll
    for (int j = 0; j < 8; ++j) f.inv[j] = __builtin_amdgcn_exp2f(-(float)(8 * (fq & 1) + j) * 0.83048202372184059f);
    return f; }
__device__ __forceinline__ void rope16(float (&y)[16], const RopeFreq& f, int pos, int fq) {
    asm volatile("" : "+v"(pos) :: "memory");
    const float pc[2] = {(float)(pos >> 6), (float)(pos & 63)};
#pragma unroll
    for (int bj = 0; bj < 2; ++bj)
#pragma unroll
        for (int j = 0; j < 8; ++j) { const int i = bj * 8 + j; (void)f; const float inv = __builtin_amdgcn_exp2f(-(float)(8 * (fq & 1) + j) * 0.83048202372184059f);
            const float rev = (pc[bj] * inv) * 0.15915494309189535f;
            const float c = __builtin_amdgcn_cosf(rev), sn = __builtin_amdgcn_sinf(rev);
            auto rr = __builtin_amdgcn_permlane32_swap(__float_as_uint(y[i]), __float_as_uint(y[i]), false, false);
            const float rot = (fq < 2) ? -__uint_as_float(rr[1]) : __uint_as_float(rr[0]); y[i] = y[i] * c + rot * sn;
            if ((j & 3) == 3) __builtin_amdgcn_sched_barrier(0); }
}
__device__ __forceinline__ void store16_bf16_wt(__amdgpu_buffer_rsrc_t rsrc, unsigned byte_off  , const float (&y)[16], int fq) {
#pragma unroll
    for (int bj = 0; bj < 2; ++bj) { u32x4 w; w.x = cvt_pk_bf16(y[bj * 8 + 0], y[bj * 8 + 1]); w.y = cvt_pk_bf16(y[bj * 8 + 2], y[bj * 8 + 3]); w.z = cvt_pk_bf16(y[bj * 8 + 4], y[bj * 8 + 5]); w.w = cvt_pk_bf16(y[bj * 8 + 6], y[bj * 8 + 7]);
        __builtin_amdgcn_raw_buffer_store_b128(w, rsrc, byte_off + (unsigned)(bj * 32 + fq * 8) * 2u, 0,   16); }
}
__device__ __forceinline__ void store16_bf16(bf16_t* rowp  , const float (&y)[16], int fq) {
#pragma unroll
    for (int bj = 0; bj < 2; ++bj) { u32x4 w; w.x = cvt_pk_bf16(y[bj * 8 + 0], y[bj * 8 + 1]); w.y = cvt_pk_bf16(y[bj * 8 + 2], y[bj * 8 + 3]); w.z = cvt_pk_bf16(y[bj * 8 + 4], y[bj * 8 + 5]); w.w = cvt_pk_bf16(y[bj * 8 + 6], y[bj * 8 + 7]);
        *(u32x4*)(rowp + bj * 32 + fq * 8) = w; }
}
template <int XM> __device__ __forceinline__ float swz_xor(float v) { return __int_as_float(__builtin_amdgcn_ds_swizzle(__float_as_int(v), (XM << 10) | 0x1F)); }
__device__ __forceinline__ float sum_xor32(float v) { auto r = __builtin_amdgcn_permlane32_swap(__float_as_uint(v), __float_as_uint(v), false, false); return __uint_as_float(r[0]) + __uint_as_float(r[1]); }
__device__ __forceinline__ float quad_sum(float s) { s += swz_xor<16>(s); return sum_xor32(s); }

struct EpiNull {
    static constexpr bool PERM = true; unsigned char* ws;
    __device__ __forceinline__ void operator()(const Acc& acc, const pg8::Unit& u, int wr, int wc, int fr, int fq) const {
        float s_ = 0.f;
#pragma unroll
        for (int a_ = 0; a_ < 2; ++a_)
#pragma unroll
            for (int b_ = 0; b_ < 2; ++b_)
#pragma unroll
                for (int m_ = 0; m_ < 4; ++m_)
#pragma unroll
                    for (int n_ = 0; n_ < 2; ++n_) s_ += acc[a_][b_][m_][n_][0] + acc[a_][b_][m_][n_][1] + acc[a_][b_][m_][n_][2] + acc[a_][b_][m_][n_][3];
        if (s_ == 1.2345e-30f) ((float*)(ws + WS_SSQK))[u.pm * 256 + wr * 64 + fr + wc + fq] = s_;
    }
};
struct EpiIn {
    static constexpr bool PERM = true;
    unsigned char* ws; const float *qn_a, *kn_a, *qn_b, *kn_b, *kn_c; int l;
    __device__ __forceinline__ void operator()(const Acc& acc, const pg8::Unit& u, int wr, int wc, int fr, int fq_in) const {
#if LAUNDER_EPI_WS
        GAS unsigned char* wsl_ = (GAS unsigned char*)this->ws; asm volatile("" : "+s"(wsl_)); unsigned char* const ws = (unsigned char*)wsl_;
#endif
        int fq = fq_in; asm volatile("" : "+v"(fq));
        const int pn = u.pn, row0 = u.pm * 256 + wr * 64 + fr; const bool lat = u.pm < NLAT / 256;
        const __amdgpu_buffer_rsrc_t wsr = __builtin_amdgcn_make_buffer_rsrc((void*)ws, 0, (int)WS_END, 0x00020000);
#ifdef EPI_NULL
        { float s_ = 0.f; for (int a_ = 0; a_ < 2; ++a_) for (int b_ = 0; b_ < 2; ++b_) for (int m_ = 0; m_ < 4; ++m_) for (int n_ = 0; n_ < 2; ++n_) s_ += acc[a_][b_][m_][n_][0]; if (s_ == 1.2345e-30f) ((float*)(ws + WS_SSQK))[row0] = s_; return; }
#endif
        if (pn < 4 || (pn >= 6 && pn <= 9)) {
            const LAS float* nw; unsigned dst; int ld, head; float osc = 1.f; bool rp = false; const LAS float* wl = xch_ptr();
            if (pn < 2) { nw = wl; dst = (unsigned)WS_QA; ld = 512; head = pn * 4 + wc; osc = C2_64; }
            else if (pn < 4) { nw = wl + 64; dst = (unsigned)WS_KA; ld = 512; head = (pn - 2) * 4 + wc; }
            else if (pn < 9) { nw = wl + 128; dst = (unsigned)WS_QB; ld = 768; head = (pn - 6) * 4 + wc; osc = C2_64; rp = lat; }
            else { nw = wl + 192; dst = (unsigned)WS_KB; ld = 256; head = wc; rp = lat; }
            const RopeFreq rf = rope_freq(fq); float w[16];
#pragma unroll
            for (int bj = 0; bj < 2; ++bj)
#pragma unroll
                for (int n = 0; n < 2; ++n) { const f32x4 t4 = *(const LAS f32x4*)(nw + bj * 32 + fq * 8 + n * 4); w[bj * 8 + n * 4 + 0] = t4[0] * osc; w[bj * 8 + n * 4 + 1] = t4[1] * osc; w[bj * 8 + n * 4 + 2] = t4[2] * osc; w[bj * 8 + n * 4 + 3] = t4[3] * osc; }
#pragma unroll
            for (int ai = 0; ai < 2; ++ai)
#pragma unroll
                for (int m = 0; m < 4; ++m) {
                    const int row = row0 + ai * 128 + m * 16; float y[16]; float s = 0.f;
#pragma unroll
                    for (int bj = 0; bj < 2; ++bj)
#pragma unroll
                        for (int n = 0; n < 2; ++n)
#pragma unroll
                            for (int t = 0; t < 4; ++t) { const float v = acc[ai][bj][m][n][t]; y[bj * 8 + n * 4 + t] = v; s += v * v; }
                    s = quad_sum(s); const float rinv = __builtin_amdgcn_rsqf(s * (1.0f / 64.0f) + EPS);
#pragma unroll
                    for (int i = 0; i < 16; ++i) y[i] = y[i] * rinv * w[i];
                    if (rp) rope16(y, rf, row & (SEQ - 1), fq);
                    store16_bf16_wt(wsr, dst + (unsigned)(row * ld + head * 64) * 2u, y, fq);
                    __builtin_amdgcn_sched_barrier(0);
                }
            return;
        }
        if (pn == 16) {
            if (wc != 0) return;
            const RopeFreq rf = rope_freq(fq); float w[16];
#pragma unroll
            for (int bj = 0; bj < 2; ++bj)
#pragma unroll
                for (int n = 0; n < 2; ++n) { const f32x4 t4 = *(const LAS f32x4*)(xch_ptr() + 256 + 128 + bj * 32 + fq * 8 + n * 4); w[bj * 8 + n * 4 + 0] = t4[0]; w[bj * 8 + n * 4 + 1] = t4[1]; w[bj * 8 + n * 4 + 2] = t4[2]; w[bj * 8 + n * 4 + 3] = t4[3]; }
#pragma unroll
            for (int ai = 0; ai < 2; ++ai)
#pragma unroll
                for (int m = 0; m < 4; ++m) {
                    const int row = row0 + ai * 128 + m * 16; float s = 0.f; float y[16];
#pragma unroll
                    for (int bj = 0; bj < 2; ++bj)
#pragma unroll
                        for (int n = 0; n < 2; ++n) { const f32x4 v = acc[ai][bj][m][n]; s += (v[0] * v[0] + v[1] * v[1]) + (v[2] * v[2] + v[3] * v[3]); *(f32x4*)((float*)(ws + WS_KPE) + (size_t)row * 64 + bj * 32 + fq * 8 + n * 4) = v;
#pragma unroll
                            for (int t = 0; t < 4; ++t) y[bj * 8 + n * 4 + t] = v[t] * w[bj * 8 + n * 4 + t]; }
                    s = quad_sum(s); if (fq == 0) __hip_atomic_store((GAS float*)(ws + WS_SSQK) + row, s, __ATOMIC_RELAXED, __HIP_MEMORY_SCOPE_AGENT);
                    if (lat) rope16(y, rf, row & (SEQ - 1), fq);
                    store16_bf16_wt(wsr, (unsigned)WS_KPR + (unsigned)(row * 64) * 2u, y, fq);
                    __builtin_amdgcn_sched_barrier(0);
                }
            return;
        }
        unsigned dst; int ld, col0; float* ssq = nullptr; const bool act = pn >= 17;
        if (pn < 6) { dst = (unsigned)WS_VA; ld = 512; col0 = (pn - 4) * 256; }
        else if (pn == 10) { dst = (unsigned)WS_VB; ld = 256; col0 = 0; }
        else if (pn < 14) { dst = (unsigned)WS_CQ; ld = 768; col0 = (pn - 11) * 256; ssq = (float*)(ws + CTL_SSQ_OFF) + (size_t)l * MTOT; }
        else if (pn < 16) { dst = (unsigned)WS_CKV; ld = 512; col0 = (pn - 14) * 256; ssq = (float*)(ws + CTL_SSQ_OFF) + (size_t)(2 + l) * MTOT; }
        else { dst = (unsigned)WS_ZS; ld = 2048; col0 = (pn - 17) * 256; }
#pragma unroll
        for (int ai = 0; ai < 2; ++ai)
#pragma unroll
            for (int m = 0; m < 4; ++m) {
                const int row = row0 + ai * 128 + m * 16; float y[16]; float s = 0.f;
#pragma unroll
                for (int bj = 0; bj < 2; ++bj)
#pragma unroll
                    for (int n = 0; n < 2; ++n)
#pragma unroll
                        for (int t = 0; t < 4; ++t) { float v = acc[ai][bj][m][n][t]; s += v * v; if (act) v = silu_f(v); y[bj * 8 + n * 4 + t] = v; }
                store16_bf16_wt(wsr, dst + (unsigned)(row * ld + col0 + wc * 64) * 2u, y, fq);
                if (ssq) { s = quad_sum(s); if (fq == 0) atomicAdd(ssq + row, s); }
                __builtin_amdgcn_sched_barrier(0);
            }
    }
};

struct EpiQC {
    static constexpr bool PERM = true;
    unsigned char* ws; const float* qn_c; int l;
    __device__ __forceinline__ void operator()(const Acc& acc, const pg8::Unit& u, int wr, int wc, int fr, int fq_in) const {
#if LAUNDER_EPI_WS
        GAS unsigned char* wsl_ = (GAS unsigned char*)this->ws; asm volatile("" : "+s"(wsl_)); unsigned char* const ws = (unsigned char*)wsl_;
#endif
        int fq = fq_in; asm volatile("" : "+v"(fq));
        const int hc = u.pn, row0 = u.pm * 256 + wr * 64 + fr; const bool lat = u.pm < NLAT / 256;
        const __amdgpu_buffer_rsrc_t wsr = __builtin_amdgcn_make_buffer_rsrc((void*)ws, 0, (int)WS_END, 0x00020000);
        const float* ssq_cq = (const float*)(ws + CTL_SSQ_OFF) + (size_t)l * MTOT; LAS float* xch = xch_ptr();
        float r1v[8];
#pragma unroll
        for (int i = 0; i < 8; ++i) r1v[i] = ssq_cq[row0 + (i >> 2) * 128 + (i & 3) * 16];
#pragma unroll
        for (int i = 0; i < 8; ++i) r1v[i] = __builtin_amdgcn_rsqf(r1v[i] * (1.0f / 768.0f) + EPS);
#pragma unroll
        for (int ai = 0; ai < 2; ++ai)
#pragma unroll
            for (int m = 0; m < 4; ++m) {
                float r1 = r1v[ai * 4 + m]; asm volatile("" : "+v"(r1) :: "memory"); float s = 0.f;
#pragma unroll
                for (int bj = 0; bj < 2; ++bj)
#pragma unroll
                    for (int n = 0; n < 2; ++n) { const f32x4 v = acc[ai][bj][m][n] * r1; s += (v[0] * v[0] + v[1] * v[1]) + (v[2] * v[2] + v[3] * v[3]); }
                s = quad_sum(s); if (fq == 0) xch[(wr * 64 + ai * 128 + m * 16 + fr) * 4 + wc] = s;
                __builtin_amdgcn_sched_barrier(0);
            }
        asm volatile("s_waitcnt lgkmcnt(0)" ::: "memory"); __builtin_amdgcn_s_barrier(); asm volatile("" ::: "memory");
        if (wc == 3) return;
        const RopeFreq rfq = rope_freq(fq); float w[16];
#pragma unroll
        for (int bj = 0; bj < 2; ++bj)
#pragma unroll
            for (int n = 0; n < 2; ++n) { const f32x4 t4 = *(const f32x4*)(qn_c + wc * 64 + bj * 32 + fq * 8 + n * 4); w[bj * 8 + n * 4 + 0] = t4[0] * C2_192; w[bj * 8 + n * 4 + 1] = t4[1] * C2_192; w[bj * 8 + n * 4 + 2] = t4[2] * C2_192; w[bj * 8 + n * 4 + 3] = t4[3] * C2_192; }
#pragma unroll
        for (int ai = 0; ai < 2; ++ai)
#pragma unroll
            for (int m = 0; m < 4; ++m) {
                const int row = row0 + ai * 128 + m * 16; const f32x4 ps = *(const LAS f32x4*)(xch + (wr * 64 + ai * 128 + m * 16 + fr) * 4);
                float r1 = r1v[ai * 4 + m]; asm volatile("" : "+v"(r1) :: "memory");
                const float r2 = __builtin_amdgcn_rsqf(((ps[0] + ps[1]) + (ps[2] + ps[3])) * (1.0f / 192.0f) + EPS) * r1; float y[16];
#pragma unroll
                for (int bj = 0; bj < 2; ++bj)
#pragma unroll
                    for (int n = 0; n < 2; ++n)
#pragma unroll
                        for (int t = 0; t < 4; ++t) y[bj * 8 + n * 4 + t] = acc[ai][bj][m][n][t] * r2 * w[bj * 8 + n * 4 + t];
                if (wc == 2 && lat) rope16(y, rfq, row & (SEQ - 1), fq);
                store16_bf16_wt(wsr, (unsigned)WS_QC + (unsigned)(row * 1152 + hc * 192 + wc * 64) * 2u, y, fq);
                __builtin_amdgcn_sched_barrier(0);
            }
    }
};
struct EpiKVC {
    static constexpr bool PERM = true;
    unsigned char* ws; const float* kn_c; int l;
    __device__ __forceinline__ void operator()(const Acc& acc, const pg8::Unit& u, int wr, int wc, int fr, int fq_in) const {
#if LAUNDER_EPI_WS
        GAS unsigned char* wsl_ = (GAS unsigned char*)this->ws; asm volatile("" : "+s"(wsl_)); unsigned char* const ws = (unsigned char*)wsl_;
#endif
        int fq = fq_in; asm volatile("" : "+v"(fq));
        const int hc = u.pn, row0 = u.pm * 256 + wr * 64 + fr; const bool lat = u.pm < NLAT / 256;
        const __amdgpu_buffer_rsrc_t wsr = __builtin_amdgcn_make_buffer_rsrc((void*)ws, 0, (int)WS_END, 0x00020000);
        const float* ssq_ckv = (const float*)(ws + CTL_SSQ_OFF) + (size_t)(2 + l) * MTOT; LAS float* xch = xch_ptr();
        float r1v[8], skv[8];
#pragma unroll
        for (int i = 0; i < 8; ++i) { r1v[i] = ssq_ckv[row0 + (i >> 2) * 128 + (i & 3) * 16]; skv[i] = ((const float*)(ws + WS_SSQK))[row0 + (i >> 2) * 128 + (i & 3) * 16]; }
#pragma unroll
        for (int i = 0; i < 8; ++i) r1v[i] = __builtin_amdgcn_rsqf(r1v[i] * (1.0f / 512.0f) + EPS);
        if (wc < 2) {
#pragma unroll
        for (int ai = 0; ai < 2; ++ai)
#pragma unroll
            for (int m = 0; m < 4; ++m) {
                float r1 = r1v[ai * 4 + m]; asm volatile("" : "+v"(r1) :: "memory");
                { float s = 0.f;
#pragma unroll
                    for (int bj = 0; bj < 2; ++bj)
#pragma unroll
                        for (int n = 0; n < 2; ++n) { const f32x4 v = acc[ai][bj][m][n] * r1; s += (v[0] * v[0] + v[1] * v[1]) + (v[2] * v[2] + v[3] * v[3]); }
                    s = quad_sum(s); if (fq == 0) xch[(wr * 64 + ai * 128 + m * 16 + fr) * 4 + wc] = s; }
                __builtin_amdgcn_sched_barrier(0);
            }
        }
        asm volatile("s_waitcnt lgkmcnt(0)" ::: "memory"); __builtin_amdgcn_s_barrier(); asm volatile("" ::: "memory");
        if (wc == 3) {
#pragma unroll
            for (int ai = 0; ai < 2; ++ai)
#pragma unroll
                for (int m = 0; m < 4; ++m) { const int row = row0 + ai * 128 + m * 16; float y[16]; float r1 = r1v[ai * 4 + m]; asm volatile("" : "+v"(r1) :: "memory");
#pragma unroll
                    for (int bj = 0; bj < 2; ++bj)
#pragma unroll
                        for (int n = 0; n < 2; ++n)
#pragma unroll
                            for (int t = 0; t < 4; ++t) y[bj * 8 + n * 4 + t] = acc[ai][bj][m][n][t] * r1;
                    store16_bf16_wt(wsr, (unsigned)WS_VC + (unsigned)(row * 768 + hc * 128 + 64) * 2u, y, fq); __builtin_amdgcn_sched_barrier(0); }
            return;
        }
        float w[16];
#pragma unroll
        for (int bj = 0; bj < 2; ++bj)
#pragma unroll
            for (int n = 0; n < 2; ++n) { const f32x4 t4 = *(const f32x4*)(kn_c + wc * 64 + bj * 32 + fq * 8 + n * 4); w[bj * 8 + n * 4 + 0] = t4[0]; w[bj * 8 + n * 4 + 1] = t4[1]; w[bj * 8 + n * 4 + 2] = t4[2]; w[bj * 8 + n * 4 + 3] = t4[3]; }
        if (wc < 2) {
#pragma unroll
            for (int ai = 0; ai < 2; ++ai)
#pragma unroll
                for (int m = 0; m < 4; ++m) {
                    const int row = row0 + ai * 128 + m * 16; const f32x4 ps = *(const LAS f32x4*)(xch + (wr * 64 + ai * 128 + m * 16 + fr) * 4);
                    float rk = __builtin_amdgcn_rsqf((ps[0] + ps[1] + skv[ai * 4 + m]) * (1.0f / 192.0f) + EPS) * r1v[ai * 4 + m]; asm volatile("" : "+v"(rk) :: "memory"); float y[16];
#pragma unroll
                    for (int bj = 0; bj < 2; ++bj)
#pragma unroll
                        for (int n = 0; n < 2; ++n)
#pragma unroll
                            for (int t = 0; t < 4; ++t) y[bj * 8 + n * 4 + t] = acc[ai][bj][m][n][t] * rk * w[bj * 8 + n * 4 + t];
                    store16_bf16_wt(wsr, (unsigned)WS_KC + (unsigned)(row * 1152 + hc * 192 + wc * 64) * 2u, y, fq);
                    __builtin_amdgcn_sched_barrier(0);
                }
            return;
        }
#pragma unroll
        for (int ai = 0; ai < 2; ++ai)
#pragma unroll
            for (int m = 0; m < 4; ++m) { const int row = row0 + ai * 128 + m * 16; float y[16]; float r1 = r1v[ai * 4 + m]; asm volatile("" : "+v"(r1) :: "memory");
#pragma unroll
                for (int bj = 0; bj < 2; ++bj)
#pragma unroll
                    for (int n = 0; n < 2; ++n)
#pragma unroll
                        for (int t = 0; t < 4; ++t) y[bj * 8 + n * 4 + t] = acc[ai][bj][m][n][t] * r1;
                store16_bf16_wt(wsr, (unsigned)WS_VC + (unsigned)(row * 768 + hc * 128) * 2u, y, fq); __builtin_amdgcn_sched_barrier(0); }
#pragma unroll
        for (int hb = 0; hb < 2; ++hb) {
            u32x4 kr[4][2];
#pragma unroll
            for (int m = 0; m < 4; ++m)
#pragma unroll
                for (int bj = 0; bj < 2; ++bj) kr[m][bj] = *(const u32x4*)((const bf16_t*)(ws + WS_KPR) + (size_t)(row0 + hb * 128 + m * 16) * 64 + bj * 32 + fq * 8);
            __builtin_amdgcn_sched_barrier(0);
#pragma unroll
            for (int m = 0; m < 4; ++m) {
                const int row = row0 + hb * 128 + m * 16; const f32x4 ps = *(const LAS f32x4*)(xch + (wr * 64 + hb * 128 + m * 16 + fr) * 4);
                float rk = __builtin_amdgcn_rsqf((ps[0] + ps[1] + skv[hb * 4 + m]) * (1.0f / 192.0f) + EPS); asm volatile("" : "+v"(rk) :: "memory"); float y[16];
#pragma unroll
                for (int bj = 0; bj < 2; ++bj)
#pragma unroll
                    for (int j = 0; j < 4; ++j) { y[bj * 8 + 2 * j] = __uint_as_float(kr[m][bj][j] << 16) * rk; y[bj * 8 + 2 * j + 1] = __uint_as_float(kr[m][bj][j] & 0xffff0000u) * rk; }
                store16_bf16_wt(wsr, (unsigned)WS_KC + (unsigned)(row * 1152 + hc * 192 + 128) * 2u, y, fq);
                __builtin_amdgcn_sched_barrier(0);
            }
        }
    }
};
struct EpiOut {
    static constexpr bool PERM = true;
    unsigned char* ws; const float *xin, *cin; float* xout; int l;
    __device__ __forceinline__ void operator()(const Acc& acc, const pg8::Unit& u, int wr, int wc, int fr, int fq) const {
        const bool lat = u.pm < NLAT / 256; const int rowt = u.pm * 256 + wr * 64 + fr; const int b = lat ? (u.pm >> 3) : 8;
        const float* src = lat ? xin : cin; float* dst = lat ? xout : (float*)(ws + WS_XC1); const float* modl = (const float*)(ws + WS_MOD) + (size_t)l * 9 * 6144; const int rbase = lat ? rowt : rowt - NLAT;
        const int col0 = u.pn * 256 + wc * 64 + fq * 8; const float* gp = modl + (size_t)b * 6144 + 4096 + col0;
        f32x4 g[2][2];
#pragma unroll
        for (int bj = 0; bj < 2; ++bj)
#pragma unroll
            for (int n = 0; n < 2; ++n) g[bj][n] = *(const f32x4*)(gp + bj * 32 + n * 4);
        f32x4 xr[3][2][2];
#define XLD(slot_, i_) do { const size_t off_ = (size_t)(rbase + ((i_) >> 2) * 128 + ((i_) & 3) * 16) * 2048 + col0; \
            _Pragma("unroll") for (int bj = 0; bj < 2; ++bj) _Pragma("unroll") for (int n = 0; n < 2; ++n) xr[slot_][bj][n] = *(const f32x4*)(src + off_ + bj * 32 + n * 4); } while (0)
        XLD(0, 0); XLD(1, 1); XLD(2, 2);
        __builtin_amdgcn_sched_barrier(0);
#pragma unroll
        for (int i = 0; i < 8; ++i) { const int ai = i >> 2, m = i & 3; const size_t off = (size_t)(rbase + ai * 128 + m * 16) * 2048 + col0;
#pragma unroll
            for (int bj = 0; bj < 2; ++bj)
#pragma unroll
                for (int n = 0; n < 2; ++n) { const f32x4 v_ = xr[i % 3][bj][n] + g[bj][n] * acc[ai][bj][m][n];
                    if (lat) *(f32x4*)(dst + off + bj * 32 + n * 4) = v_;
                    else __builtin_amdgcn_raw_buffer_store_b128(__builtin_bit_cast(u32x4, v_), __builtin_amdgcn_make_buffer_rsrc((void*)ws, 0, (int)WS_END, 0x00020000), (unsigned)WS_XC1 + (unsigned)(off + bj * 32 + n * 4) * 4u, 0, 16); }
            __builtin_amdgcn_sched_barrier(0);
            if (i + 3 < 8) { XLD(i % 3, i + 3); __builtin_amdgcn_sched_barrier(0); }
        }
#undef XLD
    }
};

__device__ __forceinline__ int crow(int r, int hi) { return (r & 3) + 8 * (r >> 2) + 4 * hi; }
template <int OFF> __device__ __forceinline__ s16x4 tr_read(int vb) { s16x4 r; asm volatile("ds_read_b64_tr_b16 %0, %1 offset:%2" : "=&v"(r) : "v"(vb), "i"(OFF) : "memory"); return r; }
__device__ __forceinline__ int v_rd_base(int lane) { return ((lane & 3) << 3) | (((lane >> 2) & 3) << 6) | (((lane >> 4) & 1) << 5) | (((lane >> 5) & 1) << 8); }
template <int DV> __device__ __forceinline__ int v_st(int k, int c) { const int kk = (k & ~0xC) | ((k & 4) << 1) | ((k & 8) >> 1); return ((kk >> 3) * (DV / 32) + (c >> 5)) * 512 + ((kk & 7) * 32 + (c & 31)) * 2; }
typedef short v4i16_t __attribute__((ext_vector_type(4)));
__device__ __forceinline__ s16x4 vtr(const LAS char* p) { return __builtin_bit_cast(s16x4, __builtin_amdgcn_ds_read_tr16_b64_v4i16((LAS v4i16_t*)p)); }
template <int DV, int D0> __device__ __forceinline__ void pv_one(f32x16& od, int vb, bf16x8 pa0, bf16x8 pa1, bf16x8 pa2, bf16x8 pa3) {
    constexpr int KS = (DV / 32) * 1024, HF = (DV / 32) * 512;
    const s16x4 l0 = tr_read<D0 * 512 + 0 * KS>(vb), h0 = tr_read<D0 * 512 + 0 * KS + HF>(vb), l1 = tr_read<D0 * 512 + 1 * KS>(vb), h1 = tr_read<D0 * 512 + 1 * KS + HF>(vb);
    const s16x4 l2 = tr_read<D0 * 512 + 2 * KS>(vb), h2 = tr_read<D0 * 512 + 2 * KS + HF>(vb), l3 = tr_read<D0 * 512 + 3 * KS>(vb), h3 = tr_read<D0 * 512 + 3 * KS + HF>(vb);
    asm volatile("s_waitcnt lgkmcnt(0)" ::: "memory"); __builtin_amdgcn_sched_barrier(0);
#define PK(L, H) (bf16x8){L[0], L[1], L[2], L[3], H[0], H[1], H[2], H[3]}
    od = __builtin_amdgcn_mfma_f32_32x32x16_bf16(pa0, PK(l0, h0), od, 0, 0, 0);
    od = __builtin_amdgcn_mfma_f32_32x32x16_bf16(pa1, PK(l1, h1), od, 0, 0, 0);
    od = __builtin_amdgcn_mfma_f32_32x32x16_bf16(pa2, PK(l2, h2), od, 0, 0, 0);
    od = __builtin_amdgcn_mfma_f32_32x32x16_bf16(pa3, PK(l3, h3), od, 0, 0, 0);
#undef PK
}

enum { MK_NONE = 0, MK_NA = 1, MK_SWA = 2 };
struct AttnDesc {
    const bf16_t *Q, *Kc, *Vc, *Kl, *Vl;
    int ldq, ldk, ldv;
    int lt0, nlt;
    int mask;
    int q0;
    float m0, l0;
    const float* bias;
    const bf16_t* Z; bf16_t* Y;
};
constexpr float THRL = 8.0f;

template <int DQK, int DV>
__device__ __forceinline__ void attn_unit(const AttnDesc& d, LAS unsigned char* lds) {
    constexpr int KB_BYTES = 64 * DQK * 2, VB_BYTES = 64 * DV * 2, KCH = DQK / 8, VCH = DV / 8, NKL = KCH * 64 / 512, NVL = VCH * 64 / 512, ND0 = DQK / 16, NDV = DV / 32;
    constexpr int OFF_V = 2 * KB_BYTES, OFF_WS = OFF_V + 2 * VB_BYTES, OFF_BIAS = OFF_WS + 8 * 64 * 4;
    static_assert(OFF_BIAS + 2048 <= RING_BYTES, "attention LDS");
    const int tid = tid_opaque(), lane = tid & 63, r32 = lane & 31, hi = lane >> 5; const int wid = __builtin_amdgcn_readfirstlane(tid >> 6);
    LAS float* wsf = (LAS float*)(lds + OFF_WS) + wid * 64;
    LAS float* biasl = (LAS float*)(lds + OFF_BIAS);
    const int NT = 4 + d.nlt;
    int wlo = 0, whi = 0x7fffffff, wrow = 0;
    if (d.mask == MK_NA) { wrow = (d.q0 >> 6) + (wid >> 1); int rs = wrow - 4; rs = rs < 0 ? 0 : (rs > 24 ? 24 : rs); wlo = rs; whi = rs + 7; }
    else if (d.mask == MK_SWA) { const int qw = d.q0 + 32 * wid; wlo = (qw - 128) >> 6; whi = (qw + 31 + 128) >> 6; }
    if (d.mask == MK_NA) { for (int i = tid; i < 15 * 31; i += 512) biasl[i] = d.bias[i] * LOG2E; }
    bf16x8 qr[ND0];
    { const bf16_t* qp = d.Q + (size_t)(wid * 32 + r32) * d.ldq + hi * 8;
#pragma unroll
      for (int d0 = 0; d0 < ND0; ++d0) qr[d0] = *(const bf16x8*)(qp + d0 * 16); }
    float m_reg = d.m0, l_reg = d.l0; f32x16 o[NDV];
#pragma unroll
    for (int i = 0; i < NDV; ++i) o[i] = f32x16{};
    bf16x8 ks[NKL], vs[NVL];
    const int vb0 = (int)(unsigned)(size_t)(lds + OFF_V) + v_rd_base(lane);
#define TILE_K(t) ((t) < 4 ? d.Kc + (size_t)((t) * 64) * d.ldk : d.Kl + (size_t)((d.lt0 + (t) - 4) * 64) * d.ldk)
#define TILE_V(t) ((t) < 4 ? d.Vc + (size_t)((t) * 64) * d.ldv : d.Vl + (size_t)((d.lt0 + (t) - 4) * 64) * d.ldv)
#define SLOADK(t) do { const bf16_t* kp_ = TILE_K(t); \
      _Pragma("unroll") for (int i_ = 0; i_ < NKL; ++i_) { const int c_ = tid + 512 * i_; ks[i_] = *(const bf16x8*)(kp_ + (size_t)(c_ / KCH) * d.ldk + (c_ % KCH) * 8); } } while (0)
#define SLOADV(t) do { const bf16_t* vp_ = TILE_V(t); \
      _Pragma("unroll") for (int i_ = 0; i_ < NVL; ++i_) { const int c_ = tid + 512 * i_; vs[i_] = *(const bf16x8*)(vp_ + (size_t)(c_ / VCH) * d.ldv + (c_ % VCH) * 8); } } while (0)
#define SWRITEK(b) do { \
      _Pragma("unroll") for (int i_ = 0; i_ < NKL; ++i_) { const int c_ = tid + 512 * i_, row_ = c_ / KCH, ch_ = c_ % KCH; *(LAS bf16x8*)(lds + (b) * KB_BYTES + row_ * (DQK * 2) + ((ch_ * 16) ^ (((row_ >> 1) & 7) << 4))) = ks[i_]; } } while (0)
#define SWRITEV(b) do { \
      _Pragma("unroll") for (int i_ = 0; i_ < NVL; ++i_) { const int c_ = tid + 512 * i_; *(LAS bf16x8*)(lds + OFF_V + (b) * VB_BYTES + v_st<DV>(c_ / VCH, (c_ % VCH) * 8)) = vs[i_]; } } while (0)
    SLOADK(0); SLOADV(0); SWRITEK(0); SWRITEV(0); __syncthreads();
    for (int t = 0; t < NT; ++t) {
        const int buf = t & 1;
        if (t + 1 < NT) SLOADK(t + 1);
        const int lt = d.lt0 + t - 4;
        const bool active = (t < 4) || (lt >= wlo && lt <= whi);
        f32x16 p0 = f32x16{}, p1 = f32x16{};
        if (active) {
            { const LAS unsigned char* kb = lds + buf * KB_BYTES;
              const int sw = ((r32 >> 1) & 7) << 4;
#pragma unroll
              for (int d0 = 0; d0 < ND0; ++d0) { const int cb = (d0 * 16 + hi * 8) * 2;
                  const bf16x8 b0 = *(const LAS bf16x8*)(kb + r32 * (DQK * 2) + (cb ^ sw));
                  const bf16x8 b1 = *(const LAS bf16x8*)(kb + (32 + r32) * (DQK * 2) + (cb ^ sw));
                  p0 = __builtin_amdgcn_mfma_f32_32x32x16_bf16(b0, qr[d0], p0, 0, 0, 0);
                  p1 = __builtin_amdgcn_mfma_f32_32x32x16_bf16(b1, qr[d0], p1, 0, 0, 0); } }
        }
        if (t + 1 < NT) { SWRITEK(buf ^ 1); SLOADV(t + 1); }
        if (active) {
            if (t >= 4) {
                if (d.mask == MK_NA) {
                    const int c = (wid & 1) * 32 + r32; int qs = c - 8; qs = qs < 0 ? 0 : (qs > 48 ? 48 : qs);
                    const LAS float* brow = biasl + (lt - wrow + 7) * 31 + (15 - c);
#pragma unroll
                    for (int r = 0; r < 16; ++r) { const int k0 = crow(r, hi), k1 = k0 + 32;
                        p0[r] = (k0 >= qs && k0 < qs + 16) ? p0[r] + brow[k0] : -INFINITY;
                        p1[r] = (k1 >= qs && k1 < qs + 16) ? p1[r] + brow[k1] : -INFINITY; }
                } else if (d.mask == MK_SWA) {
                    const int qi = d.q0 + 32 * wid + r32, kbse = lt * 64;
#pragma unroll
                    for (int r = 0; r < 16; ++r) { const int k0 = kbse + crow(r, hi), k1 = k0 + 32; const int d0_ = qi - k0, d1_ = qi - k1;
                        if (d0_ > 128 || d0_ < -128) p0[r] = -INFINITY; if (d1_ > 128 || d1_ < -128) p1[r] = -INFINITY; }
                }
            }
            float pmax = p0[0];
#pragma unroll
            for (int r = 1; r < 16; ++r) pmax = fmaxf(pmax, p0[r]);
#pragma unroll
            for (int r = 0; r < 16; ++r) pmax = fmaxf(pmax, p1[r]);
            { auto rr = __builtin_amdgcn_permlane32_swap(__float_as_uint(pmax), __float_as_uint(pmax), false, false); pmax = fmaxf(__uint_as_float(rr[0]), __uint_as_float(rr[1])); }
            float alpha = 1.f;
            if (!__all(pmax - m_reg <= THRL)) { const float mn = fmaxf(m_reg, pmax); alpha = __builtin_amdgcn_exp2f(m_reg - mn); m_reg = mn;
                if (hi == 0) wsf[r32] = alpha; asm volatile("s_waitcnt lgkmcnt(0)" ::: "memory");
#pragma unroll
                for (int dd = 0; dd < NDV; ++dd)
#pragma unroll
                    for (int r = 0; r < 16; ++r) o[dd][r] *= wsf[crow(r, hi)]; }
            float ps = 0.f;
#pragma unroll
            for (int r = 0; r < 16; ++r) { p0[r] = __builtin_amdgcn_exp2f(p0[r] - m_reg); p1[r] = __builtin_amdgcn_exp2f(p1[r] - m_reg); ps += p0[r] + p1[r]; }
            { auto rr = __builtin_amdgcn_permlane32_swap(__float_as_uint(ps), __float_as_uint(ps), false, false); ps = __uint_as_float(rr[0]) + __uint_as_float(rr[1]); }
            l_reg = l_reg * alpha + ps;
            bf16x8 pa0, pa1, pa2, pa3;
#define PK4(P, BASE, OUT) do { unsigned a0 = cvt_pk_bf16(P[BASE + 0], P[BASE + 1]), a1 = cvt_pk_bf16(P[BASE + 2], P[BASE + 3]); \
    unsigned b0_ = cvt_pk_bf16(P[BASE + 4], P[BASE + 5]), b1_ = cvt_pk_bf16(P[BASE + 6], P[BASE + 7]); \
    auto r0 = __builtin_amdgcn_permlane32_swap(a0, b0_, false, false); auto r1 = __builtin_amdgcn_permlane32_swap(a1, b1_, false, false); \
    u32x4 w_ = {r0[0], r1[0], r0[1], r1[1]}; OUT = __builtin_bit_cast(bf16x8, w_); } while (0)
            PK4(p0, 0, pa0); PK4(p0, 8, pa1); PK4(p1, 0, pa2); PK4(p1, 8, pa3);
#undef PK4
            const int vb = vb0 + buf * VB_BYTES;
            pv_one<DV, 0>(o[0], vb, pa0, pa1, pa2, pa3); pv_one<DV, 1>(o[1], vb, pa0, pa1, pa2, pa3);
            if constexpr (NDV == 4) { pv_one<DV, 2>(o[2], vb, pa0, pa1, pa2, pa3); pv_one<DV, 3>(o[3], vb, pa0, pa1, pa2, pa3); }
        }
        if (t + 1 < NT) SWRITEV(buf ^ 1);
        __syncthreads();
    }
    if (hi == 0) wsf[r32] = l_reg; asm volatile("s_waitcnt lgkmcnt(0)" ::: "memory");
    float rli[16];
#pragma unroll
    for (int r = 0; r < 16; ++r) rli[r] = __builtin_amdgcn_rcpf(wsf[crow(r, hi)]);
#pragma unroll
    for (int r = 0; r < 16; ++r) { const size_t off = (size_t)(wid * 32 + crow(r, hi)) * 2048 + r32;
#pragma unroll
        for (int dd = 0; dd < NDV; ++dd) { const float z = bf2f(d.Z[off + dd * 32]); const float v = o[dd][r] * rli[r] * z; d.Y[off + dd * 32] = (bf16_t)(cvt_pk_bf16(v, v) & 0xffffu); } }
    __syncthreads();
#undef TILE_K
#undef TILE_V
#undef SLOADK
#undef SLOADV
#undef SWRITEK
#undef SWRITEV
}


#ifndef A_ZPRE
#define A_ZPRE 1
#endif
#ifndef A_NOVMW
#define A_NOVMW 1
#endif
#ifndef A_DMAF
#define A_DMAF 2
#endif
#ifndef ATT_NSLOT64
#define ATT_NSLOT64 4
#endif
#define WAITV(n) asm volatile("s_waitcnt vmcnt(" #n ")" ::: "memory")
template <int DQK, int DV>
__device__ __forceinline__ void attn_unit2(const AttnDesc& d, float mshift, LAS unsigned char* lds, unsigned q_next = 0u, bool q_pub = false) {
    constexpr int KB_BYTES = 64 * DQK * 2, VB_BYTES = 64 * DV * 2, SLOT = KB_BYTES + VB_BYTES, NSLOT = (DQK == 64) ? ATT_NSLOT64 : 3, DIST = NSLOT - 1;
    constexpr int KCH = DQK / 8, KI = KB_BYTES / 8192, VI = VB_BYTES / 8192, IPW = KI + VI, ND0 = DQK / 16, NDV = DV / 32, VSUB = DV / 32;
    constexpr int OFF_WS = 122880, OFF_TAB = OFF_WS + 2048; constexpr bool MASKS = (DQK == 64);
    static_assert(NSLOT * SLOT <= OFF_WS && OFF_TAB + 15 * 128 * 4 <= ATT_LDS_END && 8 * 32 * DV * 2 <= NSLOT * SLOT, "attention LDS");
    const int tid = tid_opaque(), lane = tid & 63, r32 = lane & 31, hi = lane >> 5; const int wid = __builtin_amdgcn_readfirstlane(tid >> 6);
    LAS float* wsf = (LAS float*)(lds + OFF_WS) + wid * 64;
    LAS float* tab = (LAS float*)(lds + OFF_TAB);
    const int NT = 4 + d.nlt;
    int wlo = 0, whi = 0x7fffffff, wrow = 0;
    if (MASKS && d.mask == MK_NA) { wrow = (d.q0 >> 6) + (wid >> 1); int rs = wrow - 4; rs = rs < 0 ? 0 : (rs > 24 ? 24 : rs); wlo = rs; whi = rs + 7; }
    else if (MASKS && d.mask == MK_SWA) { const int qw = d.q0 + 32 * wid; wlo = (qw - 128) >> 6; whi = (qw + 31 + 128) >> 6; }
    const float negm = -mshift;
    bf16x8 qr[ND0];
    { const bf16_t* qp = d.Q + (size_t)(wid * 32 + r32) * d.ldq + hi * 8;
#pragma unroll
      for (int d0 = 0; d0 < ND0; ++d0) qr[d0] = *(const bf16x8*)(qp + d0 * 16); }
    if (MASKS && d.mask == MK_NA) { for (int i = tid; i < 15 * 128; i += 512) { const int dr = i >> 7, dc = (i & 127) - 63; tab[i] = ((dc >= -15 && dc <= 15) ? d.bias[dr * 31 + dc + 15] * LOG2E : 0.f) + negm; } }
    else if (MASKS && d.mask == MK_SWA) { for (int i = tid; i < 512; i += 512) { const int dx = i - 256; tab[i] = (dx >= -128 && dx <= 128) ? negm : -INFINITY; } }
    unsigned koff[KI], voff[VI];
#pragma unroll
    for (int i = 0; i < KI; ++i) { const int P = (wid * KI + i) * 64 + lane, row = P / KCH, cp = P % KCH; koff[i] = (unsigned)(row * d.ldk + ((cp ^ ((row >> 1) & 7)) * 8)); }
#pragma unroll
    for (int i = 0; i < VI; ++i) { const int P = (wid * VI + i) * 64 + lane, st = P >> 5, kk = (st / VSUB) * 8 + ((P >> 2) & 7), c = (st % VSUB) * 32 + (P & 3) * 8;
        const int k = (kk & ~0xC) | ((kk & 4) << 1) | ((kk & 8) >> 1); voff[i] = (unsigned)(k * d.ldv + c); }
#pragma unroll
    for (int i = 0; i < KI; ++i) asm volatile("" : "+v"(koff[i]));
#pragma unroll
    for (int i = 0; i < VI; ++i) asm volatile("" : "+v"(voff[i]));
#define TILE_K(t) ((t) < 4 ? d.Kc + (size_t)((t) * 64) * d.ldk : d.Kl + (size_t)((d.lt0 + (t) - 4) * 64) * d.ldk)
#define TILE_V(t) ((t) < 4 ? d.Vc + (size_t)((t) * 64) * d.ldv : d.Vl + (size_t)((d.lt0 + (t) - 4) * 64) * d.ldv)
#define DMA_TILE(t, sl) do { const bf16_t* kp_ = TILE_K(t); const bf16_t* vp_ = TILE_V(t); LAS unsigned char* sb_ = lds + (sl) * SLOT; \
      _Pragma("unroll") for (int i_ = 0; i_ < KI; ++i_) __builtin_amdgcn_global_load_lds((const unsigned*)(kp_ + koff[i_]), (LAS unsigned*)(sb_ + (wid * KI + i_) * 1024), 16, 0, 0); \
      _Pragma("unroll") for (int i_ = 0; i_ < VI; ++i_) __builtin_amdgcn_global_load_lds((const unsigned*)(vp_ + voff[i_]), (LAS unsigned*)(sb_ + KB_BYTES + (wid * VI + i_) * 1024), 16, 0, 0); } while (0)
#pragma unroll
    for (int d0 = 0; d0 < ND0; ++d0) asm volatile("" : "+v"(qr[d0]));
#pragma unroll
    for (int t = 0; t < DIST; ++t) if (t < NT) DMA_TILE(t, t);
    f32x16 vm0 = f32x16{}, vm1 = f32x16{};
    const int ccol = (wid & 1) * 32 + r32;
    if (MASKS && d.mask == MK_NA) { int qs = ccol - 8; qs = qs < 0 ? 0 : (qs > 48 ? 48 : qs);
#pragma unroll
        for (int r = 0; r < 16; ++r) { const int k0 = crow(r, hi), k1 = k0 + 32; vm0[r] = (k0 >= qs && k0 < qs + 16) ? 0.f : -INFINITY; vm1[r] = (k1 >= qs && k1 < qs + 16) ? 0.f : -INFINITY; } }
    float l_reg = (hi == 0 && d.l0 != 0.f) ? __builtin_amdgcn_exp2f(d.m0 - mshift) : 0.f; f32x16 o[NDV];
#pragma unroll
    for (int i = 0; i < NDV; ++i) o[i] = f32x16{};
    int slot = 0;
    for (int t = 0; t < NT; ++t) {
        if constexpr (IPW == 2) {
            const int rem = NT - 1 - t;
            if (DIST >= 6 && rem >= 5) WAITV(10); else if (DIST >= 5 && rem >= 4) WAITV(8); else if (DIST >= 4 && rem >= 3) WAITV(6); else if (DIST >= 3 && rem >= 2) WAITV(4); else if (rem >= 1) WAITV(2); else WAITV(0);
        } else { if (t + 1 < NT) WAITV(5); else WAITV(0); }
        asm volatile("s_waitcnt lgkmcnt(0)" ::: "memory"); __builtin_amdgcn_s_barrier(); asm volatile("" ::: "memory");
        if (t + DIST < NT) { int sn = slot + DIST; sn = sn >= NSLOT ? sn - NSLOT : sn; DMA_TILE(t + DIST, sn); }
        const int lt = d.lt0 + t - 4;
        const bool active = (t < 4) || (lt >= wlo && lt <= whi);
        if (active) {
            f32x16 p0, p1;
            if (MASKS && t >= 4 && d.mask == MK_NA) {
                const LAS float* bp = tab + (lt - wrow + 7) * 128 + (63 - ccol + 4 * hi);
#pragma unroll
                for (int r = 0; r < 16; ++r) { p0[r] = vm0[r] + bp[(r & 3) + 8 * (r >> 2)]; p1[r] = vm1[r] + bp[32 + (r & 3) + 8 * (r >> 2)]; }
            } else if (MASKS && t >= 4 && d.mask == MK_SWA && !((lt * 64 + 63 - (d.q0 + 32 * wid) <= 128) && (d.q0 + 32 * wid + 31 - lt * 64 <= 128))) {
                const LAS float* bp = tab + (lt * 64 + 4 * hi - (d.q0 + 32 * wid + r32) + 256);
#pragma unroll
                for (int r = 0; r < 16; ++r) { p0[r] = bp[(r & 3) + 8 * (r >> 2)]; p1[r] = bp[32 + (r & 3) + 8 * (r >> 2)]; }
            } else {
#pragma unroll
                for (int r = 0; r < 16; ++r) { p0[r] = negm; p1[r] = negm; }
            }
            { const LAS unsigned char* kb = lds + slot * SLOT; const int sw = ((r32 >> 1) & 7) << 4;
              const LAS unsigned char* kr0 = kb + r32 * (DQK * 2); int cbj[4]; (void)sw;
#pragma unroll
              for (int j = 0; j < 4; ++j) cbj[j] = ((2 * j + hi) ^ ((r32 >> 1) & 7)) << 4;
#define KLD(dst, d0_) do { dst[0] = *(const LAS bf16x8*)(kr0 + cbj[(d0_) & 3] + ((d0_) >> 2) * 128); dst[1] = *(const LAS bf16x8*)(kr0 + cbj[(d0_) & 3] + ((d0_) >> 2) * 128 + 32 * DQK * 2); } while (0)
#define KMM(src, d0_) do { p0 = __builtin_amdgcn_mfma_f32_32x32x16_bf16(src[0], qr[d0_], p0, 0, 0, 0); p1 = __builtin_amdgcn_mfma_f32_32x32x16_bf16(src[1], qr[d0_], p1, 0, 0, 0); } while (0)
              if constexpr (ND0 == 4) { bf16x8 kfa[4][2];
#pragma unroll
                  for (int j = 0; j < 4; ++j) KLD(kfa[j], j);
                  __builtin_amdgcn_sched_barrier(0);
#pragma unroll
                  for (int j = 0; j < 4; ++j) KMM(kfa[j], j);
              } else {
                  bf16x8 kfa[2], kfb[2];
                  KLD(kfa, 0);
#pragma unroll
                  for (int g = 0; g < ND0 / 2; ++g) {
                      KLD(kfb, 2 * g + 1); __builtin_amdgcn_sched_barrier(0);
                      KMM(kfa, 2 * g); __builtin_amdgcn_sched_barrier(0);
                      if (g + 1 < ND0 / 2) { KLD(kfa, 2 * g + 2); __builtin_amdgcn_sched_barrier(0); }
                      KMM(kfb, 2 * g + 1); __builtin_amdgcn_sched_barrier(0);
                  }
              }
#undef KLD
#undef KMM
            }
            __builtin_amdgcn_sched_barrier(0);
            const int vpb = (int)(unsigned)(size_t)(lds + slot * SLOT + KB_BYTES) + v_rd_base(lane);
            constexpr int KS_ = (DV / 32) * 1024, HF_ = (DV / 32) * 512, NPRE = (DQK == 64) ? 2 : 1;
            s16x4 vl[NDV][4], vh[NDV][4];
#define VLD(dd_) do { vl[dd_][0] = tr_read<(dd_) * 512 + 0 * KS_>(vpb); vh[dd_][0] = tr_read<(dd_) * 512 + 0 * KS_ + HF_>(vpb); vl[dd_][1] = tr_read<(dd_) * 512 + 1 * KS_>(vpb); vh[dd_][1] = tr_read<(dd_) * 512 + 1 * KS_ + HF_>(vpb); \
      vl[dd_][2] = tr_read<(dd_) * 512 + 2 * KS_>(vpb); vh[dd_][2] = tr_read<(dd_) * 512 + 2 * KS_ + HF_>(vpb); vl[dd_][3] = tr_read<(dd_) * 512 + 3 * KS_>(vpb); vh[dd_][3] = tr_read<(dd_) * 512 + 3 * KS_ + HF_>(vpb); } while (0)
            VLD(0); if constexpr (NPRE == 2) VLD(1);
            __builtin_amdgcn_sched_barrier(0);
            float ps = 0.f;
#pragma unroll
            for (int r = 0; r < 16; ++r) { p0[r] = __builtin_amdgcn_exp2f(p0[r]); p1[r] = __builtin_amdgcn_exp2f(p1[r]); ps += p0[r] + p1[r]; }
            l_reg += ps;
            bf16x8 pa0, pa1, pa2, pa3;
#define PK4(P, BASE, OUT) do { unsigned a0 = cvt_pk_bf16(P[BASE + 0], P[BASE + 1]), a1 = cvt_pk_bf16(P[BASE + 2], P[BASE + 3]); \
    unsigned b0_ = cvt_pk_bf16(P[BASE + 4], P[BASE + 5]), b1_ = cvt_pk_bf16(P[BASE + 6], P[BASE + 7]); \
    auto r0 = __builtin_amdgcn_permlane32_swap(a0, b0_, false, false); auto r1 = __builtin_amdgcn_permlane32_swap(a1, b1_, false, false); \
    u32x4 w_ = {r0[0], r1[0], r0[1], r1[1]}; OUT = __builtin_bit_cast(bf16x8, w_); } while (0)
            PK4(p0, 0, pa0); PK4(p0, 8, pa1); PK4(p1, 0, pa2); PK4(p1, 8, pa3);
#undef PK4
            __builtin_amdgcn_sched_barrier(0);
#define VFR(L, H) (bf16x8){L[0], L[1], L[2], L[3], H[0], H[1], H[2], H[3]}
#define PVMM(od, dd_) do { od = __builtin_amdgcn_mfma_f32_32x32x16_bf16(pa0, VFR(vl[dd_][0], vh[dd_][0]), od, 0, 0, 0); od = __builtin_amdgcn_mfma_f32_32x32x16_bf16(pa1, VFR(vl[dd_][1], vh[dd_][1]), od, 0, 0, 0); \
      od = __builtin_amdgcn_mfma_f32_32x32x16_bf16(pa2, VFR(vl[dd_][2], vh[dd_][2]), od, 0, 0, 0); od = __builtin_amdgcn_mfma_f32_32x32x16_bf16(pa3, VFR(vl[dd_][3], vh[dd_][3]), od, 0, 0, 0); } while (0)
#define VWAIT() do { asm volatile("s_waitcnt lgkmcnt(0)" ::: "memory"); __builtin_amdgcn_sched_barrier(0); } while (0)
            VWAIT();
            if constexpr (NDV == 2) { PVMM(o[0], 0); PVMM(o[1], 1); }
            else { PVMM(o[0], 0); __builtin_amdgcn_sched_barrier(0); VLD(1); VWAIT(); PVMM(o[1], 1); __builtin_amdgcn_sched_barrier(0); VLD(2); VWAIT(); PVMM(o[2], 2); __builtin_amdgcn_sched_barrier(0); VLD(3); VWAIT(); PVMM(o[3], 3); }
            __builtin_amdgcn_sched_barrier(0);
#undef VWAIT
#undef PVMM
#undef VFR
#undef VLD
        }
        slot = slot + 1 == NSLOT ? 0 : slot + 1;
    }
    if (q_pub) ((volatile LAS unsigned*)(lds + LDSCTL_OFF))[16] = q_next;
    const int tid_e = tid_opaque(), lane_e = tid_e & 63, r32_e = lane_e & 31, hi_e = lane_e >> 5; (void)r32_e;
    constexpr int CPR = DV / 8, RPI = 64 / CPR;
#if A_ZPRE
    u32x4 zpre[32 / RPI];
#pragma unroll
    for (int i = 0; i < 32 / RPI; ++i) { const int row = i * RPI + lane_e / CPR, ch = lane_e % CPR; zpre[i] = *(const u32x4*)(d.Z + (size_t)(wid * 32 + row) * 2048 + ch * 8); }
#endif
    { auto rr = __builtin_amdgcn_permlane32_swap(__float_as_uint(l_reg), __float_as_uint(l_reg), false, false); l_reg = __uint_as_float(rr[0]) + __uint_as_float(rr[1]); }
    if (hi_e == 0) ((LAS float*)(lds + OFF_WS) + wid * 64)[r32_e] = l_reg;
    asm volatile("s_waitcnt lgkmcnt(0)" ::: "memory"); __builtin_amdgcn_s_barrier(); asm volatile("" ::: "memory");
    float rli[16];
#pragma unroll
    for (int r = 0; r < 16; ++r) rli[r] = __builtin_amdgcn_rcpf(((LAS float*)(lds + OFF_WS) + wid * 64)[crow(r, hi_e)]);
    LAS bf16_t* stg = (LAS bf16_t*)(lds + wid * (32 * DV * 2));
#pragma unroll
    for (int r = 0; r < 16; ++r) { const int orow = crow(r, hi_e);
#pragma unroll
        for (int dd = 0; dd < NDV; ++dd) { const float v = o[dd][r] * rli[r]; stg[orow * DV + dd * 32 + r32_e] = (bf16_t)(cvt_pk_bf16(v, v) & 0xffffu); } }
    asm volatile("s_waitcnt lgkmcnt(0)" ::: "memory");
#pragma unroll
    for (int i = 0; i < 32 / RPI; ++i) { const int row = i * RPI + lane_e / CPR, ch = lane_e % CPR; const size_t off = (size_t)(wid * 32 + row) * 2048 + ch * 8;
        const u32x4 ov = *(const LAS u32x4*)(stg + row * DV + ch * 8);
#if A_ZPRE
        const u32x4 zv = zpre[i];
#else
        const u32x4 zv = *(const u32x4*)(d.Z + off);
#endif
        u32x4 yv;
#pragma unroll
        for (int j = 0; j < 4; ++j) { const float a0 = __uint_as_float(ov[j] << 16) * __uint_as_float(zv[j] << 16), a1 = __uint_as_float(ov[j] & 0xffff0000u) * __uint_as_float(zv[j] & 0xffff0000u); yv[j] = cvt_pk_bf16(a0, a1); }
        *(u32x4*)(d.Y + off) = yv; }
#if A_NOVMW
    asm volatile("s_waitcnt lgkmcnt(0)" ::: "memory"); __builtin_amdgcn_s_barrier(); asm volatile("" ::: "memory");
#else
    asm volatile("s_waitcnt vmcnt(0) lgkmcnt(0)" ::: "memory"); __builtin_amdgcn_s_barrier(); asm volatile("" ::: "memory");
#endif
#undef TILE_K
#undef TILE_V
#undef DMA_TILE
}

__device__ __forceinline__ void attn_unit64(const AttnDesc& d, LAS unsigned char* lds, unsigned q_next = 0u, bool q_pub = false) {
    constexpr int TB = 8192, SLOT = 4 * TB, NSLOT = 3, DIST = 2, OFF_WS = 122880, OFF_TAB = OFF_WS + 2048;
    static_assert(NSLOT * SLOT <= OFF_WS, "attention LDS");
    const int tid = tid_opaque(), lane = tid & 63, r32 = lane & 31, hi = lane >> 5; const int wid = __builtin_amdgcn_readfirstlane(tid >> 6);
    LAS float* tab = (LAS float*)(lds + OFF_TAB);
    const int NT = 4 + d.nlt, NP = (NT + 1) >> 1;
    int wlo = 0, whi = 0x7fffffff, wrow = 0;
    if (d.mask == MK_NA) { wrow = (d.q0 >> 6) + (wid >> 1); int rs = wrow - 4; rs = rs < 0 ? 0 : (rs > 24 ? 24 : rs); wlo = rs; whi = rs + 7; }
    else if (d.mask == MK_SWA) { const int qw = d.q0 + 32 * wid; wlo = (qw - 128) >> 6; whi = (qw + 31 + 128) >> 6; }
    unsigned koff, voff;
    { const int P = wid * 64 + lane, row = P >> 3, cp = P & 7; koff = (unsigned)(row * d.ldk + ((cp ^ ((row >> 1) & 7)) * 8));
      const int st = P >> 5, kk = (st >> 1) * 8 + ((P >> 2) & 7), c = (st & 1) * 32 + (P & 3) * 8, k = (kk & ~0xC) | ((kk & 4) << 1) | ((kk & 8) >> 1); voff = (unsigned)(k * d.ldv + c); }
    asm volatile("" : "+v"(koff)); asm volatile("" : "+v"(voff));
#define TILE_K(t) ((t) < 4 ? d.Kc + (size_t)((t) * 64) * d.ldk : d.Kl + (size_t)((d.lt0 + (t) - 4) * 64) * d.ldk)
#define TILE_V(t) ((t) < 4 ? d.Vc + (size_t)((t) * 64) * d.ldv : d.Vl + (size_t)((d.lt0 + (t) - 4) * 64) * d.ldv)
#define DMA1(t, off_) do { const int t_ = (t) < NT ? (t) : NT - 1; const bf16_t* kp_ = TILE_K(t_); const bf16_t* vp_ = TILE_V(t_); \
      __builtin_amdgcn_global_load_lds((const unsigned*)(kp_ + koff), (LAS unsigned*)(lds + (off_) + wid * 1024), 16, 0, 0); \
      __builtin_amdgcn_global_load_lds((const unsigned*)(vp_ + voff), (LAS unsigned*)(lds + (off_) + TB + wid * 1024), 16, 0, 0); } while (0)
#define DMA_PAIR(s_, sl) do { DMA1(2 * (s_), (sl) * SLOT); DMA1(2 * (s_) + 1, (sl) * SLOT + 2 * TB); } while (0)
#if A_DMAF >= 1
    DMA_PAIR(0, 0);
#endif
#if A_DMAF >= 2
    if (NP > 1) DMA_PAIR(1, 1);
#endif
    bf16x8 qr[4];
    { const bf16_t* qp = d.Q + (size_t)(wid * 32 + r32) * d.ldq + hi * 8;
#pragma unroll
      for (int d0 = 0; d0 < 4; ++d0) qr[d0] = *(const bf16x8*)(qp + d0 * 16); }
    if (d.mask == MK_NA) { for (int i = tid; i < 15 * 128; i += 512) { const int dr = i >> 7, dc = (i & 127) - 63; tab[i] = (dc >= -15 && dc <= 15) ? d.bias[dr * 31 + dc + 15] * LOG2E : 0.f; } }
    else if (d.mask == MK_SWA) { for (int i = tid; i < 512; i += 512) { const int dx = i - 256; tab[i] = (dx >= -128 && dx <= 128) ? 0.f : -INFINITY; } }
#pragma unroll
    for (int d0 = 0; d0 < 4; ++d0) asm volatile("" : "+v"(qr[d0]));
#if A_DMAF < 1
    DMA_PAIR(0, 0);
#endif
#if A_DMAF < 2
    if (NP > 1) DMA_PAIR(1, 1);
#endif
    f32x16 vm0 = f32x16{}, vm1 = f32x16{};
    const int ccol = (wid & 1) * 32 + r32;
    if (d.mask == MK_NA) { int qs = ccol - 8; qs = qs < 0 ? 0 : (qs > 48 ? 48 : qs);
#pragma unroll
        for (int r = 0; r < 16; ++r) { const int k0 = crow(r, hi), k1 = k0 + 32; vm0[r] = (k0 >= qs && k0 < qs + 16) ? 0.f : -INFINITY; vm1[r] = (k1 >= qs && k1 < qs + 16) ? 0.f : -INFINITY; } }
    float l_reg = (hi == 0 && d.l0 != 0.f) ? __builtin_amdgcn_exp2f(d.m0) : 0.f; f32x16 o[2];
    o[0] = f32x16{}; o[1] = f32x16{};
    const int swz = ((r32 >> 1) & 7) << 4; int cbj[4];
#pragma unroll
    for (int j = 0; j < 4; ++j) cbj[j] = ((2 * j + hi) << 4) ^ swz;
    int slot = 0;
#define PINIT(P0, P1, t_, lt_) do { \
        if ((t_) >= 4 && d.mask == MK_NA) { const LAS float* bp_ = tab + ((lt_) - wrow + 7) * 128 + (63 - ccol + 4 * hi); \
            _Pragma("unroll") for (int r = 0; r < 16; ++r) { P0[r] = vm0[r] + bp_[(r & 3) + 8 * (r >> 2)]; P1[r] = vm1[r] + bp_[32 + (r & 3) + 8 * (r >> 2)]; } } \
        else if ((t_) >= 4 && d.mask == MK_SWA && !(((lt_) * 64 + 63 - (d.q0 + 32 * wid) <= 128) && (d.q0 + 32 * wid + 31 - (lt_) * 64 <= 128))) { const LAS float* bp_ = tab + ((lt_) * 64 + 4 * hi - (d.q0 + 32 * wid + r32) + 256); \
            _Pragma("unroll") for (int r = 0; r < 16; ++r) { P0[r] = bp_[(r & 3) + 8 * (r >> 2)]; P1[r] = bp_[32 + (r & 3) + 8 * (r >> 2)]; } } \
        else { _Pragma("unroll") for (int r = 0; r < 16; ++r) { P0[r] = 0.f; P1[r] = 0.f; } } } while (0)
#define KLD4(KF, base_) do { _Pragma("unroll") for (int j = 0; j < 4; ++j) { KF[j][0] = *(const LAS bf16x8*)((base_) + r32 * 128 + cbj[j]); KF[j][1] = *(const LAS bf16x8*)((base_) + r32 * 128 + cbj[j] + 4096); } } while (0)
#define QK4(P0, P1, KF) do { _Pragma("unroll") for (int j = 0; j < 4; ++j) { P0 = __builtin_amdgcn_mfma_f32_32x32x16_bf16(KF[j][0], qr[j], P0, 0, 0, 0); P1 = __builtin_amdgcn_mfma_f32_32x32x16_bf16(KF[j][1], qr[j], P1, 0, 0, 0); } } while (0)
#define VLD2(VL, VH, vb_) do { \
        VL[0][0] = tr_read<0>(vb_); VH[0][0] = tr_read<1024>(vb_); VL[0][1] = tr_read<2048>(vb_); VH[0][1] = tr_read<3072>(vb_); VL[0][2] = tr_read<4096>(vb_); VH[0][2] = tr_read<5120>(vb_); VL[0][3] = tr_read<6144>(vb_); VH[0][3] = tr_read<7168>(vb_); \
        VL[1][0] = tr_read<512>(vb_); VH[1][0] = tr_read<1536>(vb_); VL[1][1] = tr_read<2560>(vb_); VH[1][1] = tr_read<3584>(vb_); VL[1][2] = tr_read<4608>(vb_); VH[1][2] = tr_read<5632>(vb_); VL[1][3] = tr_read<6656>(vb_); VH[1][3] = tr_read<7680>(vb_); } while (0)
#define SMAX(P0, P1, PA) do { float ps_ = 0.f; \
        _Pragma("unroll") for (int r = 0; r < 16; ++r) { P0[r] = __builtin_amdgcn_exp2f(P0[r]); P1[r] = __builtin_amdgcn_exp2f(P1[r]); ps_ += P0[r] + P1[r]; } l_reg += ps_; \
        _Pragma("unroll") for (int g_ = 0; g_ < 4; ++g_) { const int B_ = (g_ & 1) * 8; \
            const unsigned a0_ = (g_ < 2) ? cvt_pk_bf16(P0[B_ + 0], P0[B_ + 1]) : cvt_pk_bf16(P1[B_ + 0], P1[B_ + 1]), a1_ = (g_ < 2) ? cvt_pk_bf16(P0[B_ + 2], P0[B_ + 3]) : cvt_pk_bf16(P1[B_ + 2], P1[B_ + 3]); \
            const unsigned b0_ = (g_ < 2) ? cvt_pk_bf16(P0[B_ + 4], P0[B_ + 5]) : cvt_pk_bf16(P1[B_ + 4], P1[B_ + 5]), b1_ = (g_ < 2) ? cvt_pk_bf16(P0[B_ + 6], P0[B_ + 7]) : cvt_pk_bf16(P1[B_ + 6], P1[B_ + 7]); \
            auto r0_ = __builtin_amdgcn_permlane32_swap(a0_, b0_, false, false); auto r1_ = __builtin_amdgcn_permlane32_swap(a1_, b1_, false, false); \
            u32x4 w_ = {r0_[0], r1_[0], r0_[1], r1_[1]}; PA[g_] = __builtin_bit_cast(bf16x8, w_); } } while (0)
#define VFR(L, H) (bf16x8){L[0], L[1], L[2], L[3], H[0], H[1], H[2], H[3]}
#define PV2(PA, VL, VH) do { _Pragma("unroll") for (int dd = 0; dd < 2; ++dd) _Pragma("unroll") for (int ks = 0; ks < 4; ++ks) o[dd] = __builtin_amdgcn_mfma_f32_32x32x16_bf16(PA[ks], VFR(VL[dd][ks], VH[dd][ks]), o[dd], 0, 0, 0); } while (0)
#define LWAIT() do { asm volatile("s_waitcnt lgkmcnt(0)" ::: "memory"); __builtin_amdgcn_sched_barrier(0); } while (0)
    for (int s = 0; s < NP; ++s) {
        if (s + 1 < NP) WAITV(4); else WAITV(0);
        asm volatile("s_waitcnt lgkmcnt(0)" ::: "memory"); __builtin_amdgcn_s_barrier(); asm volatile("" ::: "memory");
        if (s + DIST < NP) { int sn = slot + DIST; sn = sn >= NSLOT ? sn - NSLOT : sn; DMA_PAIR(s + DIST, sn); }
        const int ta = 2 * s, tb = 2 * s + 1, lta = d.lt0 + ta - 4, ltb = lta + 1;
        const bool acta = (ta < 4) || (lta >= wlo && lta <= whi), actb = (tb < NT) && ((tb < 4) || (ltb >= wlo && ltb <= whi));
        const LAS unsigned char* sb = lds + slot * SLOT;
        const int vba = (int)(unsigned)(size_t)(sb + TB) + v_rd_base(lane), vbb = vba + 2 * TB;
        f32x16 pa0, pa1, pb0, pb1; bf16x8 kf[4][2];
        if (acta) { PINIT(pa0, pa1, ta, lta); KLD4(kf, sb); __builtin_amdgcn_sched_barrier(0); QK4(pa0, pa1, kf); }
        __builtin_amdgcn_sched_barrier(0);
        if (actb) { PINIT(pb0, pb1, tb, ltb); KLD4(kf, sb + 2 * TB); __builtin_amdgcn_sched_barrier(0); QK4(pb0, pb1, kf); }
        __builtin_amdgcn_sched_barrier(0);
        s16x4 vl[2][4], vh[2][4]; bf16x8 qp[4];
        if (acta) { VLD2(vl, vh, vba); __builtin_amdgcn_sched_barrier(0); SMAX(pa0, pa1, qp); __builtin_amdgcn_sched_barrier(0); LWAIT(); PV2(qp, vl, vh); }
        __builtin_amdgcn_sched_barrier(0);
        if (actb) { VLD2(vl, vh, vbb); __builtin_amdgcn_sched_barrier(0); SMAX(pb0, pb1, qp); __builtin_amdgcn_sched_barrier(0); LWAIT(); PV2(qp, vl, vh); }
        __builtin_amdgcn_sched_barrier(0);
        slot = slot + 1 == NSLOT ? 0 : slot + 1;
    }
#undef PINIT
#undef KLD4
#undef QK4
#undef VLD2
#undef SMAX
#undef VFR
#undef PV2
#undef LWAIT
    if (q_pub) ((volatile LAS unsigned*)(lds + LDSCTL_OFF))[16] = q_next;
    const int tid_e = tid_opaque(), lane_e = tid_e & 63, r32_e = lane_e & 31, hi_e = lane_e >> 5;
#if A_ZPRE
    u32x4 zpre[4];
#pragma unroll
    for (int i = 0; i < 4; ++i) { const int row = i * 8 + lane_e / 8, ch = lane_e % 8; zpre[i] = *(const u32x4*)(d.Z + (size_t)(wid * 32 + row) * 2048 + ch * 8); }
#endif
    { auto rr = __builtin_amdgcn_permlane32_swap(__float_as_uint(l_reg), __float_as_uint(l_reg), false, false); l_reg = __uint_as_float(rr[0]) + __uint_as_float(rr[1]); }
    if (hi_e == 0) ((LAS float*)(lds + OFF_WS) + wid * 64)[r32_e] = l_reg;
    asm volatile("s_waitcnt lgkmcnt(0)" ::: "memory"); __builtin_amdgcn_s_barrier(); asm volatile("" ::: "memory");
    float rli[16];
#pragma unroll
    for (int r = 0; r < 16; ++r) rli[r] = __builtin_amdgcn_rcpf(((LAS float*)(lds + OFF_WS) + wid * 64)[crow(r, hi_e)]);
    LAS bf16_t* stg = (LAS bf16_t*)(lds + wid * 4096);
#pragma unroll
    for (int r = 0; r < 16; ++r) { const int orow = crow(r, hi_e);
#pragma unroll
        for (int dd = 0; dd < 2; ++dd) { const float v = o[dd][r] * rli[r]; stg[orow * 64 + dd * 32 + r32_e] = (bf16_t)(cvt_pk_bf16(v, v) & 0xffffu); } }
    asm volatile("s_waitcnt lgkmcnt(0)" ::: "memory");
#pragma unroll
    for (int i = 0; i < 4; ++i) { const int row = i * 8 + lane_e / 8, ch = lane_e % 8; const size_t off = (size_t)(wid * 32 + row) * 2048 + ch * 8;
        const u32x4 ov = *(const LAS u32x4*)(stg + row * 64 + ch * 8);
#if A_ZPRE
        const u32x4 zv = zpre[i];
#else
        const u32x4 zv = *(const u32x4*)(d.Z + off);
#endif
        u32x4 yv;
#pragma unroll
        for (int j = 0; j < 4; ++j) { const float a0 = __uint_as_float(ov[j] << 16) * __uint_as_float(zv[j] << 16), a1 = __uint_as_float(ov[j] & 0xffff0000u) * __uint_as_float(zv[j] & 0xffff0000u); yv[j] = cvt_pk_bf16(a0, a1); }
        *(u32x4*)(d.Y + off) = yv; }
#if A_NOVMW
    asm volatile("s_waitcnt lgkmcnt(0)" ::: "memory"); __builtin_amdgcn_s_barrier(); asm volatile("" ::: "memory");
#else
    asm volatile("s_waitcnt vmcnt(0) lgkmcnt(0)" ::: "memory"); __builtin_amdgcn_s_barrier(); asm volatile("" ::: "memory");
#endif
#undef TILE_K
#undef TILE_V
#undef DMA1
#undef DMA_PAIR
}

typedef GAS unsigned gu32;
#define RLX_AGENT __ATOMIC_RELAXED, __HIP_MEMORY_SCOPE_AGENT
#define LDS_WAIT() asm volatile("s_waitcnt lgkmcnt(0)" ::: "memory")
#define XB_TMO      128
#define XB_XCNT(j)  (256  + 64 * (j))
#define XB_XSUB(j)  (1280 + 64 * (j))
#define XB_XGEN(j)  (2304 + 64 * (j))
#define XB_TOP      3328
#define XB_TOPGEN   3392
#define XCD_BAR_WORDS 3456
#define XB_SPIN_CAP (1u << 22)
__device__ __forceinline__ unsigned xb_ld(unsigned* p)              { return __hip_atomic_load(p, __ATOMIC_RELAXED, __HIP_MEMORY_SCOPE_AGENT); }
__device__ __forceinline__ unsigned xb_add(unsigned* p, unsigned v) { return __hip_atomic_fetch_add(p, v, __ATOMIC_RELAXED, __HIP_MEMORY_SCOPE_AGENT); }
__device__ __forceinline__ unsigned xb_xcc_id() { return (unsigned)__builtin_amdgcn_s_getreg((3 << 11) | 20) & 0xFu; }
#define XB_SPIN(cond, bar) do { unsigned _sp = 0; while (cond) { __builtin_amdgcn_s_sleep(1); \
    if ((++_sp & 255u) == 0u) { if (xb_ld(&(bar)[XB_TMO])) break; if (_sp > XB_SPIN_CAP) { atomicAdd(&(bar)[XB_TMO], 1u); break; } } } } while (0)
struct XcdBarrier { unsigned* bar; unsigned x; volatile LAS unsigned* st; };
__device__ __forceinline__ XcdBarrier xcd_barrier_post(unsigned* bar, volatile LAS unsigned* st) {
    XcdBarrier b; b.bar = bar; b.x = xb_xcc_id(); b.st = st;
    if (threadIdx.x == 0) (void)xb_add(&bar[XB_XCNT(b.x)], 1u);
    return b;
}
__device__ __forceinline__ void xcd_barrier_complete(unsigned* bar, unsigned x, unsigned& nloc, unsigned& nx) {
    const unsigned G = gridDim.x * gridDim.y * gridDim.z;
    unsigned sum, cnt, mine, sp = 0u;
    for (;;) {
        sum = 0u; cnt = 0u; mine = 0u;
#pragma unroll
        for (unsigned j = 0; j < 16; ++j) { const unsigned c = xb_ld(&bar[XB_XCNT(j)]); sum += c; cnt += (c > 0u) ? 1u : 0u; mine = (j == x) ? c : mine; }
        if (sum == G) break;
        __builtin_amdgcn_s_sleep(1);
        if ((++sp & 255u) == 0u) { if (xb_ld(&bar[XB_TMO])) break; if (sp > XB_SPIN_CAP) { atomicAdd(&bar[XB_TMO], 1u); break; } }
    }
    nloc = mine > 0u ? mine : 1u; nx = cnt > 0u ? cnt : 1u;
}
template <bool FIRST> __device__ __forceinline__ void xcd_barrier(const XcdBarrier& b) {
    asm volatile("s_waitcnt vmcnt(0)" ::: "memory");
    __syncthreads();
    if (threadIdx.x == 0) {
        unsigned* bar = b.bar;
        __builtin_amdgcn_s_waitcnt(0);
        unsigned nloc = b.st[0], nx = b.st[1];
        if constexpr (FIRST) { if (nloc == 0u) { xcd_barrier_complete(bar, b.x, nloc, nx); b.st[0] = nloc; b.st[1] = nx; } }
        else { nloc = nloc ? nloc : 1u; nx = nx ? nx : 1u; }
        const unsigned old = xb_add(&bar[XB_XSUB(b.x)], 1u);
        const unsigned gen = old / nloc;
        if (old + 1u == (gen + 1u) * nloc) {
            __builtin_amdgcn_fence(__ATOMIC_RELEASE, "agent");
            asm volatile("s_waitcnt vmcnt(0)" ::: "memory");
            const unsigned og = xb_add(&bar[XB_TOP], 1u);
            const unsigned tg = og / nx;
            if (og + 1u == (tg + 1u) * nx) xb_add(&bar[XB_TOPGEN], 1u);
            else XB_SPIN(xb_ld(&bar[XB_TOPGEN]) == tg, bar);
            __builtin_amdgcn_fence(__ATOMIC_ACQUIRE, "agent");
            xb_add(&bar[XB_XGEN(b.x)], 1u);
            asm volatile("s_waitcnt vmcnt(0)" ::: "memory");
        } else {
            XB_SPIN(xb_ld(&bar[XB_XGEN(b.x)]) == gen, bar);
            __builtin_amdgcn_fence(__ATOMIC_ACQUIRE, "agent");
            asm volatile("s_waitcnt vmcnt(0)" ::: "memory");
        }
    }
    __syncthreads();
}

__device__ __forceinline__ void xcd_barrier_arrive(const XcdBarrier& b, volatile LAS unsigned* info) {
    asm volatile("s_waitcnt vmcnt(0)" ::: "memory");
    __syncthreads();
    if (threadIdx.x == 0) {
        unsigned* bar = b.bar;
        __builtin_amdgcn_s_waitcnt(0);
        unsigned nloc = b.st[0], nx = b.st[1]; nloc = nloc ? nloc : 1u; nx = nx ? nx : 1u;
        const unsigned old = xb_add(&bar[XB_XSUB(b.x)], 1u);
        const unsigned gen = old / nloc;
        unsigned leader = 0u;
        if (old + 1u == (gen + 1u) * nloc) {
            leader = 1u;
            __builtin_amdgcn_fence(__ATOMIC_RELEASE, "agent");
            asm volatile("s_waitcnt vmcnt(0)" ::: "memory");
            const unsigned og = xb_add(&bar[XB_TOP], 1u);
            const unsigned tg = og / nx;
            if (og + 1u == (tg + 1u) * nx) xb_add(&bar[XB_TOPGEN], 1u);
            else XB_SPIN(xb_ld(&bar[XB_TOPGEN]) == tg, bar);
            __builtin_amdgcn_fence(__ATOMIC_ACQUIRE, "agent");
            xb_add(&bar[XB_XGEN(b.x)], 1u);
            asm volatile("s_waitcnt vmcnt(0)" ::: "memory");
        }
        info[0] = gen; info[1] = leader;
    }
    __syncthreads();
}
__device__ __forceinline__ void xcd_barrier_wait(const XcdBarrier& b, volatile LAS unsigned* info) {
    if (threadIdx.x == 0 && info[1] == 0u) {
        unsigned* bar = b.bar; const unsigned gen = info[0];
        XB_SPIN(xb_ld(&bar[XB_XGEN(b.x)]) == gen, bar);
        __builtin_amdgcn_fence(__ATOMIC_ACQUIRE, "agent");
        asm volatile("s_waitcnt vmcnt(0)" ::: "memory");
    }
    __syncthreads();
}

__device__ __forceinline__ void delay_ticks(unsigned ticks) { if (ticks) { const unsigned long long t0 = __builtin_amdgcn_s_memrealtime(); while (__builtin_amdgcn_s_memrealtime() - t0 < ticks) __builtin_amdgcn_s_sleep(16); } }
struct Args { const float* in[21]; float* out; unsigned char* ws; int ph_lo, ph_hi; };

__device__ __forceinline__ float wave_sum(float v) {
    v += swz_xor<1>(v); v += swz_xor<2>(v); v += swz_xor<4>(v); v += swz_xor<8>(v); v += swz_xor<16>(v);
    return sum_xor32(v);
}
__device__ __forceinline__ unsigned f2bf(float f) { unsigned u = __builtin_bit_cast(unsigned, f); return (u + 0x7fffu + ((u >> 16) & 1u)) >> 16; }
__device__ __forceinline__ unsigned pk2(float lo, float hi) { return f2bf(lo) | (f2bf(hi) << 16); }

struct TItem { const float* W; const float* sc; bf16_t* WT; int ldw, c0, K, r0, kb; };
__device__ __forceinline__ void ti_load(const TItem& it, float (&v)[32], int lane) {
    if (it.W) { const float* p = it.W + (size_t)(64 * it.kb + (lane >> 5)) * it.ldw + it.c0 + (lane & 31);
#pragma unroll
        for (int i = 0; i < 32; ++i) v[i] = p[(size_t)(2 * i) * it.ldw]; }
}
__device__ __forceinline__ void ti_finish(const TItem& it, float (&v)[32], LAS float* scr, int lane) {
    const int k0 = 64 * it.kb;
    if (it.W) {
        if (it.sc) {
#pragma unroll
            for (int i = 0; i < 32; ++i) v[i] *= it.sc[k0 + 2 * i + (lane >> 5)]; }
#pragma unroll
        for (int i = 0; i < 32; ++i) scr[(2 * i + (lane >> 5)) * 33 + (lane & 31)] = v[i];
    } else {
#pragma unroll 8
        for (int i = 0; i < 32; ++i) { const int kk = 2 * i + (lane >> 5); scr[kk * 33 + (lane & 31)] = 0.f; }
    }
    LDS_WAIT(); asm volatile("" ::: "memory");
    const int c = lane & 7;
#pragma unroll
    for (int j = 0; j < 4; ++j) { const int n = (lane >> 3) + 8 * j; const LAS float* s = scr + (8 * c) * 33 + n;
        u32x4 o; o.x = pk2(s[0 * 33], s[1 * 33]); o.y = pk2(s[2 * 33], s[3 * 33]); o.z = pk2(s[4 * 33], s[5 * 33]); o.w = pk2(s[6 * 33], s[7 * 33]);
        *(u32x4*)(it.WT + (size_t)(it.r0 + n) * it.K + k0 + 8 * c) = o; }
    LDS_WAIT(); asm volatile("" ::: "memory");
}
__device__ __forceinline__ void blk_feat(int nb, int& t, int& f0) { t = nb >> 3; const int j8 = nb & 7; f0 = 64 * (j8 & 3) + 32 * (j8 >> 2); }


__device__ __forceinline__ void ada_item(const Args& args, unsigned char* ws, LAS unsigned char* lds, int l, int cg, int tid, int lane, int wave) {
    const int c4 = (lane & 15) * 4, rsub = lane >> 4;
    LAS float* sl = (LAS float*)lds + wave * (9 * 256);
    LAS float* red = (LAS float*)(lds + 8 * 9 * 256 * 4);
#pragma unroll
    for (int r = 0; r < 9; ++r)
#pragma unroll
        for (int j = 0; j < 4; ++j) { const int k = 256 * wave + 64 * j + lane; const float v = (r < 8) ? args.in[1][r * 2048 + k] : args.in[3][k]; sl[r * 256 + 64 * j + lane] = v / (1.0f + __expf(-v)); }
    LDS_WAIT();
    f32x4 acc[9];
#pragma unroll
    for (int r = 0; r < 9; ++r) acc[r] = (f32x4){0.f, 0.f, 0.f, 0.f};
    const float* wp = args.in[5] + (size_t)l * 2048 * 6144 + (size_t)(256 * wave + rsub) * 6144 + cg * 64 + c4;
#pragma unroll 1
    for (int kk = 0; kk < 256; kk += 64) {
        f32x4 wv[16];
#pragma unroll
        for (int uu = 0; uu < 16; ++uu) wv[uu] = *(const f32x4*)(wp + (size_t)(kk + 4 * uu) * 6144);
#pragma unroll
        for (int uu = 0; uu < 16; ++uu)
#pragma unroll
            for (int r = 0; r < 9; ++r) acc[r] += sl[r * 256 + kk + 4 * uu + rsub] * wv[uu];
    }
#pragma unroll
    for (int r = 0; r < 9; ++r)
#pragma unroll
        for (int j = 0; j < 4; ++j) { float v = acc[r][j]; v += swz_xor<16>(v); v = sum_xor32(v); acc[r][j] = v; }
    if (rsub == 0) {
#pragma unroll
        for (int r = 0; r < 9; ++r) *(LAS f32x4*)(red + (wave * 9 + r) * 64 + c4) = acc[r]; }
    __syncthreads();
    for (int o = tid; o < 576; o += 512) { const int r = o >> 6, cl = o & 63; float s = 0.f;
#pragma unroll
        for (int w8 = 0; w8 < 8; ++w8) s += red[(w8 * 9 + r) * 64 + cl];
        __hip_atomic_store((GAS float*)(ws + WS_MOD) + ((size_t)l * 9 + r) * 6144 + cg * 64 + cl, s + args.in[6][l * 6144 + cg * 64 + cl], __ATOMIC_RELAXED, __HIP_MEMORY_SCOPE_AGENT); }
    asm volatile("s_waitcnt vmcnt(0)" ::: "memory");
    __syncthreads();
}
constexpr int CVT_ITEMS = 200 * 32 + 64 * 32 + 48 * 12 + 48 * 8;
__device__ __forceinline__ TItem cvt_decode(const Args& args, unsigned char* ws, int l, int r) {
    constexpr int I_IN = 200 * 32, I_OUT = 64 * 32, I_QB = 48 * 12;
    static_assert(I_IN + I_OUT + I_QB + 48 * 8 == CVT_ITEMS, "item count");
    TItem it; int t, f0;
    if (r < I_IN) { const int kb = r / 200, nb = r % 200; blk_feat(nb, t, f0); const bool valid = !(t == 16 && f0 >= 64); const int src = (t <= 16 ? 256 * t : 4160 + 256 * (t - 17)) + f0;
        it.W = valid ? args.in[7] + (size_t)l * 2048 * N_IN : nullptr; it.ldw = N_IN; it.c0 = src; it.sc = nullptr; it.WT = (bf16_t*)(ws + WS_WIN) + (size_t)l * 6400 * 2048; it.K = 2048; it.r0 = nb * 32; it.kb = kb; return it; }
    r -= I_IN;
    if (r < I_OUT) { const int kb = r / 64, nb = r % 64; blk_feat(nb, t, f0);
        it.W = args.in[20] + (size_t)l * 2048 * 2048; it.ldw = 2048; it.c0 = 256 * t + f0; it.sc = nullptr; it.WT = (bf16_t*)(ws + WS_WOUT) + (size_t)l * 2048 * 2048; it.K = 2048; it.r0 = nb * 32; it.kb = kb; return it; }
    r -= I_OUT;
    if (r < I_QB) { const int kb = r / 48, nb = r % 48; blk_feat(nb, t, f0); const bool valid = f0 < 192;
        it.W = valid ? args.in[16] + (size_t)l * 768 * 1152 : nullptr; it.ldw = 1152; it.c0 = 192 * t + f0; it.sc = args.in[14] + l * 768; it.WT = (bf16_t*)(ws + WS_WQB) + (size_t)l * 1536 * 768; it.K = 768; it.r0 = nb * 32; it.kb = kb; return it; }
    r -= I_QB;
    { const int kb = r / 48, nb = r % 48; blk_feat(nb, t, f0);
      it.W = args.in[17] + (size_t)l * 512 * 1536; it.ldw = 1536; it.c0 = 256 * t + f0; it.sc = args.in[15] + l * 512; it.WT = (bf16_t*)(ws + WS_WKVB) + (size_t)l * 1536 * 512; it.K = 512; it.r0 = nb * 32; it.kb = kb; return it; }
}
__device__ __forceinline__ void convert_items(const Args& args, unsigned char* ws, LAS unsigned char* lds, int l, int first, int stride, int lane, int wave, int lo = 0, int hi = CVT_ITEMS) {
    LAS float* scr = (LAS float*)(lds + wave * 16384);
    int rr = lo + first;
    if (rr >= hi) return;
    float va[32], vb[32];
    TItem ia = cvt_decode(args, ws, l, rr), ib = ia;
    ti_load(ia, va, lane);
#pragma unroll 1
    for (;;) {
        const int rb = rr + stride; const bool hb = rb < hi;
        if (hb) { ib = cvt_decode(args, ws, l, rb); ti_load(ib, vb, lane); }
        ti_finish(ia, va, scr, lane);
        if (!hb) break;
        rr = rb + stride; const bool ha = rr < hi;
        if (ha) { ia = cvt_decode(args, ws, l, rr); ti_load(ia, va, lane); }
        ti_finish(ib, vb, scr, lane);
        if (!ha) break;
    }
}

#define P1_ROWS(W0_, STRIDE_, RB_, RE_) do { \
            for (int row0 = (RB_) + (W0_); row0 < (RE_); row0 += 2 * (STRIDE_)) { \
                const int row1 = row0 + (STRIDE_); const bool has1 = row1 < (RE_); \
                const bool lat0 = row0 < NLAT, lat1 = row1 < NLAT; \
                const float* xr0 = lat0 ? xl + (size_t)row0 * 2048 : xcl + (size_t)(row0 - NLAT) * 2048; \
                const float* xr1 = has1 ? (lat1 ? xl + (size_t)row1 * 2048 : xcl + (size_t)(row1 - NLAT) * 2048) : xr0; \
                f32x4 v0[8], v1[8]; float s0 = 0.f, s1 = 0.f; \
                _Pragma("unroll") for (int j = 0; j < 8; ++j) v0[j] = *(const f32x4*)(xr0 + 8 * lane + 512 * (j >> 1) + 4 * (j & 1)); \
                _Pragma("unroll") for (int j = 0; j < 8; ++j) v1[j] = *(const f32x4*)(xr1 + 8 * lane + 512 * (j >> 1) + 4 * (j & 1)); \
                _Pragma("unroll") for (int j = 0; j < 8; ++j) { s0 += (v0[j][0] * v0[j][0] + v0[j][1] * v0[j][1]) + (v0[j][2] * v0[j][2] + v0[j][3] * v0[j][3]); s1 += (v1[j][0] * v1[j][0] + v1[j][1] * v1[j][1]) + (v1[j][2] * v1[j][2] + v1[j][3] * v1[j][3]); } \
                const float ri0 = __builtin_amdgcn_rsqf(wave_sum(s0) * (1.0f / 2048.0f) + EPS), ri1 = __builtin_amdgcn_rsqf(wave_sum(s1) * (1.0f / 2048.0f) + EPS); \
                const float* sh0 = modl + (size_t)(lat0 ? (row0 >> 11) : 8) * 6144; const float* sh1 = modl + (size_t)(lat1 ? (row1 >> 11) : 8) * 6144; \
                _Pragma("unroll") for (int jj = 0; jj < 4; ++jj) { const int k = 8 * lane + 512 * jj; u32x4 o0, o1; \
                    _Pragma("unroll") for (int hf = 0; hf < 2; ++hf) { const int kk = k + 4 * hf; const f32x4 w4 = *(const f32x4*)(nw + kk); \
                        { const f32x4 s4 = *(const f32x4*)(sh0 + 2048 + kk), h4 = *(const f32x4*)(sh0 + kk); const f32x4 y = v0[2 * jj + hf] * ri0 * w4 * (s4 + 1.0f) + h4; o0[2 * hf] = cvt_pk_bf16(y[0], y[1]); o0[2 * hf + 1] = cvt_pk_bf16(y[2], y[3]); } \
                        { const f32x4 s4 = *(const f32x4*)(sh1 + 2048 + kk), h4 = *(const f32x4*)(sh1 + kk); const f32x4 y = v1[2 * jj + hf] * ri1 * w4 * (s4 + 1.0f) + h4; o1[2 * hf] = cvt_pk_bf16(y[0], y[1]); o1[2 * hf + 1] = cvt_pk_bf16(y[2], y[3]); } } \
                    *(u32x4*)(XN + (size_t)row0 * 2048 + k) = o0; if (has1) *(u32x4*)(XN + (size_t)row1 * 2048 + k) = o1; } \
            } \
} while (0)

#ifndef MK_P1_EARLY
#define MK_P1_EARLY 1
#endif
__global__ void __launch_bounds__(512, 2) hymba_fwd(Args kargs) {
    LAS unsigned char* lds = (LAS unsigned char*)lds_;
    volatile LAS unsigned* MISC = (volatile LAS unsigned*)(lds + LDSCTL_OFF);
    const int tid = threadIdx.x, lane = tid & 63, wave = __builtin_amdgcn_readfirstlane(tid >> 6);
    const int G = gridDim.x, bx = blockIdx.x; const int G0_ = G, bx0_ = bx;
    const int vcu = (G % 8 == 0) ? (bx % 8) * (G / 8) + bx / 8 : bx;
    unsigned char* ws0 = kargs.ws;
    gu32* ctl = (gu32*)(ws0 + WS_CTL);
    for (int u = tid; u < 128; u += 512) MISC[u] = 0u;
    __syncthreads();
    XcdBarrier bar = xcd_barrier_post((unsigned*)ctl + CW_BAR + (MK_N_LAUNCHES == 1 ? 0 : kargs.ph_lo) * XCD_BAR_WORDS, MISC + 8);
    if (tid == 0) { unsigned nloc, nx; xcd_barrier_complete(bar.bar, bar.x, nloc, nx); bar.st[0] = nloc; bar.st[1] = nx; }
    __syncthreads();
    const int lo = kargs.ph_lo, hi_ph = kargs.ph_hi;
#ifdef STAMP_PROBE
#define STAMP(k) do { if (bx == 0 && tid == 0) ((unsigned long long*)(kargs.ws + WS_END))[k] = __builtin_amdgcn_s_memrealtime(); } while (0)
#else
#define STAMP(k) do {} while (0)
#endif
    STAMP(0);
#ifndef PH_MASK
#define PH_MASK 0x3f
#endif
#define KEN(j) (((PH_MASK) >> (j)) & 1)
#define IN(k) (lo <= (k) && (k) < hi_ph)
#define SEAM(k) do { if (IN(k) && IN((k) + 1)) xcd_barrier<false>(bar); } while (0)
#if defined(__HIP_DEVICE_COMPILE__)
#define PHASE_ARGS const __attribute__((address_space(4))) unsigned long long* kap_ = (const __attribute__((address_space(4))) unsigned long long*)__builtin_amdgcn_kernarg_segment_ptr(); asm volatile("" : "+s"(kap_)); \
    Args args; _Pragma("unroll") for (int i_ = 0; i_ < 21; ++i_) args.in[i_] = (const float*)kap_[i_]; args.out = (float*)kap_[21]; args.ws = (unsigned char*)kap_[22]; args.ph_lo = 0; args.ph_hi = 0;
#else
#define PHASE_ARGS const Args args = kargs;
#endif
#if LAUNDER_LDS
#define PHASE_LDS LAS unsigned char* lds = (LAS unsigned char*)lds_; asm volatile("" : "+s"(lds)); volatile LAS unsigned* MISC = (volatile LAS unsigned*)(lds + LDSCTL_OFF); (void)MISC;
#else
#define PHASE_LDS
#endif
#define PHASE_WS PHASE_ARGS PHASE_LDS const int bx = launder_s(bx0_), G = launder_s(G0_); const int vcu = (G % 8 == 0) ? (bx % 8) * (G / 8) + bx / 8 : bx; const int gw = vcu * 8 + wave, NGW = G * 8; (void)gw; (void)NGW; \
    GAS unsigned char* wsg_ = (GAS unsigned char*)args.ws; asm volatile("" : "+s"(wsg_)); unsigned char* ws = (unsigned char*)wsg_;
#define modp ((float*)(ws + WS_MOD))
#define ropep ((float*)(ws + WS_ROPE))
#define XN ((bf16_t*)(ws + WS_XN))
#define YG ((bf16_t*)(ws + WS_XN))
#define QA ((bf16_t*)(ws + WS_QA))
#define KA ((bf16_t*)(ws + WS_KA))
#define VA ((bf16_t*)(ws + WS_VA))
#define QB ((bf16_t*)(ws + WS_QB))
#define KB ((bf16_t*)(ws + WS_KB))
#define VB ((bf16_t*)(ws + WS_VB))
#define CQ ((bf16_t*)(ws + WS_CQ))
#define CKV ((bf16_t*)(ws + WS_CKV))
#define ZS ((bf16_t*)(ws + WS_ZS))
#define QC ((bf16_t*)(ws + WS_QC))
#define KC ((bf16_t*)(ws + WS_KC))
#define VC ((bf16_t*)(ws + WS_VC))
#define KPE ((float*)(ws + WS_KPE))
#define SSQK ((float*)(ws + WS_SSQK))
#define XC1 ((float*)(ws + WS_XC1))
#define x_in (args.in[0])
#define ctx_in (args.in[2])
    const int gw = vcu * 8 + wave, NGW = G * 8;

    if (KEN(0) && IN(0)) { PHASE_WS
#ifdef PREP_ALL_IN_P0
        for (int it = bx; it < 192; it += G) ada_item(args, ws, lds, it / 96, it % 96, tid, lane, wave);
        convert_items(args, ws, lds, 0, gw, NGW, lane, wave); convert_items(args, ws, lds, 1, gw, NGW, lane, wave);
#else
        for (int it = bx; it < 96; it += G) { ada_item(args, ws, lds, 0, it, tid, lane, wave); if (P3_FLOW && tid == 0) (void)xb_add((unsigned*)ctl + CW_ADA0, 1u); }
        if (bx >= 96) convert_items(args, ws, lds, 0, (bx - 96) * 8 + wave, (G - 96) * 8, lane, wave, 0, CVT_ITEMS - P0_ADA_SHARE);
        else convert_items(args, ws, lds, 0, bx * 8 + wave, 96 * 8, lane, wave, CVT_ITEMS - P0_ADA_SHARE, CVT_ITEMS);
#endif
    }
    if (IN(0) && IN(1) && !(P3_FLOW && MK_N_LAUNCHES == 1)) xcd_barrier<false>(bar);
    STAMP(1);

#pragma unroll 1
    for (int l = 0; l < DEPTH; ++l) {
        const int P = 1 + 5 * l;
        if (KEN(1) && IN(P) && (l == 0 || !P3_FLOW)) { PHASE_WS
            if (P3_FLOW && l == 0) { if (tid_opaque() == 0) { unsigned sp_ = 0u; while (xb_ld((unsigned*)ctl + CW_ADA0) < 96u) { __builtin_amdgcn_s_sleep(2); if (++sp_ > XB_SPIN_CAP) break; }
                    __builtin_amdgcn_fence(__ATOMIC_ACQUIRE, "agent"); asm volatile("s_waitcnt vmcnt(0)" ::: "memory"); }
                __syncthreads(); }
            const float* modl = modp + (size_t)l * 9 * 6144; (void)modl;
            const float* xl = (l == 0) ? x_in : args.out; (void)xl;
            const float* xcl = (l == 0) ? ctx_in : XC1; (void)xcl;
            float* ssq_cq = (float*)(ws + CTL_SSQ_OFF) + (size_t)l * MTOT; (void)ssq_cq;
            float* ssq_ckv = (float*)(ws + CTL_SSQ_OFF) + (size_t)(2 + l) * MTOT; (void)ssq_ckv;
            const float* nw = args.in[4] + l * 2048; const int lane = tid_opaque() & 63;
            P1_ROWS(gw, NGW, (l == 0 || MK_P1_EARLY == 0) ? 0 : NLAT, MTOT);
        }
        if (l == 0 || !P3_FLOW) SEAM(P);
        STAMP(P + 1);
        if (KEN(2) && IN(P + 1)) { PHASE_WS
            const float* modl = modp + (size_t)l * 9 * 6144; (void)modl;
            const float* xl = (l == 0) ? x_in : args.out; (void)xl;
            const float* xcl = (l == 0) ? ctx_in : XC1; (void)xcl;
            float* ssq_cq = (float*)(ws + CTL_SSQ_OFF) + (size_t)l * MTOT; (void)ssq_cq;
            float* ssq_ckv = (float*)(ws + CTL_SSQ_OFF) + (size_t)(2 + l) * MTOT; (void)ssq_ckv;
            pg8::Gemm g{XN, (const bf16_t*)(ws + WS_WIN) + (size_t)l * 6400 * 2048, MTOT, 6400, 2048};
            pg8::Sched2 S; S.G = G; S.c = bx; S.nN1 = NT_IN; S.pm2 = 64; S.nN2 = 9;
            if (l == DEPTH - 1) { S.nM1 = 64; S.nM2 = 8; if (EARLY_Q && G == 256) S.sig = (unsigned*)ctl + CW_CQDONE; } else { S.nM1 = 72; S.nM2 = 0; }
            const bool flow = P3_FLOW && G == 256;
            const bool split0 = (l == 0) && (G == 256);
            if (split0) { S.cut = 7 * 256; S.swap8 = true; }
            if (flow) { S.twoA = S.nM1 * 6 + S.nM2 * 3; S.sig = (unsigned*)ctl + CW_P3IN + 64 * l; pg8::Unit us; S.next((S.twoA - 1 - bx) >> 8, us); S.sig_pm = __builtin_amdgcn_readfirstlane(us.pm); S.sig_pn = __builtin_amdgcn_readfirstlane(us.pn); }
            EpiIn E{ws, args.in[8] + l * 64, args.in[9] + l * 64, args.in[11] + l * 64, args.in[12] + l * 64, args.in[19] + l * 192, l};
            { LAS float* wl = xch_ptr(); const int t_w = tid_opaque();
              if (t_w < 448) { const float* sp = t_w < 64 ? E.qn_a + t_w : t_w < 128 ? E.kn_a + (t_w - 64) : t_w < 192 ? E.qn_b + (t_w - 128) : t_w < 256 ? E.kn_b + (t_w - 192) : E.kn_c + (t_w - 256); wl[t_w] = *sp; }
              __syncthreads(); }
#ifdef STAGGER_P2
            delay_ticks((unsigned)(((bx >> 3) & 3) * STAGGER_P2));
#endif
#ifdef P2_TWICE
            { EpiNull EN{ws}; pg8::gemm_phase<EpiNull, pg8::Sched2, true, true>(lds, g, S, EN); }
#endif
            pg8::gemm_phase<EpiIn, pg8::Sched2, true, true>(lds, g, S, E);
#ifndef PREP_ALL_IN_P0
            if (EARLY_Q && l == DEPTH - 1 && G == 256 && bx >= 136) {
                if (tid_opaque() == 0) { unsigned sp_ = 0u; while (xb_ld((unsigned*)ctl + CW_CQDONE) < (unsigned)G) { __builtin_amdgcn_s_sleep(2); if (++sp_ > XB_SPIN_CAP) break; }
                    __builtin_amdgcn_fence(__ATOMIC_ACQUIRE, "agent"); asm volatile("s_waitcnt vmcnt(0)" ::: "memory"); }
                __syncthreads();
                { LAS float* gl = (LAS float*)(lds + 131072 + 4096); (void)gl; }
                pg8::Gemm gq{CQ, (const bf16_t*)(ws + WS_WQB) + (size_t)l * 1536 * 768, MTOT, 1536, 768};
                EpiQC Eq{ws, args.in[18] + l * 192, l};
                pg8::SchedOne S1; pg8::grid_map(383 - (bx - 136), 64, 6, S1.pm, S1.pn);
                pg8::gemm_phase<EpiQC, pg8::SchedOne, true, true>(lds, gq, S1, Eq);
            }
            if (split0) {
                const int t2 = tid_opaque(), lane2 = t2 & 63, wave2 = __builtin_amdgcn_readfirstlane(t2 >> 6);
                if (bx < 96) ada_item(args, ws, lds, 1, bx, t2, lane2, wave2);
                else convert_items(args, ws, lds, 1, (bx - 96) * 8 + wave2, (G - 96) * 8, lane2, wave2, 0, CVT_ITEMS - PREP_A - PREP_B);
                __syncthreads();
            } else if (l == 0 && bx >= 8) {
                const int t2 = tid_opaque(), lane2 = t2 & 63, wave2 = __builtin_amdgcn_readfirstlane(t2 >> 6);
                if (bx < 104) ada_item(args, ws, lds, 1, bx - 8, t2, lane2, wave2);
                else convert_items(args, ws, lds, 1, (bx - 104) * 8 + wave2, (G - 104) * 8, lane2, wave2);
                __syncthreads();
            }
#endif
            if (P3_FLOW && G == 256 && !(l == 0 && bx >= 248)) { if (tid_opaque() == 0) (void)xb_add((unsigned*)ctl + CW_P2DONE + 64 * l, 1u); }
        }
        if (!(P3_FLOW && G == 256 && MK_N_LAUNCHES == 1)) SEAM(P + 1);
        STAMP(P + 2);
        if (KEN(3) && IN(P + 2)) { PHASE_WS
            const float* modl = modp + (size_t)l * 9 * 6144; (void)modl;
            const float* xl = (l == 0) ? x_in : args.out; (void)xl;
            const float* xcl = (l == 0) ? ctx_in : XC1; (void)xcl;
            float* ssq_cq = (float*)(ws + CTL_SSQ_OFF) + (size_t)l * MTOT; (void)ssq_cq;
            float* ssq_ckv = (float*)(ws + CTL_SSQ_OFF) + (size_t)(2 + l) * MTOT; (void)ssq_ckv;
            if (P3_FLOW && G == 256) {
                if (tid_opaque() == 0) { unsigned sp_ = 0u; while (xb_ld((unsigned*)ctl + CW_P3IN + 64 * l) < (unsigned)G) { __builtin_amdgcn_s_sleep(2); if (++sp_ > XB_SPIN_CAP) break; }
                    __builtin_amdgcn_fence(__ATOMIC_ACQUIRE, "agent"); asm volatile("s_waitcnt vmcnt(0)" ::: "memory"); }
                __syncthreads();
            }
            const bool split0 = (l == 0) && (G == 256);
            if (split0 && bx >= 248) {
                pg8::Gemm gi{XN, (const bf16_t*)(ws + WS_WIN) + (size_t)l * 6400 * 2048, MTOT, 6400, 2048};
                EpiIn Ei{ws, args.in[8] + l * 64, args.in[9] + l * 64, args.in[11] + l * 64, args.in[12] + l * 64, args.in[19] + l * 192, l};
                pg8::SchedOne S1; S1.pm = 64 + (bx - 248); S1.pn = NT_IN - 1;
                pg8::gemm_phase<EpiIn, pg8::SchedOne, true, true>(lds, gi, S1, Ei);
                if (P3_FLOW && G == 256 && tid_opaque() == 0) (void)xb_add((unsigned*)ctl + CW_P2DONE + 64 * l, 1u);
            }
            { pg8::Gemm g{CQ, (const bf16_t*)(ws + WS_WQB) + (size_t)l * 1536 * 768, MTOT, 1536, 768};
              pg8::Sched2 S; S.G = G; S.c = bx; S.nN1 = 6; S.nM1 = (l == DEPTH - 1) ? 64 : 72; S.nM2 = 0; S.nN2 = 0; S.pm2 = 0;
              if (EARLY_Q && l == DEPTH - 1 && G == 256) S.cut = 384 - 120;
              if (P3_FLOW && l == DEPTH - 1 && G == 256) { S.c = bx >= 136 ? bx - 136 : bx + 120; S.rk_idle = 120; S.rk_off3 = 0; }
              EpiQC E{ws, args.in[18] + l * 192, l};
#ifdef P3_TWICE
              { EpiNull EN{ws}; pg8::gemm_phase<EpiNull, pg8::Sched2, true, true>(lds, g, S, EN); }
#endif
              pg8::gemm_phase<EpiQC, pg8::Sched2, true, true>(lds, g, S, E); }
            { pg8::Gemm g{CKV, (const bf16_t*)(ws + WS_WKVB) + (size_t)l * 1536 * 512, MTOT, 1536, 512};
              pg8::Sched2 S; S.G = G; S.c = (EARLY_Q && l == DEPTH - 1 && G == 256) ? G - 1 - bx : bx; S.nN1 = 6; S.nM1 = 72; S.nM2 = 0; S.nN2 = 0; S.pm2 = 0;
              if (P3_FLOW && l == DEPTH - 1 && G == 256) { S.c = bx >= 136 ? bx - 136 : bx + 120; S.rk_idle = 120; S.rk_off3 = 64; }
              EpiKVC E{ws, args.in[19] + l * 192, l};
#ifdef P3_TWICE
              { EpiNull EN{ws}; pg8::gemm_phase<EpiNull, pg8::Sched2, true, true>(lds, g, S, EN); }
#endif
              pg8::gemm_phase<EpiKVC, pg8::Sched2, true, true>(lds, g, S, E); }
            if (P3_FLOW && G == 256 && tid_opaque() == 0) (void)xb_add((unsigned*)ctl + CW_P3DONE + 64 * l, 1u);
            if (split0 && bx >= 128 && bx < 248) {
                const int t2 = tid_opaque(), lane2 = t2 & 63, wave2 = __builtin_amdgcn_readfirstlane(t2 >> 6);
                if (bx >= 176) convert_items(args, ws, lds, 1, (bx - 176) * 8 + wave2, 72 * 8, lane2, wave2, CVT_ITEMS - PREP_A - PREP_B, CVT_ITEMS - PREP_B);
                else convert_items(args, ws, lds, 1, (bx - 128) * 8 + wave2, 48 * 8, lane2, wave2, CVT_ITEMS - PREP_B, CVT_ITEMS);
                __syncthreads();
            }
        }
        if (!(ATT_NPRE > 0 && P3_FLOW && G == 256 && MK_N_LAUNCHES == 1)) SEAM(P + 2);
        STAMP(P + 3);
        if (KEN(4) && IN(P + 3)) { PHASE_WS
            const float* modl = modp + (size_t)l * 9 * 6144; (void)modl;
            const float* xl = (l == 0) ? x_in : args.out; (void)xl;
            const float* xcl = (l == 0) ? ctx_in : XC1; (void)xcl;
            float* ssq_cq = (float*)(ws + CTL_SSQ_OFF) + (size_t)l * MTOT; (void)ssq_cq;
            float* ssq_ckv = (float*)(ws + CTL_SSQ_OFF) + (size_t)(2 + l) * MTOT; (void)ssq_ckv;
            const int NU_C = BATCH * HC * 8, NU_B = BATCH * HB * 8, NU_A = BATCH * HA * 8;
            const int NU_CC = (l == DEPTH - 1) ? 0 : BATCH * HC, NU_CB = (l == DEPTH - 1) ? 0 : BATCH * HB, NU_CA = (l == DEPTH - 1) ? 0 : BATCH * HA;
            const int NU = NU_C + NU_B + NU_A + NU_CC + NU_CB + NU_CA;
            if (tid_opaque() == 0) MISC[16] = atomicAdd((unsigned*)ctl + CW_QUEUE + 64 * l, 1u);
            __syncthreads();
            int u_next = (int)MISC[16];
            __syncthreads();
#if ATT_NPRE > 0
            if (P3_FLOW && G == 256) {
                if (tid_opaque() == 0) { unsigned sp_ = 0u; while (xb_ld((unsigned*)ctl + CW_P2DONE + 64 * l) < (unsigned)G) { __builtin_amdgcn_s_sleep(2); if (++sp_ > XB_SPIN_CAP) break; }
                    __builtin_amdgcn_fence(__ATOMIC_ACQUIRE, "agent"); asm volatile("s_waitcnt vmcnt(0)" ::: "memory"); }
                __syncthreads();
            }
#endif
            bool p3_done = false;
            for (;;) {
                int u = u_next;
                if (u >= NU) break;
                unsigned q_next = 0u; const bool q_lane = tid_opaque() == 0;
                if (q_lane) q_next = atomicAdd((unsigned*)ctl + CW_QUEUE + 64 * l, 1u);
#if ATT_NPRE > 0
                if (P3_FLOW && G == 256) { if (u >= ATT_NPRE && !p3_done) {
                        if (q_lane) { unsigned sp_ = 0u; while (xb_ld((unsigned*)ctl + CW_P3DONE + 64 * l) < (unsigned)G) { __builtin_amdgcn_s_sleep(2); if (++sp_ > XB_SPIN_CAP) break; }
                            __builtin_amdgcn_fence(__ATOMIC_ACQUIRE, "agent"); asm volatile("s_waitcnt vmcnt(0)" ::: "memory"); }
                        __syncthreads(); p3_done = true; }
                    u = u < NU_A ? NU_C + NU_B + u : (u < NU_A + NU_C ? u - NU_A : (u < NU_A + NU_C + NU_B ? u - NU_A : u)); }
#endif
                bool big = false; AttnDesc d; d.m0 = -1e30f; d.l0 = 0.f; d.bias = nullptr; d.mask = MK_NONE; d.lt0 = 0; d.nlt = 0; d.q0 = 0;
                if (u < NU_C) {
                    const int qb = u & 7, hc = (u >> 3) % HC, b = u / (8 * HC); const size_t r0 = (size_t)b * SEQ + qb * 256, rc = (size_t)NLAT + b * LC;
                    d.Q = QC + r0 * 1152 + hc * 192; d.Kc = KC + rc * 1152 + hc * 192; d.Vc = VC + rc * 768 + hc * 128; d.Kl = KC + (size_t)b * SEQ * 1152 + hc * 192; d.Vl = VC + (size_t)b * SEQ * 768 + hc * 128;
                    d.ldq = 1152; d.ldk = 1152; d.ldv = 768; d.nlt = 32; d.Z = ZS + r0 * 2048 + 1280 + hc * 128; d.Y = YG + r0 * 2048 + 1280 + hc * 128; big = true; }
                else if ((u -= NU_C) < NU_B) {
                    const int qb = u & 7, hb = (u >> 3) % HB, b = u / (8 * HB), kv = hb / 3; const size_t r0 = (size_t)b * SEQ + qb * 256, rc = (size_t)NLAT + b * LC;
                    d.Q = QB + r0 * 768 + hb * 64; d.Kc = KB + rc * 256 + kv * 64; d.Vc = VB + rc * 256 + kv * 64; d.Kl = KB + (size_t)b * SEQ * 256 + kv * 64; d.Vl = VB + (size_t)b * SEQ * 256 + kv * 64;
                    d.ldq = 768; d.ldk = 256; d.ldv = 256; const int t0 = qb * 4 - 2 < 0 ? 0 : qb * 4 - 2, t1 = qb * 4 + 5 > 31 ? 31 : qb * 4 + 5; d.lt0 = t0; d.nlt = t1 - t0 + 1;
                    d.mask = MK_SWA; d.q0 = qb * 256; d.m0 = args.in[13][l * HB + hb] * LOG2E; d.l0 = 1.0f;
                    d.Z = ZS + r0 * 2048 + 512 + hb * 64; d.Y = YG + r0 * 2048 + 512 + hb * 64; }
                else if ((u -= NU_B) < NU_A) {
                    const int g4 = u & 7, ha = (u >> 3) % HA, b = u / (8 * HA); const size_t r0 = (size_t)b * SEQ + g4 * 256, rc = (size_t)NLAT + b * LC;
                    d.Q = QA + r0 * 512 + ha * 64; d.Kc = KA + rc * 512 + ha * 64; d.Vc = VA + rc * 512 + ha * 64; d.Kl = KA + (size_t)b * SEQ * 512 + ha * 64; d.Vl = VA + (size_t)b * SEQ * 512 + ha * 64;
                    d.ldq = 512; d.ldk = 512; d.ldv = 512; int ra = 4 * g4 - 4; ra = ra < 0 ? 0 : (ra > 24 ? 24 : ra); int rb = 4 * g4 + 3 - 4; rb = rb < 0 ? 0 : (rb > 24 ? 24 : rb); d.lt0 = ra; d.nlt = rb + 8 - ra;
                    d.mask = MK_NA; d.q0 = g4 * 256; d.bias = args.in[10] + ((size_t)l * HA + ha) * (15 * 31);
                    d.Z = ZS + r0 * 2048 + ha * 64; d.Y = YG + r0 * 2048 + ha * 64; }
                else if ((u -= NU_A) < NU_CC) {
                    const int hc = u % HC, b = u / HC; const size_t rc = (size_t)NLAT + b * LC;
                    d.Q = QC + rc * 1152 + hc * 192; d.Kc = KC + rc * 1152 + hc * 192; d.Vc = VC + rc * 768 + hc * 128; d.Kl = d.Kc; d.Vl = d.Vc; d.ldq = 1152; d.ldk = 1152; d.ldv = 768;
                    d.Z = ZS + rc * 2048 + 1280 + hc * 128; d.Y = YG + rc * 2048 + 1280 + hc * 128; big = true; }
                else if ((u -= NU_CC) < NU_CB) {
                    const int hb = u % HB, b = u / HB, kv = hb / 3; const size_t rc = (size_t)NLAT + b * LC;
                    d.Q = QB + rc * 768 + hb * 64; d.Kc = KB + rc * 256 + kv * 64; d.Vc = VB + rc * 256 + kv * 64; d.Kl = d.Kc; d.Vl = d.Vc; d.ldq = 768; d.ldk = 256; d.ldv = 256;
                    d.m0 = args.in[13][l * HB + hb] * LOG2E; d.l0 = 1.0f;
                    d.Z = ZS + rc * 2048 + 512 + hb * 64; d.Y = YG + rc * 2048 + 512 + hb * 64; }
                else { u -= NU_CB;
                    const int ha = u % HA, b = u / HA; const size_t rc = (size_t)NLAT + b * LC;
                    d.Q = QA + rc * 512 + ha * 64; d.Kc = KA + rc * 512 + ha * 64; d.Vc = VA + rc * 512 + ha * 64; d.Kl = d.Kc; d.Vl = d.Vc; d.ldq = 512; d.ldk = 512; d.ldv = 512;
                    d.Z = ZS + rc * 2048 + ha * 64; d.Y = YG + rc * 2048 + ha * 64; }
                bool skip_unit = false;
#ifdef ATTN_ONLY
                { const int cls = big ? (d.nlt ? 1 : 8) : (d.mask == MK_SWA ? 2 : (d.mask == MK_NA ? 4 : 8)); skip_unit = !((ATTN_ONLY) & cls); }
#endif
                const float mshift = 0.f;
#if defined(ATTN_SLOW_PATH) || defined(ATTN_MIX) || defined(ATTN_NO_PAIR)
#ifdef ATTN_SLOW_PATH
                (void)mshift; if (!skip_unit) { if (big) attn_unit<192, 128>(d, lds); else attn_unit<64, 64>(d, lds); }
#elif defined(ATTN_MIX)
                if (big) attn_unit2<192, 128>(d, fminf(mshift, 60.f), lds); else attn_unit<64, 64>(d, lds);
#else
                (void)mshift; if (!skip_unit) { if (big) attn_unit2<192, 128>(d, 0.f, lds); else attn_unit2<64, 64>(d, 0.f, lds); }
#endif
                if (q_lane) MISC[16] = q_next;
                __syncthreads();
                u_next = (int)MISC[16];
                __syncthreads();
#else
                (void)mshift; if (!skip_unit) { if (big) attn_unit2<192, 128>(d, 0.f, lds, q_next, q_lane); else attn_unit64(d, lds, q_next, q_lane); }
                else { if (q_lane) MISC[16] = q_next; __syncthreads(); }
                u_next = (int)MISC[16];
#endif
            }
        }
        SEAM(P + 3); STAMP(P + 4);
        if (KEN(5) && IN(P + 4)) { PHASE_WS
            const float* modl = modp + (size_t)l * 9 * 6144; (void)modl;
            const float* xl = (l == 0) ? x_in : args.out; (void)xl;
            const float* xcl = (l == 0) ? ctx_in : XC1; (void)xcl;
            float* ssq_cq = (float*)(ws + CTL_SSQ_OFF) + (size_t)l * MTOT; (void)ssq_cq;
            float* ssq_ckv = (float*)(ws + CTL_SSQ_OFF) + (size_t)(2 + l) * MTOT; (void)ssq_ckv;
            pg8::Gemm g{YG, (const bf16_t*)(ws + WS_WOUT) + (size_t)l * 2048 * 2048, MTOT, 2048, 2048};
            EpiOut E{ws, xl, xcl, args.out, l};
#if MK_P1_EARLY
            { pg8::Sched2 S; S.G = G; S.c = bx; S.nN1 = 8; S.nM1 = 64; S.nM2 = 0; S.nN2 = 0; S.pm2 = 0;
              pg8::gemm_phase<EpiOut, pg8::Sched2, true, true>(lds, g, S, E); }
            if (l + 1 < DEPTH) {
                xcd_barrier_arrive(bar, MISC + 24);
                if (tid_opaque() == 0) MISC[26] = atomicAdd((unsigned*)(ws + WS_CTL) + CW_CTXTICKET, 1u);
                __syncthreads();
                const int ticket = (int)MISC[26];
                if (ticket < 64) { pg8::Sched2 S; S.G = 64; S.c = ticket; S.nN1 = 0; S.nM1 = 0; S.nM2 = 8; S.nN2 = 8; S.pm2 = 64; S.id2 = true;
                    pg8::gemm_phase<EpiOut, pg8::Sched2, true, true>(lds, g, S, E);
                    if (P3_FLOW && tid_opaque() == 0) (void)xb_add((unsigned*)ctl + CW_CTXOUT, 1u); }
                xcd_barrier_wait(bar, MISC + 24);
                { const float* modl1 = modp + (size_t)(l + 1) * 9 * 6144; const float* nw = args.in[4] + (l + 1) * 2048; const int lane = tid_opaque() & 63;
                  const int wv = __builtin_amdgcn_readfirstlane(tid_opaque() >> 6); bool ctx_ready = false;
                  for (;;) { if (tid_opaque() == 0) MISC[18] = atomicAdd((unsigned*)(ws + WS_CTL) + CW_Q_P1, 1u); __syncthreads(); const int ch = (int)MISC[18]; __syncthreads(); if (ch >= (P3_FLOW ? MTOT : NLAT) / 32) break;
                      if (P3_FLOW && ch >= NLAT / 32 && !ctx_ready) {
                          if (tid_opaque() == 0) { unsigned sp_ = 0u; while (xb_ld((unsigned*)ctl + CW_CTXOUT) < 64u) { __builtin_amdgcn_s_sleep(2); if (++sp_ > XB_SPIN_CAP) break; }
                              __builtin_amdgcn_fence(__ATOMIC_ACQUIRE, "agent"); asm volatile("s_waitcnt vmcnt(0)" ::: "memory"); }
                          __syncthreads(); ctx_ready = true; }
                      { const float* modl = modl1; const float* xl = args.out; const float* xcl = XC1; (void)xcl; P1_ROWS(wv, 8, ch * 32, ch * 32 + 32); } } }
            }
#else
            { pg8::Sched2 S; S.G = G; S.c = bx; S.nN1 = 8; S.nM1 = (l == DEPTH - 1) ? 64 : 72; S.nM2 = 0; S.nN2 = 0; S.pm2 = 0;
              pg8::gemm_phase<EpiOut, pg8::Sched2, true, true>(lds, g, S, E); }
#endif
        }
        if (l + 1 < DEPTH) SEAM(P + 4);
        STAMP(P + 5);
    }
#undef IN
#undef SEAM
}


#ifdef VERIFY_PROBE
#ifndef VERIFY_SKIP_A
#define VERIFY_SKIP_A -1
#endif
#ifndef VERIFY_SKIP_B
#define VERIFY_SKIP_B -1
#endif
constexpr size_t WS_VER = WS_END;
constexpr int NVR = 16;
__device__ __constant__ int vrows[NVR] = {0, 1, 63, 64, 255, 256, 1000, 2047, 2048, 5000, 8191, 12345, 16383, 16384, 16500, 18431};
__device__ __forceinline__ void vf_err(float* errs, int id, float got, float exp, float scale) { (void)scale; const float df = got - exp; atomicAdd(errs + 2 * id, df * df); atomicAdd(errs + 2 * id + 1, exp * exp); }
__device__ __forceinline__ float vf_round(float x) { return __uint_as_float(f2bf(x) << 16); }
__device__ __forceinline__ float vf_block_sum(float v, float* red) {
    __syncthreads(); red[threadIdx.x] = v; __syncthreads();
    for (int s = 128; s > 0; s >>= 1) { if ((int)threadIdx.x < s) red[threadIdx.x] += red[threadIdx.x + s]; __syncthreads(); }
    const float r = red[0]; __syncthreads(); return r;
}
__device__ __forceinline__ float vf_block_max(float v, float* red) {
    __syncthreads(); red[threadIdx.x] = v; __syncthreads();
    for (int s = 128; s > 0; s >>= 1) { if ((int)threadIdx.x < s) red[threadIdx.x] = fmaxf(red[threadIdx.x], red[threadIdx.x + s]); __syncthreads(); }
    const float r = red[0]; __syncthreads(); return r;
}
__device__ __forceinline__ int vf_partner(int e) { const int q = e >> 4, i = e & 15; return q == 0 ? 16 + i : (q == 1 ? i : (q == 2 ? 48 + i : 32 + i)); }
__device__ __forceinline__ float vf_rope(float xe, float xp, int e, int pos) {
    const int q = e >> 4, i = e & 15; const float inv = powf(10000.0f, -(float)i / 16.0f); const float ang = (float)(q < 2 ? (pos >> 6) : (pos & 63)) * inv;
    const float rot = (q & 1) ? xp : -xp;
    return xe * cosf(ang) + rot * sinf(ang);
}
__global__ void __launch_bounds__(256) verify_kernel(Args args, int stage, int l) {
    __shared__ float sh[6400]; __shared__ float red[256]; __shared__ float sh2[2048];
    unsigned char* ws = args.ws; float* errs = (float*)(ws + WS_VER) + 64 * l; float* xsave = (float*)(ws + WS_VER) + 256;
    const int t = threadIdx.x, blk = blockIdx.x;
    const float* modl = (const float*)(ws + WS_MOD) + (size_t)l * 9 * 6144;
    if (stage == 0) {
        const int o = blk * 256 + t; if (o >= 9 * 64) return; const int ll = l, r = (o / 64) % 9, n = (o % 64) * 96 + 5;
        float acc = 0.f; for (int k = 0; k < 2048; ++k) { const float c = r < 8 ? args.in[1][r * 2048 + k] : args.in[3][k]; acc += c / (1.f + expf(-c)) * args.in[5][((size_t)ll * 2048 + k) * 6144 + n]; }
        acc += args.in[6][ll * 6144 + n]; vf_err(errs, 0, ((const float*)(ws + WS_MOD))[((size_t)ll * 9 + r) * 6144 + n], acc, 0.02f); return; }
    const int row = vrows[blk % NVR]; const bool lat = row < NLAT; const int b = lat ? row / 2048 : 8; const int pos = row & 2047;
    const float* xl = (l == 0) ? args.in[0] : args.out; const float* xcl = (l == 0) ? args.in[2] : (const float*)(ws + WS_XC1);
    const float* xr = lat ? xl + (size_t)row * 2048 : xcl + (size_t)(row - NLAT) * 2048;
    if (stage == 1) {
        float s = 0.f; for (int k = t; k < 2048; k += 256) s += xr[k] * xr[k]; s = vf_block_sum(s, red); const float rinv = 1.f / sqrtf(s / 2048.f + EPS);
        for (int k = t; k < 2048; k += 256) { const float e = xr[k] * rinv * args.in[4][l * 2048 + k] * (1.f + modl[b * 6144 + 2048 + k]) + modl[b * 6144 + k]; vf_err(errs, 1, bf2f(((const bf16_t*)(ws + WS_XN))[(size_t)row * 2048 + k]), e, 0.05f); }
        return; }
    if (stage == 2) {
        const bf16_t* xn = (const bf16_t*)(ws + WS_XN) + (size_t)row * 2048; for (int k = t; k < 2048; k += 256) sh2[k] = bf2f(xn[k]); __syncthreads();
        const float* W = args.in[7] + (size_t)l * 2048 * N_IN;
        for (int c = t; c < N_IN; c += 256) { float acc = 0.f; for (int k = 0; k < 2048; ++k) acc += sh2[k] * vf_round(W[(size_t)k * N_IN + c]); sh[c] = acc; } __syncthreads();
        const bool qok = lat || l == 0;
        for (int which = 0; which < 4; ++which) {
            const int base = which == 0 ? 0 : which == 1 ? 512 : which == 2 ? 1536 : 2304, nh = which == 0 ? 8 : which == 1 ? 8 : which == 2 ? 12 : 4;
            const float* nw = args.in[which == 0 ? 8 : which == 1 ? 9 : which == 2 ? 11 : 12] + l * 64; const float osc = (which == 0 || which == 2) ? C2_64 : 1.f; const bool rp = which >= 2 && lat;
            const bf16_t* dst = (const bf16_t*)(ws + (which == 0 ? WS_QA : which == 1 ? WS_KA : which == 2 ? WS_QB : WS_KB)); const int ld = nh * 64;
            if ((which == 0 || which == 2) && !qok) continue;
            for (int o = t; o < nh * 64; o += 256) { const int h = o >> 6, e = o & 63; const float* u = sh + base + h * 64; float ss = 0.f; for (int j = 0; j < 64; ++j) ss += u[j] * u[j]; const float rinv = 1.f / sqrtf(ss / 64.f + EPS);
                const int pe = vf_partner(e); const float xe = u[e] * rinv * nw[e], xp = u[pe] * rinv * nw[pe]; const float v = (rp ? vf_rope(xe, xp, e, pos) : xe) * osc;
                vf_err(errs, 2 + which, bf2f(dst[(size_t)row * ld + o]), v, 0.05f * osc); } }
        for (int o = t; o < 512; o += 256) vf_err(errs, 6, bf2f(((const bf16_t*)(ws + WS_VA))[(size_t)row * 512 + o]), sh[1024 + o], 0.05f);
        for (int o = t; o < 256; o += 256) vf_err(errs, 7, bf2f(((const bf16_t*)(ws + WS_VB))[(size_t)row * 256 + o]), sh[2560 + o], 0.05f);
        if (qok) for (int o = t; o < 768; o += 256) vf_err(errs, 8, bf2f(((const bf16_t*)(ws + WS_CQ))[(size_t)row * 768 + o]), sh[2816 + o], 0.05f);
        for (int o = t; o < 512; o += 256) vf_err(errs, 9, bf2f(((const bf16_t*)(ws + WS_CKV))[(size_t)row * 512 + o]), sh[3584 + o], 0.05f);
        for (int o = t; o < 64; o += 256) vf_err(errs, 10, ((const float*)(ws + WS_KPE))[(size_t)row * 64 + o], sh[4096 + o], 0.05f);
        if (qok) for (int o = t; o < 2048; o += 256) { const float z = sh[4160 + o]; vf_err(errs, 11, bf2f(((const bf16_t*)(ws + WS_ZS))[(size_t)row * 2048 + o]), z / (1.f + expf(-z)), 0.05f); }
        return; }
    if (stage == 3) {
        const bool qok = lat || l == 0;
        const bf16_t* cq = (const bf16_t*)(ws + WS_CQ) + (size_t)row * 768; const bf16_t* ckv = (const bf16_t*)(ws + WS_CKV) + (size_t)row * 512; const float* kpe = (const float*)(ws + WS_KPE) + (size_t)row * 64;
        float s1 = 0.f; for (int k = t; k < 768; k += 256) { const float v = bf2f(cq[k]); s1 += v * v; } s1 = vf_block_sum(s1, red); const float r1 = 1.f / sqrtf(s1 / 768.f + EPS);
        float s2 = 0.f; for (int k = t; k < 512; k += 256) { const float v = bf2f(ckv[k]); s2 += v * v; } s2 = vf_block_sum(s2, red); const float r2 = 1.f / sqrtf(s2 / 512.f + EPS);
        if (qok) {
            for (int k = t; k < 768; k += 256) sh2[k] = bf2f(cq[k]) * r1 * args.in[14][l * 768 + k]; __syncthreads();
            const float* W = args.in[16] + (size_t)l * 768 * 1152;
            for (int c = t; c < 1152; c += 256) { float acc = 0.f; for (int k = 0; k < 768; ++k) acc += sh2[k] * W[(size_t)k * 1152 + c]; sh[c] = acc; } __syncthreads();
            for (int o = t; o < 1152; o += 256) { const int h = o / 192, f = o % 192; const float* u = sh + h * 192; float ss = 0.f; for (int j = 0; j < 192; ++j) ss += u[j] * u[j]; const float rinv = 1.f / sqrtf(ss / 192.f + EPS);
                float v; if (f < 128 || !lat) v = u[f] * rinv * args.in[18][l * 192 + f]; else { const int e = f - 128, pe = vf_partner(e); v = vf_rope(u[128 + e] * rinv * args.in[18][l * 192 + 128 + e], u[128 + pe] * rinv * args.in[18][l * 192 + 128 + pe], e, pos); }
                vf_err(errs, 12, bf2f(((const bf16_t*)(ws + WS_QC))[(size_t)row * 1152 + o]), v * C2_192, 0.05f * C2_192); }
            __syncthreads(); }
        for (int k = t; k < 512; k += 256) sh2[k] = bf2f(ckv[k]) * r2 * args.in[15][l * 512 + k]; __syncthreads();
        const float* W = args.in[17] + (size_t)l * 512 * 1536;
        for (int c = t; c < 1536; c += 256) { float acc = 0.f; for (int k = 0; k < 512; ++k) acc += sh2[k] * W[(size_t)k * 1536 + c]; sh[c] = acc; } __syncthreads();
        for (int o = t; o < 6 * 192; o += 256) { const int h = o / 192, f = o % 192; const float* u = sh + h * 256; float ss = 0.f; for (int j = 0; j < 128; ++j) ss += u[j] * u[j]; for (int j = 0; j < 64; ++j) ss += kpe[j] * kpe[j]; const float rinv = 1.f / sqrtf(ss / 192.f + EPS);
            float v; if (f < 128) v = u[f] * rinv * args.in[19][l * 192 + f]; else { const int e = f - 128, pe = vf_partner(e); const float xe = kpe[e] * rinv * args.in[19][l * 192 + 128 + e], xp = kpe[pe] * rinv * args.in[19][l * 192 + 128 + pe]; v = lat ? vf_rope(xe, xp, e, pos) : xe; }
            vf_err(errs, 13, bf2f(((const bf16_t*)(ws + WS_KC))[(size_t)row * 1152 + o]), v, 0.05f); }
        for (int o = t; o < 768; o += 256) { const int h = o / 128, f = o % 128; vf_err(errs, 14, bf2f(((const bf16_t*)(ws + WS_VC))[(size_t)row * 768 + o]), sh[h * 256 + 128 + f], 0.05f); }
        return; }
    if (stage == 4) {
        const int grp = (blk / NVR) % 3, hs = blk / (3 * NVR);
        if (!lat && l == DEPTH - 1) return;
        const int nh = grp == 0 ? HA : grp == 1 ? HB : HC, h = hs == 0 ? 0 : (hs == 1 ? nh / 2 : nh - 1);
        const int dq = grp == 2 ? 192 : 64, dv = grp == 2 ? 128 : 64;
        const bf16_t* Q = (const bf16_t*)(ws + (grp == 0 ? WS_QA : grp == 1 ? WS_QB : WS_QC)); const int ldq = nh * dq;
        const bf16_t* K = (const bf16_t*)(ws + (grp == 0 ? WS_KA : grp == 1 ? WS_KB : WS_KC)); const bf16_t* V = (const bf16_t*)(ws + (grp == 0 ? WS_VA : grp == 1 ? WS_VB : WS_VC));
        const int kvh = grp == 1 ? h / 3 : h, ldk = grp == 0 ? 512 : grp == 1 ? 256 : 1152, ldv = grp == 0 ? 512 : grp == 1 ? 256 : 768;
        for (int j = t; j < dq; j += 256) sh2[j] = bf2f(Q[(size_t)row * ldq + h * dq + j]); __syncthreads();
        const int bb = lat ? b : (row - NLAT) / LC;
        const int r = pos >> 6, c = pos & 63; int rs = r - 4; rs = rs < 0 ? 0 : (rs > 24 ? 24 : rs); int qs = c - 8; qs = qs < 0 ? 0 : (qs > 48 ? 48 : qs);
        const int NK = 2048 + 256; float mx = -3e38f;
        for (int j = t; j < NK; j += 256) { float s = -INFINITY; bool ok; size_t krow;
            if (j < 2048) { krow = (size_t)bb * 2048 + j; const int kr = j >> 6, kc = j & 63;
                ok = lat && (grp == 2 || (grp == 1 && abs(pos - j) <= 128) || (grp == 0 && kr >= rs && kr < rs + 8 && kc >= qs && kc < qs + 16)); }
            else { krow = (size_t)NLAT + bb * LC + (j - 2048); ok = true; }
            if (ok) { float a = 0.f; for (int dd = 0; dd < dq; ++dd) a += sh2[dd] * bf2f(K[krow * ldk + kvh * dq + dd]); s = a;
                if (grp == 0 && j < 2048) s += args.in[10][(((size_t)l * HA + h) * 15 + ((j >> 6) - r + 7)) * 31 + ((j & 63) - c + 15)] * LOG2E; }
            sh[j] = s; mx = fmaxf(mx, s); }
        const float snk = grp == 1 ? args.in[13][l * HB + h] * LOG2E : -INFINITY; mx = fmaxf(vf_block_max(mx, red), snk);
        float ls = 0.f; for (int j = t; j < NK; j += 256) { const float p = exp2f(sh[j] - mx); sh[j] = p; ls += p; } ls = vf_block_sum(ls, red) + exp2f(snk - mx);
        for (int dd = t; dd < dv; dd += 256) { float o = 0.f; for (int j = 0; j < NK; ++j) { if (sh[j] != 0.f) { const size_t krow = j < 2048 ? (size_t)bb * 2048 + j : (size_t)NLAT + bb * LC + (j - 2048); o += sh[j] * bf2f(V[krow * ldv + kvh * dv + dd]); } }
            const int col = (grp == 0 ? 0 : grp == 1 ? 512 : 1280) + h * dv + dd; const float y = o / ls * bf2f(((const bf16_t*)(ws + WS_ZS))[(size_t)row * 2048 + col]);
            vf_err(errs, 15 + grp + (lat ? 0 : 3), bf2f(((const bf16_t*)(ws + WS_XN))[(size_t)row * 2048 + col]), y, 0.02f); }
        return; }
    if (stage == 5) {
        if (lat || l == 0) for (int k = t; k < 2048; k += 256) { xsave[(blk % NVR) * 2048 + k] = xr[k]; xsave[(NVR + blk % NVR) * 2048 + k] = bf2f(((const bf16_t*)(ws + WS_XN))[(size_t)row * 2048 + k]); }
        return; }
    if (stage == 6) {
        if (!lat && l == DEPTH - 1) return;
        for (int k = t; k < 2048; k += 256) sh2[k] = xsave[(NVR + blk % NVR) * 2048 + k]; __syncthreads();
        const float* W = args.in[20] + (size_t)l * 2048 * 2048; const float* got = lat ? args.out + (size_t)row * 2048 : (const float*)(ws + WS_XC1) + (size_t)(row - NLAT) * 2048;
        for (int c = t; c < 2048; c += 256) { float acc = 0.f; for (int k = 0; k < 2048; ++k) acc += sh2[k] * vf_round(W[(size_t)k * 2048 + c]); const float dl = modl[b * 6144 + 4096 + c] * acc;
            vf_err(errs, 21, got[c] - xsave[(blk % NVR) * 2048 + c], dl, 0.f); }
        return; }
}
__global__ void __launch_bounds__(256) verify_inject(Args args) {
    float* errs = (float*)(args.ws + WS_VER); float emax = 0.f; int imax = 0;
    for (int i = 0; i < 64; ++i) { const float e = sqrtf(errs[2 * i] / (errs[2 * i + 1] + 1e-30f)); if (i == VERIFY_SKIP_A || i == VERIFY_SKIP_B) continue; if (!(e <= emax)) { emax = e; imax = i; } }
    if (!(emax < 1e3f)) emax = 1e3f;
#ifdef VERIFY_ID_A
    { float ea = sqrtf(errs[2 * VERIFY_ID_A] / (errs[2 * VERIFY_ID_A + 1] + 1e-30f)), eb = sqrtf(errs[2 * VERIFY_ID_B] / (errs[2 * VERIFY_ID_B + 1] + 1e-30f)); if (!(ea < 1e3f)) ea = 1e3f; if (!(eb < 90.f)) eb = 90.f; emax = ea; imax = (int)(eb * 100.f) / 100;
      const size_t n = (size_t)NLAT * DM; const float add = sqrtf(emax);
      for (size_t i = (size_t)blockIdx.x * 256 + threadIdx.x; i < n; i += (size_t)gridDim.x * 256) { float v = args.in[0][i] + add; if (i == 12345) v += 100.f * (1.f + eb); args.out[i] = v; } return; }
#endif
    const size_t n = (size_t)NLAT * DM; const float add = sqrtf(emax);
    for (size_t i = (size_t)blockIdx.x * 256 + threadIdx.x; i < n; i += (size_t)gridDim.x * 256) { float v = args.in[0][i] + add; if (i == 12345) v += 1.0f * (float)(imax + 1); args.out[i] = v; }
}
#endif


#ifdef STAMP_PROBE
#ifndef STAMP_ASCALE
#define STAMP_ASCALE 0.01f
#endif
#ifndef STAMP_BSCALE
#define STAMP_BSCALE 3e-5f
#endif
__global__ void __launch_bounds__(256) stamp_inject(Args args) {
    const unsigned long long* ts = (const unsigned long long*)(args.ws + WS_END);
    const float Ta = (float)(ts[STAMP_A1] - ts[STAMP_A0]) * 0.01f, Tb = (float)(ts[STAMP_B1] - ts[STAMP_B0]) * 0.01f;
    const size_t n = (size_t)NLAT * DM; const float add = Tb * STAMP_BSCALE;
    for (size_t i = (size_t)blockIdx.x * 256 + threadIdx.x; i < n; i += (size_t)gridDim.x * 256) { float v = args.out[i] + add; if (i == 12345) v += Ta * STAMP_ASCALE; args.out[i] = v; }
}
#endif

extern "C" void kernel_launch(void* const* d_in, const int* in_sizes, int n_in, void* d_out, int out_size, void* d_ws, size_t ws_size, hipStream_t stream) {
    static int grid = 0;
    if (grid == 0) {
        if (n_in != 21 || in_sizes[0] != NLAT * DM || out_size != NLAT * DM || ws_size < WS_END) {
            fprintf(stderr, "kernel_launch: shape/workspace mismatch: n_in %d in0 %d out %d ws %zu (need %zu)\n", n_in, n_in > 0 ? in_sizes[0] : -1, out_size, ws_size, (size_t)WS_END); grid = -1; return; }
        int dev = 0, cus = 0, per_cu = 0;
        if (hipGetDevice(&dev) != hipSuccess || hipDeviceGetAttribute(&cus, hipDeviceAttributeMultiprocessorCount, dev) != hipSuccess) { grid = -1; return; }
        if (hipFuncSetAttribute((const void*)hymba_fwd, hipFuncAttributeMaxDynamicSharedMemorySize, LDS_BYTES) != hipSuccess) { fprintf(stderr, "kernel_launch: hipFuncSetAttribute failed\n"); grid = -1; return; }
        if (hipOccupancyMaxActiveBlocksPerMultiprocessor(&per_cu, (const void*)hymba_fwd, 512, LDS_BYTES) != hipSuccess || per_cu < 1) { fprintf(stderr, "kernel_launch: occupancy query says %d blocks per CU\n", per_cu); }
        (void)hipGetLastError();
        grid = cus;
    }
    if (grid < 0) return;
    (void)hipMemsetAsync((char*)d_ws + WS_CTL, 0, CTL_ZERO_BYTES, stream);
    Args a{};
    for (int i = 0; i < 21; ++i) a.in[i] = (const float*)d_in[i];
    a.out = (float*)d_out; a.ws = (unsigned char*)d_ws;
#ifdef VERIFY_PROBE
    (void)hipMemsetAsync((char*)d_ws + WS_VER, 0, 512, stream);
    for (int p = 0; p < 11; ++p) { a.ph_lo = p; a.ph_hi = p + 1; const int l = p == 0 ? 0 : (p - 1) / 5, k = p == 0 ? 0 : (p - 1) % 5 + 1;
        if (k == 5) hipLaunchKernelGGL(verify_kernel, dim3(NVR), dim3(256), 0, stream, a, 5, l);
        hipLaunchKernelGGL(hymba_fwd, dim3(grid), dim3(512), LDS_BYTES, stream, a);
        if (k == 0) hipLaunchKernelGGL(verify_kernel, dim3(3), dim3(256), 0, stream, a, 0, 0);
        if (p == 2) hipLaunchKernelGGL(verify_kernel, dim3(3), dim3(256), 0, stream, a, 0, 1);
        else if (k == 4) hipLaunchKernelGGL(verify_kernel, dim3(NVR * 9), dim3(256), 0, stream, a, 4, l);
        else if (k == 5) hipLaunchKernelGGL(verify_kernel, dim3(NVR), dim3(256), 0, stream, a, 6, l);
        else hipLaunchKernelGGL(verify_kernel, dim3(NVR), dim3(256), 0, stream, a, k, l); }
    hipLaunchKernelGGL(verify_inject, dim3(2048), dim3(256), 0, stream, a);
#else
    if (MK_N_LAUNCHES == 1) { a.ph_lo = 0; a.ph_hi = 11; hipLaunchKernelGGL(hymba_fwd, dim3(grid), dim3(512), LDS_BYTES, stream, a); }
    else { for (int p = 0; p < 11; ++p) { a.ph_lo = p; a.ph_hi = p + 1; hipLaunchKernelGGL(hymba_fwd, dim3(grid), dim3(512), LDS_BYTES, stream, a); } }
#endif
#ifdef STAMP_PROBE
    hipLaunchKernelGGL(stamp_inject, dim3(2048), dim3(256), 0, stream, a);
#endif
    const hipError_t le = hipPeekAtLastError();
    if (le != hipSuccess) fprintf(stderr, "kernel_launch: launch failed: %s\n", hipGetErrorName(le));
}
```

```cpp
#include <hip/hip_runtime.h>
#include <hip/hip_bf16.h>
#include <cstdio>
#include <cstdint>

#ifndef LAUNDER_EPI_WS
#define LAUNDER_EPI_WS 1
#endif
#ifndef LAUNDER_LDS
#define LAUNDER_LDS 0
#endif
#ifndef P0_ADA_SHARE
#define P0_ADA_SHARE 0
#endif
#ifndef PREP_A
#define PREP_A 3456
#endif
#ifndef PREP_B
#define PREP_B 1152
#endif
#ifndef EARLY_Q
#define EARLY_Q 0
#endif
#ifndef P3_FLOW
#define P3_FLOW 1
#endif
#ifndef ATT_NPRE
#define ATT_NPRE 512
#endif
#ifndef MK_N_LAUNCHES
#define MK_N_LAUNCHES 1
#endif

constexpr int BATCH = 8, SEQ = 2048, DM = 2048, LC = 256, DEPTH = 2;
constexpr int NLAT = BATCH * SEQ;
constexpr int NCTX = BATCH * LC;
constexpr int MTOT = NLAT + NCTX;
constexpr int N_IN = 6208, NT_IN = 25;
constexpr int HA = 8, HB = 12, HKVB = 4, HC = 6;
constexpr int QLORA = 768, KVLORA = 512;
constexpr float EPS = 1e-6f;
constexpr float LOG2E = 1.4426950408889634f;
constexpr float C2_64 = 0.125f * LOG2E;
constexpr float C2_192 = 0.07216878364870323f * LOG2E;

constexpr size_t al256(size_t x) { return (x + 255) / 256 * 256; }
constexpr size_t WS_CTL = 0, CTL_ZERO_BYTES = 1u << 20;
constexpr size_t CTL_SSQ_OFF = 65536;
constexpr size_t WS_MOD = CTL_ZERO_BYTES;
constexpr size_t WS_ROPE = WS_MOD + al256((size_t)2 * 9 * 6144 * 4);
constexpr size_t WS_WIN = WS_ROPE + (size_t)2048 * 64 * 4;
constexpr size_t WS_WOUT = WS_WIN + (size_t)2 * 6400 * 2048 * 2;
constexpr size_t WS_WQB = WS_WOUT + (size_t)2 * 2048 * 2048 * 2;
constexpr size_t WS_WKVB = WS_WQB + (size_t)2 * 1536 * 768 * 2;
constexpr size_t WS_XN = WS_WKVB + (size_t)2 * 1536 * 512 * 2;
constexpr size_t WS_QA = WS_XN + (size_t)MTOT * 2048 * 2;
constexpr size_t WS_KA = WS_QA + (size_t)MTOT * 512 * 2;
constexpr size_t WS_VA = WS_KA + (size_t)MTOT * 512 * 2;
constexpr size_t WS_QB = WS_VA + (size_t)MTOT * 512 * 2;
constexpr size_t WS_KB = WS_QB + (size_t)MTOT * 768 * 2;
constexpr size_t WS_VB = WS_KB + (size_t)MTOT * 256 * 2;
constexpr size_t WS_CQ = WS_VB + (size_t)MTOT * 256 * 2;
constexpr size_t WS_CKV = WS_CQ + (size_t)MTOT * 768 * 2;
constexpr size_t WS_KPE = WS_CKV + (size_t)MTOT * 512 * 2;
constexpr size_t WS_SSQK = WS_KPE + (size_t)MTOT * 64 * 4;
constexpr size_t WS_ZS = WS_SSQK + al256((size_t)MTOT * 4);
constexpr size_t WS_QC = WS_ZS + (size_t)MTOT * 2048 * 2;
constexpr size_t WS_KC = WS_QC + (size_t)MTOT * 1152 * 2;
constexpr size_t WS_VC = WS_KC + (size_t)MTOT * 1152 * 2;
constexpr size_t WS_XC1 = WS_VC + (size_t)MTOT * 768 * 2;
constexpr size_t WS_KPR = WS_XC1 + (size_t)NCTX * 2048 * 4;
constexpr size_t WS_END = WS_KPR + (size_t)MTOT * 64 * 2;
static_assert(WS_END + (1u << 20) <= 536870912ull, "workspace map must fit 512 MiB");
static_assert(CTL_SSQ_OFF + (size_t)4 * MTOT * 4 <= (size_t)98304 * 4 && ((size_t)98304 + 11 * 3456) * 4 <= CTL_ZERO_BYTES, "control-word map");
constexpr int CW_TMO = 0, CW_QUEUE = 64  , CW_MB = 256  , CW_Q_CVT = 320  , CW_Q_ADA1 = 512  , CW_Q_P1 = 576  , CW_RT = 2048  , CW_CTXOUT = 1216  , CW_ADA0 = 1152  , CW_P3DONE = 1024  , CW_P2DONE = 896  , CW_P3IN = 768  , CW_CQDONE = 704  , CW_CTXTICKET = 640  , CW_BAR = 98304  ;

constexpr int RING_BYTES = 131072;
constexpr int LDS_BYTES = 147456;
constexpr int LDSCTL_OFF = LDS_BYTES - 1024;
constexpr int XCH_OFF = LDS_BYTES - 1024 - 4096;
constexpr int ATT_LDS_END = XCH_OFF;


#define GAS __attribute__((address_space(1)))
#define LAS __attribute__((address_space(3)))
typedef unsigned short bf16_t;
typedef short bf16x8 __attribute__((ext_vector_type(8)));
typedef short s16x4 __attribute__((ext_vector_type(4)));
typedef float f32x4 __attribute__((ext_vector_type(4)));
typedef float f32x16 __attribute__((ext_vector_type(16)));
typedef unsigned u32x4 __attribute__((ext_vector_type(4)));
typedef unsigned u32x2 __attribute__((ext_vector_type(2)));

__device__ __forceinline__ int launder_s(int x) { asm volatile("" : "+s"(x)); return x; }
__device__ __forceinline__ int tid_opaque() { int t = threadIdx.x; asm volatile("" : "+v"(t)); return t; }
typedef float f32x2_t __attribute__((ext_vector_type(2))); typedef __bf16 bf16x2_t __attribute__((ext_vector_type(2)));
__device__ __forceinline__ unsigned cvt_pk_bf16(float lo, float hi) { const f32x2_t v = {lo, hi}; return __builtin_bit_cast(unsigned, __builtin_convertvector(v, bf16x2_t)); }
__device__ __forceinline__ float bf2f(unsigned short b) { return __uint_as_float(((unsigned)b) << 16); }
__device__ __forceinline__ float silu_f(float v) { return v * __builtin_amdgcn_rcpf(1.0f + __builtin_amdgcn_exp2f(-v * LOG2E)); }

extern __shared__ __attribute__((aligned(16))) unsigned char lds_[];
__device__ __forceinline__ LAS unsigned char* lds_base() { return (LAS unsigned char*)lds_; }
namespace pg8 {
#define PG8_LAS __attribute__((address_space(3)))
constexpr int BM = 256, BK = 64, HALF = 128, HTB = HALF * BK * 2, STAGE_BYTES = 8 * HTB, NXCD = 8, WGM = 8;
__host__ __device__ __forceinline__ int lds_byte(int r, int c) { const int st = (r >> 4) * 2 + (c >> 5), rr = r & 15, cc = c & 31, ob = rr * 64 + cc * 2; return st * 1024 + (ob ^ (((ob >> 9) & 1) << 5)); }
__host__ __device__ __forceinline__ void stage_rc(int b, int& R, int& C) { const int st = b / 1024, sb = b % 1024, swz = sb ^ (((sb >> 9) & 1) << 5); R = (st >> 1) * 16 + swz / 64; C = (st & 1) * 32 + (swz % 64) / 2; }
__host__ __device__ __forceinline__ int perm32(int rho) { const int n = rho >> 4, i = rho & 15; return 8 * (i >> 2) + 4 * n + (i & 3); }
struct Unit { int pm, pn; };
struct Gemm { const bf16_t* A; const bf16_t* Bt; int M, N, K; };

__host__ __device__ __forceinline__ int ctx_pn(int j) { return j < 4 ? 2 + j : (j < 6 ? 5 + j : 8 + j); }
__host__ __device__ __forceinline__ void grid_map(int L, int nM, int nN, int& pm, int& pn) {
    const int nwg = nM * nN; int wgid = L; { const int q = nwg / NXCD, r = nwg % NXCD, xcd = wgid % NXCD, off = wgid / NXCD; wgid = (xcd < r ? xcd * (q + 1) : r * (q + 1) + (xcd - r) * q) + off; }
    const int nig = WGM * nN, gid = wgid / nig, fm = gid * WGM, gsz = (nM - fm) < WGM ? (nM - fm) : WGM;
    pm = fm + ((wgid % nig) % gsz); pn = (wgid % nig) / gsz;
}
struct Sched2 {
    int nM1, nN1, nM2, nN2, pm2, G, c; bool id2 = false;
    unsigned* sig = nullptr; int sig_pm = -1, sig_pn = -1;
    int rk_idle = 0, rk_off3 = 0;
    int twoA = 0;
    int cut = 0x7fffffff; bool swap8 = false;
    __device__ __forceinline__ bool next(int i, Unit& u) const {
        if (rk_idle > 0) {
            const int n = nM1 * nN1; int L;
            if (i == 0) L = c; else if (i == 1) L = c < rk_idle ? G + c : n; else if (i == 2) L = (c >= rk_off3 && c < rk_idle) ? G + rk_idle + (c - rk_off3) : n; else L = n;
            if (L >= n) return false;
            grid_map(L, nM1, nN1, u.pm, u.pn); return true;
        }
        if (twoA > 0) {
            const int a1 = nM1 * 6, a2 = nM2 * 3, b1 = nM1 * 19, b2 = nM2 * 6; int L = i * G + c, j;
            if (L >= cut) return false;
            if (L < a1) { grid_map(L, nM1, 6, u.pm, j); u.pn = 11 + j; return true; }
            L -= a1;
            if (L < a2) { int pm; grid_map(L, nM2, 3, pm, j); u.pm = pm2 + pm; u.pn = 14 + j; return true; }
            L -= a2;
            if (L < b1) { grid_map(L, nM1, 19, u.pm, j); if (swap8 && j == 18 && u.pm >= 64) grid_map(b1 - 8 + (u.pm - 64), nM1, 19, u.pm, j); u.pn = j < 11 ? j : j + 6; return true; }
            L -= b1;
            if (L < b2) { int pm; grid_map(L, nM2, 6, pm, j); u.pm = pm2 + pm; u.pn = j < 4 ? 2 + j : 5 + j; return true; }
            return false;
        }
        const int L = i * G + c, n1 = nM1 * nN1, n2 = nM2 * nN2;
        if (L >= cut) return false;
        if (L < n1) { grid_map(L, nM1, nN1, u.pm, u.pn); if (swap8 && u.pn == nN1 - 1 && u.pm >= 64) grid_map(cut + (u.pm - 64), nM1, nN1, u.pm, u.pn); return true; }
        if (L < n1 + n2) { int pm, pj; grid_map(L - n1, nM2, nN2, pm, pj); u.pm = pm2 + pm; u.pn = id2 ? pj : ctx_pn(pj); return true; }
        return false;
    }
    unsigned* rt = nullptr; unsigned rt_need = 26u;
    __device__ __forceinline__ void a_ready(const Unit& u) const {
        if (rt != nullptr && tid_opaque() == 0) { unsigned sp_ = 0u; while (__hip_atomic_load(rt + u.pm, __ATOMIC_RELAXED, __HIP_MEMORY_SCOPE_AGENT) < rt_need) { __builtin_amdgcn_s_sleep(2); if (++sp_ > (1u << 22)) break; }
            __builtin_amdgcn_fence(__ATOMIC_ACQUIRE, "agent"); asm volatile("s_waitcnt vmcnt(0)" ::: "memory"); }
    }
    __device__ __forceinline__ void done(const Unit& u) const {
        if (sig != nullptr && u.pm == sig_pm && u.pn == sig_pn) { asm volatile("s_waitcnt vmcnt(0)" ::: "memory");
            if ((tid_opaque() & 63) == 0) { LAS unsigned* wc_ = (LAS unsigned*)(lds_base() + LDSCTL_OFF) + 20;
                if (__hip_atomic_fetch_add(wc_, 1u, __ATOMIC_RELAXED, __HIP_MEMORY_SCOPE_WORKGROUP) == 7u) { *wc_ = 0u; (void)__hip_atomic_fetch_add(sig, 1u, __ATOMIC_RELAXED, __HIP_MEMORY_SCOPE_AGENT); } } }
    }
};

struct SchedOne {
    int pm, pn;
    __device__ __forceinline__ bool next(int i, Unit& u) const { if (i == 0) { u.pm = pm; u.pn = pn; return true; } return false; }
    __device__ __forceinline__ void a_ready(const Unit&) const {}
    __device__ __forceinline__ void done(const Unit&) const {}
};

template <class Epi, class Sched, bool ALIGN_EPI = false, bool SP2 = false>
__device__ __forceinline__ void gemm_phase(PG8_LAS unsigned char* lds, const Gemm g, const Sched& S, const Epi& E) {
    const int tid = tid_opaque(), wid = __builtin_amdgcn_readfirstlane(tid >> 6), lane = tid & 63, wr = wid >> 2, wc = wid & 3, fr = lane & 15, fq = lane >> 4;
    const int K = g.K, nt = K / BK;
    unsigned voffA[2], voffB[2];
#pragma unroll
    for (int i = 0; i < 2; ++i) { int R, C; stage_rc(tid * 16 + i * 8192, R, C); const int Rb = Epi::PERM ? ((R & ~31) + perm32(R & 31)) : R;
        voffA[i] = (unsigned)(R * K + C) * 2u; voffB[i] = (unsigned)(Rb * K + C) * 2u; }
    const size_t kstep = (size_t)(BK * 2);
    const size_t hstep = (size_t)HALF * K * 2;
    const size_t tstep = 2 * hstep;
    const unsigned ldsw = (unsigned)wid * 1024u;
    const int aoff = lds_byte(wr * 64 + fr, fq * 8), boff = lds_byte(wc * 32 + fr, fq * 8);
#define PG8_SA(b, h) (((b) * 2 + (h)) * HTB)
#define PG8_SB(b, h) ((4 + (b) * 2 + (h)) * HTB)
#define PG8_STAGE(bufoff, gbase, voff) do { _Pragma("unroll") for (int _i = 0; _i < 2; ++_i) \
        __builtin_amdgcn_global_load_lds((const unsigned*)((const char*)(gbase) + (voff)[_i]), (PG8_LAS unsigned*)(lds + (bufoff) + ldsw + _i * 8192), 16, 0, 0); } while (0)
#define PG8_LDA(dst, b, h) do { _Pragma("unroll") for (int m = 0; m < 4; ++m) _Pragma("unroll") for (int k = 0; k < 2; ++k) dst[m][k] = *(const PG8_LAS bf16x8*)(lds + PG8_SA(b, h) + aoff + m * 2048 + k * 1024); } while (0)
#define PG8_LDB(dst, b, h) do { _Pragma("unroll") for (int n = 0; n < 2; ++n) _Pragma("unroll") for (int k = 0; k < 2; ++k) dst[n][k] = *(const PG8_LAS bf16x8*)(lds + PG8_SB(b, h) + boff + n * 2048 + k * 1024); } while (0)
#define PG8_MMA(ai, bj, At, Bt) do { __builtin_amdgcn_s_setprio(1); _Pragma("unroll") for (int m = 0; m < 4; ++m) _Pragma("unroll") for (int n = 0; n < 2; ++n) _Pragma("unroll") for (int k = 0; k < 2; ++k) \
        acc[ai][bj][m][n] = __builtin_amdgcn_mfma_f32_16x16x32_bf16(Bt[n][k], At[m][k], acc[ai][bj][m][n], 0, 0, 0); __builtin_amdgcn_s_setprio(0); } while (0)
#define PG8_WAIT_V(n) asm volatile("s_waitcnt vmcnt(" #n ")" ::: "memory")
#define PG8_WAIT_L(n) asm volatile("s_waitcnt lgkmcnt(" #n ")" ::: "memory")
#define PG8_BAR __builtin_amdgcn_s_barrier()
#define PG8_SCHED __builtin_amdgcn_sched_barrier(0)
    Unit cur, nxt; int ui = 0;
    if (!S.next(0, cur)) return;
    f32x4 acc[2][2][4][2];
#pragma unroll
    for (int a = 0; a < 2; ++a)
#pragma unroll
        for (int b = 0; b < 2; ++b)
#pragma unroll
            for (int m = 0; m < 4; ++m)
#pragma unroll
                for (int n = 0; n < 2; ++n) acc[a][b][m][n] = (f32x4){0.f, 0.f, 0.f, 0.f};
    bf16x8 At[4][2], B0[2][2], B1[2][2];
    const char* cA = (const char*)g.A + (size_t)cur.pm * tstep; const char* cB = (const char*)g.Bt + (size_t)cur.pn * tstep;
    S.a_ready(cur); PG8_BAR;
    if constexpr (SP2) {
        PG8_STAGE(PG8_SB(0, 0), cB, voffB); PG8_STAGE(PG8_SB(0, 1), cB + hstep, voffB); PG8_STAGE(PG8_SA(0, 0), cA, voffA); PG8_STAGE(PG8_SA(0, 1), cA + hstep, voffA);
        if (wr == 1) PG8_BAR;
        PG8_WAIT_V(2); PG8_BAR;
        PG8_STAGE(PG8_SB(1, 0), cB + kstep, voffB); PG8_STAGE(PG8_SA(1, 0), cA + kstep, voffA); PG8_STAGE(PG8_SB(1, 1), cB + hstep + kstep, voffB);
        PG8_WAIT_V(6); PG8_BAR;
    } else {
        PG8_STAGE(PG8_SB(0, 0), cB, voffB); PG8_STAGE(PG8_SA(0, 0), cA, voffA); PG8_STAGE(PG8_SB(0, 1), cB + hstep, voffB); PG8_STAGE(PG8_SA(0, 1), cA + hstep, voffA);
        if (wr == 1) PG8_BAR;
        PG8_WAIT_V(4); PG8_BAR;
        PG8_STAGE(PG8_SB(1, 0), cB + kstep, voffB); PG8_STAGE(PG8_SA(1, 0), cA + kstep, voffA); PG8_STAGE(PG8_SB(1, 1), cB + hstep + kstep, voffB);
        PG8_WAIT_V(6); PG8_BAR;
    }
    for (;;) {
        const bool has_next = S.next(ui + 1, nxt);
        const char* nA = has_next ? (const char*)g.A + (size_t)nxt.pm * tstep : cA; const char* nB = has_next ? (const char*)g.Bt + (size_t)nxt.pn * tstep : cB;
        for (int t = 0; t < nt; t += 2) {
            const bool last = (t == nt - 2);
            const char* a1 = cA + (size_t)(t + 1) * kstep;
            const char* a2 = last ? nA : cA + (size_t)(t + 2) * kstep; const char* b2 = last ? nB : cB + (size_t)(t + 2) * kstep;
            const char* a3 = a2 + kstep; const char* b3 = b2 + kstep;
            if (last && has_next) S.a_ready(nxt);
            if constexpr (SP2) {
            PG8_LDB(B0, 0, 0); PG8_LDB(B1, 0, 1); PG8_SCHED; PG8_LDA(At, 0, 0); PG8_STAGE(PG8_SA(1, 1), a1 + hstep, voffA);
            PG8_WAIT_V(8); PG8_WAIT_L(0); PG8_BAR; PG8_MMA(0, 0, At, B0); PG8_MMA(0, 1, At, B1); PG8_BAR; PG8_SCHED;
            PG8_LDA(At, 0, 1); PG8_STAGE(PG8_SB(0, 0), b2, voffB); PG8_STAGE(PG8_SB(0, 1), b2 + hstep, voffB); PG8_STAGE(PG8_SA(0, 0), a2, voffA);
            PG8_WAIT_V(8); PG8_WAIT_L(0); PG8_BAR; PG8_MMA(1, 0, At, B0); PG8_MMA(1, 1, At, B1); PG8_BAR; PG8_SCHED;
            PG8_LDB(B0, 1, 0); PG8_LDB(B1, 1, 1); PG8_SCHED; PG8_LDA(At, 1, 0); PG8_STAGE(PG8_SA(0, 1), a2 + hstep, voffA);
            PG8_WAIT_V(8); PG8_WAIT_L(0); PG8_BAR; PG8_MMA(0, 0, At, B0); PG8_MMA(0, 1, At, B1); PG8_BAR; PG8_SCHED;
            PG8_LDA(At, 1, 1); PG8_STAGE(PG8_SB(1, 0), b3, voffB); PG8_STAGE(PG8_SB(1, 1), b3 + hstep, voffB); PG8_STAGE(PG8_SA(1, 0), a3, voffA);
            PG8_WAIT_V(8); PG8_WAIT_L(0); PG8_BAR; PG8_MMA(1, 0, At, B0); PG8_MMA(1, 1, At, B1); PG8_BAR; PG8_SCHED;
            } else {
            PG8_LDB(B0, 0, 0); PG8_SCHED; PG8_LDA(At, 0, 0); PG8_STAGE(PG8_SA(1, 1), a1 + hstep, voffA);
            PG8_WAIT_L(8); PG8_BAR; PG8_WAIT_L(0); PG8_MMA(0, 0, At, B0); PG8_BAR; PG8_SCHED;
            PG8_LDB(B1, 0, 1); PG8_STAGE(PG8_SB(0, 0), b2, voffB);
            PG8_BAR; PG8_WAIT_L(0); PG8_MMA(0, 1, At, B1); PG8_BAR;
            PG8_LDA(At, 0, 1); PG8_STAGE(PG8_SA(0, 0), a2, voffA);
            PG8_BAR; PG8_WAIT_L(0); PG8_MMA(1, 0, At, B0); PG8_BAR; PG8_SCHED;
            PG8_STAGE(PG8_SB(0, 1), b2 + hstep, voffB);
            PG8_WAIT_V(6); PG8_BAR; PG8_MMA(1, 1, At, B1); PG8_BAR;
            PG8_LDB(B0, 1, 0); PG8_SCHED; PG8_LDA(At, 1, 0); PG8_STAGE(PG8_SA(0, 1), a2 + hstep, voffA);
            PG8_WAIT_L(8); PG8_BAR; PG8_WAIT_L(0); PG8_MMA(0, 0, At, B0); PG8_BAR; PG8_SCHED;
            PG8_LDB(B1, 1, 1); PG8_STAGE(PG8_SB(1, 0), b3, voffB);
            PG8_BAR; PG8_WAIT_L(0); PG8_MMA(0, 1, At, B1); PG8_BAR;
            PG8_LDA(At, 1, 1); PG8_STAGE(PG8_SA(1, 0), a3, voffA);
            PG8_BAR; PG8_WAIT_L(0); PG8_MMA(1, 0, At, B0); PG8_BAR; PG8_SCHED;
            PG8_STAGE(PG8_SB(1, 1), b3 + hstep, voffB);
            PG8_WAIT_V(6); PG8_BAR; PG8_MMA(1, 1, At, B1); PG8_BAR;
            }
        }
        if constexpr (ALIGN_EPI) { if (wr == 0) PG8_BAR; }
        E(acc, cur, wr, wc, fr, fq); S.done(cur);
        if (!has_next) break;
#pragma unroll
        for (int a = 0; a < 2; ++a)
#pragma unroll
            for (int b = 0; b < 2; ++b)
#pragma unroll
                for (int m = 0; m < 4; ++m)
#pragma unroll
                    for (int n = 0; n < 2; ++n) acc[a][b][m][n] = (f32x4){0.f, 0.f, 0.f, 0.f};
        cur = nxt; cA = nA; cB = nB; ++ui;
        if constexpr (ALIGN_EPI) { if (wr == 1) PG8_BAR; }
    }
    PG8_WAIT_V(0);
    if constexpr (!ALIGN_EPI) { if (wr == 0) PG8_BAR; }
    PG8_BAR;
#undef PG8_SA
#undef PG8_SB
#undef PG8_STAGE
#undef PG8_LDA
#undef PG8_LDB
#undef PG8_MMA
#undef PG8_WAIT_V
#undef PG8_WAIT_L
#undef PG8_BAR
#undef PG8_SCHED
}
}

typedef f32x4 Acc[2][2][4][2];
extern __shared__ __attribute__((aligned(16))) unsigned char lds_[];
__device__ __forceinline__ LAS float* xch_ptr() { return (LAS float*)((LAS unsigned char*)lds_ + XCH_OFF); }

struct RopeFreq { float inv[8]; };
__device__ __forceinline__ RopeFreq rope_freq(int fq) { RopeFreq f;
#pragma unroll
    for (int j = 0; j < 8; ++j) f.inv[j] = __builtin_amdgcn_exp2f(-(float)(8 * (fq & 1) + j) * 0.83048202372184059f);
    return f; }
__device__ __forceinline__ void rope16(float (&y)[16], const RopeFreq& f, int pos, int fq) {
    asm volatile("" : "+v"(pos) :: "memory");
    const float pc[2] = {(float)(pos >> 6), (float)(pos & 63)};
#pragma unroll
    for (int bj = 0; bj < 2; ++bj)
#pragma unroll
        for (int j = 0; j < 8; ++j) { const int i = bj * 8 + j; (void)f; const float inv = __builtin_amdgcn_exp2f(-(float)(8 * (fq & 1) + j) * 0.83048202372184059f);
            const float rev = (pc[bj] * inv) * 0.15915494309189535f;
            const float c = __builtin_amdgcn_cosf(rev), sn = __builtin_amdgcn_sinf(rev);
            auto rr = __builtin_amdgcn_permlane32_swap(__float_as_uint(y[i]), __float_as_uint(y[i]), false, false);
            const float rot = (fq < 2) ? -__uint_as_float(rr[1]) : __uint_as_float(rr[0]); y[i] = y[i] * c + rot * sn;
            if ((j & 3) == 3) __builtin_amdgcn_sched_barrier(0); }
}
__device__ __forceinline__ void store16_bf16_wt(__amdgpu_buffer_rsrc_t rsrc, unsigned byte_off  , const float (&y)[16], int fq) {
#pragma unroll
    for (int bj = 0; bj < 2; ++bj) { u32x4 w; w.x = cvt_pk_bf16(y[bj * 8 + 0], y[bj * 8 + 1]); w.y = cvt_pk_bf16(y[bj * 8 + 2], y[bj * 8 + 3]); w.z = cvt_pk_bf16(y[bj * 8 + 4], y[bj * 8 + 5]); w.w = cvt_pk_bf16(y[bj * 8 + 6], y[bj * 8 + 7]);
        __builtin_amdgcn_raw_buffer_store_b128(w, rsrc, byte_off + (unsigned)(bj * 32 + fq * 8) * 2u, 0,   16); }
}
__device__ __forceinline__ void store16_bf16(bf16_t* rowp  , const float (&y)[16], int fq) {
#pragma unroll
    for (int bj = 0; bj < 2; ++bj) { u32x4 w; w.x = cvt_pk_bf16(y[bj * 8 + 0], y[bj * 8 + 1]); w.y = cvt_pk_bf16(y[bj * 8 + 2], y[bj * 8 + 3]); w.z = cvt_pk_bf16(y[bj * 8 + 4], y[bj * 8 + 5]); w.w = cvt_pk_bf16(y[bj * 8 + 6], y[bj * 8 + 7]);
        *(u32x4*)(rowp + bj * 32 + fq * 8) = w; }
}
template <int XM> __device__ __forceinline__ float swz_xor(float v) { return __int_as_float(__builtin_amdgcn_ds_swizzle(__float_as_int(v), (XM << 10) | 0x1F)); }
__device__ __forceinline__ float sum_xor32(float v) { auto r = __builtin_amdgcn_permlane32_swap(__float_as_uint(v), __float_as_uint(v), false, false); return __uint_as_float(r[0]) + __uint_as_float(r[1]); }
__device__ __forceinline__ float quad_sum(float s) { s += swz_xor<16>(s); return sum_xor32(s); }

struct EpiNull {
    static constexpr bool PERM = true; unsigned char* ws;
    __device__ __forceinline__ void operator()(const Acc& acc, const pg8::Unit& u, int wr, int wc, int fr, int fq) const {
        float s_ = 0.f;
#pragma unroll
        for (int a_ = 0; a_ < 2; ++a_)
#pragma unroll
            for (int b_ = 0; b_ < 2; ++b_)
#pragma unroll
                for (int m_ = 0; m_ < 4; ++m_)
#pragma unroll
                    for (int n_ = 0; n_ < 2; ++n_) s_ += acc[a_][b_][m_][n_][0] + acc[a_][b_][m_][n_][1] + acc[a_][b_][m_][n_][2] + acc[a_][b_][m_][n_][3];
        if (s_ == 1.2345e-30f) ((float*)(ws + WS_SSQK))[u.pm * 256 + wr * 64 + fr + wc + fq] = s_;
    }
};
struct EpiIn {
    static constexpr bool PERM = true;
    unsigned char* ws; const float *qn_a, *kn_a, *qn_b, *kn_b, *kn_c; int l;
    __device__ __forceinline__ void operator()(const Acc& acc, const pg8::Unit& u, int wr, int wc, int fr, int fq_in) const {
#if LAUNDER_EPI_WS
        GAS unsigned char* wsl_ = (GAS unsigned char*)this->ws; asm volatile("" : "+s"(wsl_)); unsigned char* const ws = (unsigned char*)wsl_;
#endif
        int fq = fq_in; asm volatile("" : "+v"(fq));
        const int pn = u.pn, row0 = u.pm * 256 + wr * 64 + fr; const bool lat = u.pm < NLAT / 256;
        const __amdgpu_buffer_rsrc_t wsr = __builtin_amdgcn_make_buffer_rsrc((void*)ws, 0, (int)WS_END, 0x00020000);
#ifdef EPI_NULL
        { float s_ = 0.f; for (int a_ = 0; a_ < 2; ++a_) for (int b_ = 0; b_ < 2; ++b_) for (int m_ = 0; m_ < 4; ++m_) for (int n_ = 0; n_ < 2; ++n_) s_ += acc[a_][b_][m_][n_][0]; if (s_ == 1.2345e-30f) ((float*)(ws + WS_SSQK))[row0] = s_; return; }
#endif
        if (pn < 4 || (pn >= 6 && pn <= 9)) {
            const LAS float* nw; unsigned dst; int ld, head; float osc = 1.f; bool rp = false; const LAS float* wl = xch_ptr();
            if (pn < 2) { nw = wl; dst = (unsigned)WS_QA; ld = 512; head = pn * 4 + wc; osc = C2_64; }
            else if (pn < 4) { nw = wl + 64; dst = (unsigned)WS_KA; ld = 512; head = (pn - 2) * 4 + wc; }
            else if (pn < 9) { nw = wl + 128; dst = (unsigned)WS_QB; ld = 768; head = (pn - 6) * 4 + wc; osc = C2_64; rp = lat; }
            else { nw = wl + 192; dst = (unsigned)WS_KB; ld = 256; head = wc; rp = lat; }
            const RopeFreq rf = rope_freq(fq); float w[16];
#pragma unroll
            for (int bj = 0; bj < 2; ++bj)
#pragma unroll
                for (int n = 0; n < 2; ++n) { const f32x4 t4 = *(const LAS f32x4*)(nw + bj * 32 + fq * 8 + n * 4); w[bj * 8 + n * 4 + 0] = t4[0] * osc; w[bj * 8 + n * 4 + 1] = t4[1] * osc; w[bj * 8 + n * 4 + 2] = t4[2] * osc; w[bj * 8 + n * 4 + 3] = t4[3] * osc; }
#pragma unroll
            for (int ai = 0; ai < 2; ++ai)
#pragma unroll
                for (int m = 0; m < 4; ++m) {
                    const int row = row0 + ai * 128 + m * 16; float y[16]; float s = 0.f;
#pragma unroll
                    for (int bj = 0; bj < 2; ++bj)
#pragma unroll
                        for (int n = 0; n < 2; ++n)
#pragma unroll
                            for (int t = 0; t < 4; ++t) { const float v = acc[ai][bj][m][n][t]; y[bj * 8 + n * 4 + t] = v; s += v * v; }
                    s = quad_sum(s); const float rinv = __builtin_amdgcn_rsqf(s * (1.0f / 64.0f) + EPS);
#pragma unroll
                    for (int i = 0; i < 16; ++i) y[i] = y[i] * rinv * w[i];
                    if (rp) rope16(y, rf, row & (SEQ - 1), fq);
                    store16_bf16_wt(wsr, dst + (unsigned)(row * ld + head * 64) * 2u, y, fq);
                    __builtin_amdgcn_sched_barrier(0);
                }
            return;
        }
        if (pn == 16) {
            if (wc != 0) return;
            const RopeFreq rf = rope_freq(fq); float w[16];
#pragma unroll
            for (int bj = 0; bj < 2; ++bj)
#pragma unroll
                for (int n = 0; n < 2; ++n) { const f32x4 t4 = *(const LAS f32x4*)(xch_ptr() + 256 + 128 + bj * 32 + fq * 8 + n * 4); w[bj * 8 + n * 4 + 0] = t4[0]; w[bj * 8 + n * 4 + 1] = t4[1]; w[bj * 8 + n * 4 + 2] = t4[2]; w[bj * 8 + n * 4 + 3] = t4[3]; }
#pragma unroll
            for (int ai = 0; ai < 2; ++ai)
#pragma unroll
                for (int m = 0; m < 4; ++m) {
                    const int row = row0 + ai * 128 + m * 16; float s = 0.f; float y[16];
#pragma unroll
                    for (int bj = 0; bj < 2; ++bj)
#pragma unroll
                        for (int n = 0; n < 2; ++n) { const f32x4 v = acc[ai][bj][m][n]; s += (v[0] * v[0] + v[1] * v[1]) + (v[2] * v[2] + v[3] * v[3]); *(f32x4*)((float*)(ws + WS_KPE) + (size_t)row * 64 + bj * 32 + fq * 8 + n * 4) = v;
#pragma unroll
                            for (int t = 0; t < 4; ++t) y[bj * 8 + n * 4 + t] = v[t] * w[bj * 8 + n * 4 + t]; }
                    s = quad_sum(s); if (fq == 0) __hip_atomic_store((GAS float*)(ws + WS_SSQK) + row, s, __ATOMIC_RELAXED, __HIP_MEMORY_SCOPE_AGENT);
                    if (lat) rope16(y, rf, row & (SEQ - 1), fq);
                    store16_bf16_wt(wsr, (unsigned)WS_KPR + (unsigned)(row * 64) * 2u, y, fq);
                    __builtin_amdgcn_sched_barrier(0);
                }
            return;
        }
        unsigned dst; int ld, col0; float* ssq = nullptr; const bool act = pn >= 17;
        if (pn < 6) { dst = (unsigned)WS_VA; ld = 512; col0 = (pn - 4) * 256; }
        else if (pn == 10) { dst = (unsigned)WS_VB; ld = 256; col0 = 0; }
        else if (pn < 14) { dst = (unsigned)WS_CQ; ld = 768; col0 = (pn - 11) * 256; ssq = (float*)(ws + CTL_SSQ_OFF) + (size_t)l * MTOT; }
        else if (pn < 16) { dst = (unsigned)WS_CKV; ld = 512; col0 = (pn - 14) * 256; ssq = (float*)(ws + CTL_SSQ_OFF) + (size_t)(2 + l) * MTOT; }
        else { dst = (unsigned)WS_ZS; ld = 2048; col0 = (pn - 17) * 256; }
#pragma unroll
        for (int ai = 0; ai < 2; ++ai)
#pragma unroll
            for (int m = 0; m < 4; ++m) {
                const int row = row0 + ai * 128 + m * 16; float y[16]; float s = 0.f;
#pragma unroll
                for (int bj = 0; bj < 2; ++bj)
#pragma unroll
                    for (int n = 0; n < 2; ++n)
#pragma unroll
                        for (int t = 0; t < 4; ++t) { float v = acc[ai][bj][m][n][t]; s += v * v; if (act) v = silu_f(v); y[bj * 8 + n * 4 + t] = v; }
                store16_bf16_wt(wsr, dst + (unsigned)(row * ld + col0 + wc * 64) * 2u, y, fq);
                if (ssq) { s = quad_sum(s); if (fq == 0) atomicAdd(ssq + row, s); }
                __builtin_amdgcn_sched_barrier(0);
            }
    }
};

struct EpiQC {
    static constexpr bool PERM = true;
    unsigned char* ws; const float* qn_c; int l;
    __device__ __forceinline__ void operator()(const Acc& acc, const pg8::Unit& u, int wr, int wc, int fr, int fq_in) const {
#if LAUNDER_EPI_WS
        GAS unsigned char* wsl_ = (GAS unsigned char*)this->ws; asm volatile("" : "+s"(wsl_)); unsigned char* const ws = (unsigned char*)wsl_;
#endif
        int fq = fq_in; asm volatile("" : "+v"(fq));
        const int hc = u.pn, row0 = u.pm * 256 + wr * 64 + fr; const bool lat = u.pm < NLAT / 256;
        const __amdgpu_buffer_rsrc_t wsr = __builtin_amdgcn_make_buffer_rsrc((void*)ws, 0, (int)WS_END, 0x00020000);
        const float* ssq_cq = (const float*)(ws + CTL_SSQ_OFF) + (size_t)l * MTOT; LAS float* xch = xch_ptr();
        float r1v[8];
#pragma unroll
        for (int i = 0; i < 8; ++i) r1v[i] = ssq_cq[row0 + (i >> 2) * 128 + (i & 3) * 16];
#pragma unroll
        for (int i = 0; i < 8; ++i) r1v[i] = __builtin_amdgcn_rsqf(r1v[i] * (1.0f / 768.0f) + EPS);
#pragma unroll
        for (int ai = 0; ai < 2; ++ai)
#pragma unroll
            for (int m = 0; m < 4; ++m) {
                float r1 = r1v[ai * 4 + m]; asm volatile("" : "+v"(r1) :: "memory"); float s = 0.f;
#pragma unroll
                for (int bj = 0; bj < 2; ++bj)
#pragma unroll
                    for (int n = 0; n < 2; ++n) { const f32x4 v = acc[ai][bj][m][n] * r1; s += (v[0] * v[0] + v[1] * v[1]) + (v[2] * v[2] + v[3] * v[3]); }
                s = quad_sum(s); if (fq == 0) xch[(wr * 64 + ai * 128 + m * 16 + fr) * 4 + wc] = s;
                __builtin_amdgcn_sched_barrier(0);
            }
        asm volatile("s_waitcnt lgkmcnt(0)" ::: "memory"); __builtin_amdgcn_s_barrier(); asm volatile("" ::: "memory");
        if (wc == 3) return;
        const RopeFreq rfq = rope_freq(fq); float w[16];
#pragma unroll
        for (int bj = 0; bj < 2; ++bj)
#pragma unroll
            for (int n = 0; n < 2; ++n) { const f32x4 t4 = *(const f32x4*)(qn_c + wc * 64 + bj * 32 + fq * 8 + n * 4); w[bj * 8 + n * 4 + 0] = t4[0] * C2_192; w[bj * 8 + n * 4 + 1] = t4[1] * C2_192; w[bj * 8 + n * 4 + 2] = t4[2] * C2_192; w[bj * 8 + n * 4 + 3] = t4[3] * C2_192; }
#pragma unroll
        for (int ai = 0; ai < 2; ++ai)
#pragma unroll
            for (int m = 0; m < 4; ++m) {
                const int row = row0 + ai * 128 + m * 16; const f32x4 ps = *(const LAS f32x4*)(xch + (wr * 64 + ai * 128 + m * 16 + fr) * 4);
                float r1 = r1v[ai * 4 + m]; asm volatile("" : "+v"(r1) :: "memory");
                const float r2 = __builtin_amdgcn_rsqf(((ps[0] + ps[1]) + (ps[2] + ps[3])) * (1.0f / 192.0f) + EPS) * r1; float y[16];
#pragma unroll
                for (int bj = 0; bj < 2; ++bj)
#pragma unroll
                    for (int n = 0; n < 2; ++n)
#pragma unroll
                        for (int t = 0; t < 4; ++t) y[bj * 8 + n * 4 + t] = acc[ai][bj][m][n][t] * r2 * w[bj * 8 + n * 4 + t];
                if (wc == 2 && lat) rope16(y, rfq, row & (SEQ - 1), fq);
                store16_bf16_wt(wsr, (unsigned)WS_QC + (unsigned)(row * 1152 + hc * 192 + wc * 64) * 2u, y, fq);
                __builtin_amdgcn_sched_barrier(0);
            }
    }
};
struct EpiKVC {
    static constexpr bool PERM = true;
    unsigned char* ws; const float* kn_c; int l;
    __device__ __forceinline__ void operator()(const Acc& acc, const pg8::Unit& u, int wr, int wc, int fr, int fq_in) const {
#if LAUNDER_EPI_WS
        GAS unsigned char* wsl_ = (GAS unsigned char*)this->ws; asm volatile("" : "+s"(wsl_)); unsigned char* const ws = (unsigned char*)wsl_;
#endif
        int fq = fq_in; asm volatile("" : "+v"(fq));
        const int hc = u.pn, row0 = u.pm * 256 + wr * 64 + fr; const bool lat = u.pm < NLAT / 256;
        const __amdgpu_buffer_rsrc_t wsr = __builtin_amdgcn_make_buffer_rsrc((void*)ws, 0, (int)WS_END, 0x00020000);
        const float* ssq_ckv = (const float*)(ws + CTL_SSQ_OFF) + (size_t)(2 + l) * MTOT; LAS float* xch = xch_ptr();
        float r1v[8], skv[8];
#pragma unroll
        for (int i = 0; i < 8; ++i) { r1v[i] = ssq_ckv[row0 + (i >> 2) * 128 + (i & 3) * 16]; skv[i] = ((const float*)(ws + WS_SSQK))[row0 + (i >> 2) * 128 + (i & 3) * 16]; }
#pragma unroll
        for (int i = 0; i < 8; ++i) r1v[i] = __builtin_amdgcn_rsqf(r1v[i] * (1.0f / 512.0f) + EPS);
        if (wc < 2) {
#pragma unroll
        for (int ai = 0; ai < 2; ++ai)
#pragma unroll
            for (int m = 0; m < 4; ++m) {
                float r1 = r1v[ai * 4 + m]; asm volatile("" : "+v"(r1) :: "memory");
                { float s = 0.f;
#pragma unroll
                    for (int bj = 0; bj < 2; ++bj)
#pragma unroll
                        for (int n = 0; n < 2; ++n) { const f32x4 v = acc[ai][bj][m][n] * r1; s += (v[0] * v[0] + v[1] * v[1]) + (v[2] * v[2] + v[3] * v[3]); }
                    s = quad_sum(s); if (fq == 0) xch[(wr * 64 + ai * 128 + m * 16 + fr) * 4 + wc] = s; }
                __builtin_amdgcn_sched_barrier(0);
            }
        }
        asm volatile("s_waitcnt lgkmcnt(0)" ::: "memory"); __builtin_amdgcn_s_barrier(); asm volatile("" ::: "memory");
        if (wc == 3) {
#pragma unroll
            for (int ai = 0; ai < 2; ++ai)
#pragma unroll
                for (int m = 0; m < 4; ++m) { const int row = row0 + ai * 128 + m * 16; float y[16]; float r1 = r1v[ai * 4 + m]; asm volatile("" : "+v"(r1) :: "memory");
#pragma unroll
                    for (int bj = 0; bj < 2; ++bj)
#pragma unroll
                        for (int n = 0; n < 2; ++n)
#pragma unroll
                            for (int t = 0; t < 4; ++t) y[bj * 8 + n * 4 + t] = acc[ai][bj][m][n][t] * r1;
                    store16_bf16_wt(wsr, (unsigned)WS_VC + (unsigned)(row * 768 + hc * 128 + 64) * 2u, y, fq); __builtin_amdgcn_sched_barrier(0); }
            return;
        }
        float w[16];
#pragma unroll
        for (int bj = 0; bj < 2; ++bj)
#pragma unroll
            for (int n = 0; n < 2; ++n) { const f32x4 t4 = *(const f32x4*)(kn_c + wc * 64 + bj * 32 + fq * 8 + n * 4); w[bj * 8 + n * 4 + 0] = t4[0]; w[bj * 8 + n * 4 + 1] = t4[1]; w[bj * 8 + n * 4 + 2] = t4[2]; w[bj * 8 + n * 4 + 3] = t4[3]; }
        if (wc < 2) {
#pragma unroll
            for (int ai = 0; ai < 2; ++ai)
#pragma unroll
                for (int m = 0; m < 4; ++m) {
                    const int row = row0 + ai * 128 + m * 16; const f32x4 ps = *(const LAS f32x4*)(xch + (wr * 64 + ai * 128 + m * 16 + fr) * 4);
                    float rk = __builtin_amdgcn_rsqf((ps[0] + ps[1] + skv[ai * 4 + m]) * (1.0f / 192.0f) + EPS) * r1v[ai * 4 + m]; asm volatile("" : "+v"(rk) :: "memory"); float y[16];
#pragma unroll
                    for (int bj = 0; bj < 2; ++bj)
#pragma unroll
                        for (int n = 0; n < 2; ++n)
#pragma unroll
                            for (int t = 0; t < 4; ++t) y[bj * 8 + n * 4 + t] = acc[ai][bj][m][n][t] * rk * w[bj * 8 + n * 4 + t];
                    store16_bf16_wt(wsr, (unsigned)WS_KC + (unsigned)(row * 1152 + hc * 192 + wc * 64) * 2u, y, fq);
                    __builtin_amdgcn_sched_barrier(0);
                }
            return;
        }
#pragma unroll
        for (int ai = 0; ai < 2; ++ai)
#pragma unroll
            for (int m = 0; m < 4; ++m) { const int row = row0 + ai * 128 + m * 16; float y[16]; float r1 = r1v[ai * 4 + m]; asm volatile("" : "+v"(r1) :: "memory");
#pragma unroll
                for (int bj = 0; bj < 2; ++bj)
#pragma unroll
                    for (int n = 0; n < 2; ++n)
#pragma unroll
                        for (int t = 0; t < 4; ++t) y[bj * 8 + n * 4 + t] = acc[ai][bj][m][n][t] * r1;
                store16_bf16_wt(wsr, (unsigned)WS_VC + (unsigned)(row * 768 + hc * 128) * 2u, y, fq); __builtin_amdgcn_sched_barrier(0); }
#pragma unroll
        for (int hb = 0; hb < 2; ++hb) {
            u32x4 kr[4][2];
#pragma unroll
            for (int m = 0; m < 4; ++m)
#pragma unroll
                for (int bj = 0; bj < 2; ++bj) kr[m][bj] = *(const u32x4*)((const bf16_t*)(ws + WS_KPR) + (size_t)(row0 + hb * 128 + m * 16) * 64 + bj * 32 + fq * 8);
            __builtin_amdgcn_sched_barrier(0);
#pragma unroll
            for (int m = 0; m < 4; ++m) {
                const int row = row0 + hb * 128 + m * 16; const f32x4 ps = *(const LAS f32x4*)(xch + (wr * 64 + hb * 128 + m * 16 + fr) * 4);
                float rk = __builtin_amdgcn_rsqf((ps[0] + ps[1] + skv[hb * 4 + m]) * (1.0f / 192.0f) + EPS); asm volatile("" : "+v"(rk) :: "memory"); float y[16];
#pragma unroll
                for (int bj = 0; bj < 2; ++bj)
#pragma unroll
                    for (int j = 0; j < 4; ++j) { y[bj * 8 + 2 * j] = __uint_as_float(kr[m][bj][j] << 16) * rk; y[bj * 8 + 2 * j + 1] = __uint_as_float(kr[m][bj][j] & 0xffff0000u) * rk; }
                store16_bf16_wt(wsr, (unsigned)WS_KC + (unsigned)(row * 1152 + hc * 192 + 128) * 2u, y, fq);
                __builtin_amdgcn_sched_barrier(0);
            }
        }
    }
};
struct EpiOut {
    static constexpr bool PERM = true;
    unsigned char* ws; const float *xin, *cin; float* xout; int l;
    __device__ __forceinline__ void operator()(const Acc& acc, const pg8::Unit& u, int wr, int wc, int fr, int fq) const {
        const bool lat = u.pm < NLAT / 256; const int rowt = u.pm * 256 + wr * 64 + fr; const int b = lat ? (u.pm >> 3) : 8;
        const float* src = lat ? xin : cin; float* dst = lat ? xout : (float*)(ws + WS_XC1); const float* modl = (const float*)(ws + WS_MOD) + (size_t)l * 9 * 6144; const int rbase = lat ? rowt : rowt - NLAT;
        const int col0 = u.pn * 256 + wc * 64 + fq * 8; const float* gp = modl + (size_t)b * 6144 + 4096 + col0;
        f32x4 g[2][2];
#pragma unroll
        for (int bj = 0; bj < 2; ++bj)
#pragma unroll
            for (int n = 0; n < 2; ++n) g[bj][n] = *(const f32x4*)(gp + bj * 32 + n * 4);
        f32x4 xr[3][2][2];
#define XLD(slot_, i_) do { const size_t off_ = (size_t)(rbase + ((i_) >> 2) * 128 + ((i_) & 3) * 16) * 2048 + col0; \
            _Pragma("unroll") for (int bj = 0; bj < 2; ++bj) _Pragma("unroll") for (int n = 0; n < 2; ++n) xr[slot_][bj][n] = *(const f32x4*)(src + off_ + bj * 32 + n * 4); } while (0)
        XLD(0, 0); XLD(1, 1); XLD(2, 2);
        __builtin_amdgcn_sched_barrier(0);
#pragma unroll
        for (int i = 0; i < 8; ++i) { const int ai = i >> 2, m = i & 3; const size_t off = (size_t)(rbase + ai * 128 + m * 16) * 2048 + col0;
#pragma unroll
            for (int bj = 0; bj < 2; ++bj)
#pragma unroll
                for (int n = 0; n < 2; ++n) { const f32x4 v_ = xr[i % 3][bj][n] + g[bj][n] * acc[ai][bj][m][n];
                    if (lat) *(f32x4*)(dst + off + bj * 32 + n * 4) = v_;
                    else __builtin_amdgcn_raw_buffer_store_b128(__builtin_bit_cast(u32x4, v_), __builtin_amdgcn_make_buffer_rsrc((void*)ws, 0, (int)WS_END, 0x00020000), (unsigned)WS_XC1 + (unsigned)(off + bj * 32 + n * 4) * 4u, 0, 16); }
            __builtin_amdgcn_sched_barrier(0);
            if (i + 3 < 8) { XLD(i % 3, i + 3); __builtin_amdgcn_sched_barrier(0); }
        }
#undef XLD
    }
};

__device__ __forceinline__ int crow(int r, int hi) { return (r & 3) + 8 * (r >> 2) + 4 * hi; }
template <int OFF> __device__ __forceinline__ s16x4 tr_read(int vb) { s16x4 r; asm volatile("ds_read_b64_tr_b16 %0, %1 offset:%2" : "=&v"(r) : "v"(vb), "i"(OFF) : "memory"); return r; }
__device__ __forceinline__ int v_rd_base(int lane) { return ((lane & 3) << 3) | (((lane >> 2) & 3) << 6) | (((lane >> 4) & 1) << 5) | (((lane >> 5) & 1) << 8); }
template <int DV> __device__ __forceinline__ int v_st(int k, int c) { const int kk = (k & ~0xC) | ((k & 4) << 1) | ((k & 8) >> 1); return ((kk >> 3) * (DV / 32) + (c >> 5)) * 512 + ((kk & 7) * 32 + (c & 31)) * 2; }
typedef short v4i16_t __attribute__((ext_vector_type(4)));
__device__ __forceinline__ s16x4 vtr(const LAS char* p) { return __builtin_bit_cast(s16x4, __builtin_amdgcn_ds_read_tr16_b64_v4i16((LAS v4i16_t*)p)); }
template <int DV, int D0> __device__ __forceinline__ void pv_one(f32x16& od, int vb, bf16x8 pa0, bf16x8 pa1, bf16x8 pa2, bf16x8 pa3) {
    constexpr int KS = (DV / 32) * 1024, HF = (DV / 32) * 512;
    const s16x4 l0 = tr_read<D0 * 512 + 0 * KS>(vb), h0 = tr_read<D0 * 512 + 0 * KS + HF>(vb), l1 = tr_read<D0 * 512 + 1 * KS>(vb), h1 = tr_read<D0 * 512 + 1 * KS + HF>(vb);
    const s16x4 l2 = tr_read<D0 * 512 + 2 * KS>(vb), h2 = tr_read<D0 * 512 + 2 * KS + HF>(vb), l3 = tr_read<D0 * 512 + 3 * KS>(vb), h3 = tr_read<D0 * 512 + 3 * KS + HF>(vb);
    asm volatile("s_waitcnt lgkmcnt(0)" ::: "memory"); __builtin_amdgcn_sched_barrier(0);
#define PK(L, H) (bf16x8){L[0], L[1], L[2], L[3], H[0], H[1], H[2], H[3]}
    od = __builtin_amdgcn_mfma_f32_32x32x16_bf16(pa0, PK(l0, h0), od, 0, 0, 0);
    od = __builtin_amdgcn_mfma_f32_32x32x16_bf16(pa1, PK(l1, h1), od, 0, 0, 0);
    od = __builtin_amdgcn_mfma_f32_32x32x16_bf16(pa2, PK(l2, h2), od, 0, 0, 0);
    od = __builtin_amdgcn_mfma_f32_32x32x16_bf16(pa3, PK(l3, h3), od, 0, 0, 0);
#undef PK
}

enum { MK_NONE = 0, MK_NA = 1, MK_SWA = 2 };
__device__ __forceinline__ unsigned char* ws_from_kernarg() {
#if defined(__HIP_DEVICE_COMPILE__)
    return (unsigned char*)((const __attribute__((address_space(4))) unsigned long long*)__builtin_amdgcn_kernarg_segment_ptr())[22];
#else
    return nullptr;
#endif
}
struct AttnDesc {
    const bf16_t *Q, *Kc, *Vc, *Kl, *Vl;
    int ldq, ldk, ldv;
    int lt0, nlt;
    int mask;
    int q0;
    float m0, l0;
    const float* bias;
    const bf16_t* Z; bf16_t* Y;
};
constexpr float THRL = 8.0f;

template <int DQK, int DV>
__device__ __forceinline__ void attn_unit(const AttnDesc& d, LAS unsigned char* lds) {
    constexpr int KB_BYTES = 64 * DQK * 2, VB_BYTES = 64 * DV * 2, KCH = DQK / 8, VCH = DV / 8, NKL = KCH * 64 / 512, NVL = VCH * 64 / 512, ND0 = DQK / 16, NDV = DV / 32;
    constexpr int OFF_V = 2 * KB_BYTES, OFF_WS = OFF_V + 2 * VB_BYTES, OFF_BIAS = OFF_WS + 8 * 64 * 4;
    static_assert(OFF_BIAS + 2048 <= RING_BYTES, "attention LDS");
    const int tid = tid_opaque(), lane = tid & 63, r32 = lane & 31, hi = lane >> 5; const int wid = __builtin_amdgcn_readfirstlane(tid >> 6);
    LAS float* wsf = (LAS float*)(lds + OFF_WS) + wid * 64;
    LAS float* biasl = (LAS float*)(lds + OFF_BIAS);
    const int NT = 4 + d.nlt;
    int wlo = 0, whi = 0x7fffffff, wrow = 0;
    if (d.mask == MK_NA) { wrow = (d.q0 >> 6) + (wid >> 1); int rs = wrow - 4; rs = rs < 0 ? 0 : (rs > 24 ? 24 : rs); wlo = rs; whi = rs + 7; }
    else if (d.mask == MK_SWA) { const int qw = d.q0 + 32 * wid; wlo = (qw - 128) >> 6; whi = (qw + 31 + 128) >> 6; }
    if (d.mask == MK_NA) { for (int i = tid; i < 15 * 31; i += 512) biasl[i] = d.bias[i] * LOG2E; }
    bf16x8 qr[ND0];
    { const bf16_t* qp = d.Q + (size_t)(wid * 32 + r32) * d.ldq + hi * 8;
#pragma unroll
      for (int d0 = 0; d0 < ND0; ++d0) qr[d0] = *(const bf16x8*)(qp + d0 * 16); }
    float m_reg = d.m0, l_reg = d.l0; f32x16 o[NDV];
#pragma unroll
    for (int i = 0; i < NDV; ++i) o[i] = f32x16{};
    bf16x8 ks[NKL], vs[NVL];
    const int vb0 = (int)(unsigned)(size_t)(lds + OFF_V) + v_rd_base(lane);
#define TILE_K(t) ((t) < 4 ? d.Kc + (size_t)((t) * 64) * d.ldk : d.Kl + (size_t)((d.lt0 + (t) - 4) * 64) * d.ldk)
#define TILE_V(t) ((t) < 4 ? d.Vc + (size_t)((t) * 64) * d.ldv : d.Vl + (size_t)((d.lt0 + (t) - 4) * 64) * d.ldv)
#define SLOADK(t) do { const bf16_t* kp_ = TILE_K(t); \
      _Pragma("unroll") for (int i_ = 0; i_ < NKL; ++i_) { const int c_ = tid + 512 * i_; ks[i_] = *(const bf16x8*)(kp_ + (size_t)(c_ / KCH) * d.ldk + (c_ % KCH) * 8); } } while (0)
#define SLOADV(t) do { const bf16_t* vp_ = TILE_V(t); \
      _Pragma("unroll") for (int i_ = 0; i_ < NVL; ++i_) { const int c_ = tid + 512 * i_; vs[i_] = *(const bf16x8*)(vp_ + (size_t)(c_ / VCH) * d.ldv + (c_ % VCH) * 8); } } while (0)
#define SWRITEK(b) do { \
      _Pragma("unroll") for (int i_ = 0; i_ < NKL; ++i_) { const int c_ = tid + 512 * i_, row_ = c_ / KCH, ch_ = c_ % KCH; *(LAS bf16x8*)(lds + (b) * KB_BYTES + row_ * (DQK * 2) + ((ch_ * 16) ^ (((row_ >> 1) & 7) << 4))) = ks[i_]; } } while (0)
#define SWRITEV(b) do { \
      _Pragma("unroll") for (int i_ = 0; i_ < NVL; ++i_) { const int c_ = tid + 512 * i_; *(LAS bf16x8*)(lds + OFF_V + (b) * VB_BYTES + v_st<DV>(c_ / VCH, (c_ % VCH) * 8)) = vs[i_]; } } while (0)
    SLOADK(0); SLOADV(0); SWRITEK(0); SWRITEV(0); __syncthreads();
    for (int t = 0; t < NT; ++t) {
        const int buf = t & 1;
        if (t + 1 < NT) SLOADK(t + 1);
        const int lt = d.lt0 + t - 4;
        const bool active = (t < 4) || (lt >= wlo && lt <= whi);
        f32x16 p0 = f32x16{}, p1 = f32x16{};
        if (active) {
            { const LAS unsigned char* kb = lds + buf * KB_BYTES;
              const int sw = ((r32 >> 1) & 7) << 4;
#pragma unroll
              for (int d0 = 0; d0 < ND0; ++d0) { const int cb = (d0 * 16 + hi * 8) * 2;
                  const bf16x8 b0 = *(const LAS bf16x8*)(kb + r32 * (DQK * 2) + (cb ^ sw));
                  const bf16x8 b1 = *(const LAS bf16x8*)(kb + (32 + r32) * (DQK * 2) + (cb ^ sw));
                  p0 = __builtin_amdgcn_mfma_f32_32x32x16_bf16(b0, qr[d0], p0, 0, 0, 0);
                  p1 = __builtin_amdgcn_mfma_f32_32x32x16_bf16(b1, qr[d0], p1, 0, 0, 0); } }
        }
        if (t + 1 < NT) { SWRITEK(buf ^ 1); SLOADV(t + 1); }
        if (active) {
            if (t >= 4) {
                if (d.mask == MK_NA) {
                    const int c = (wid & 1) * 32 + r32; int qs = c - 8; qs = qs < 0 ? 0 : (qs > 48 ? 48 : qs);
                    const LAS float* brow = biasl + (lt - wrow + 7) * 31 + (15 - c);
#pragma unroll
                    for (int r = 0; r < 16; ++r) { const int k0 = crow(r, hi), k1 = k0 + 32;
                        p0[r] = (k0 >= qs && k0 < qs + 16) ? p0[r] + brow[k0] : -INFINITY;
                        p1[r] = (k1 >= qs && k1 < qs + 16) ? p1[r] + brow[k1] : -INFINITY; }
                } else if (d.mask == MK_SWA) {
                    const int qi = d.q0 + 32 * wid + r32, kbse = lt * 64;
#pragma unroll
                    for (int r = 0; r < 16; ++r) { const int k0 = kbse + crow(r, hi), k1 = k0 + 32; const int d0_ = qi - k0, d1_ = qi - k1;
                        if (d0_ > 128 || d0_ < -128) p0[r] = -INFINITY; if (d1_ > 128 || d1_ < -128) p1[r] = -INFINITY; }
                }
            }
            float pmax = p0[0];
#pragma unroll
            for (int r = 1; r < 16; ++r) pmax = fmaxf(pmax, p0[r]);
#pragma unroll
            for (int r = 0; r < 16; ++r) pmax = fmaxf(pmax, p1[r]);
            { auto rr = __builtin_amdgcn_permlane32_swap(__float_as_uint(pmax), __float_as_uint(pmax), false, false); pmax = fmaxf(__uint_as_float(rr[0]), __uint_as_float(rr[1])); }
            float alpha = 1.f;
            if (!__all(pmax - m_reg <= THRL)) { const float mn = fmaxf(m_reg, pmax); alpha = __builtin_amdgcn_exp2f(m_reg - mn); m_reg = mn;
                if (hi == 0) wsf[r32] = alpha; asm volatile("s_waitcnt lgkmcnt(0)" ::: "memory");
#pragma unroll
                for (int dd = 0; dd < NDV; ++dd)
#pragma unroll
                    for (int r = 0; r < 16; ++r) o[dd][r] *= wsf[crow(r, hi)]; }
            float ps = 0.f;
#pragma unroll
            for (int r = 0; r < 16; ++r) { p0[r] = __builtin_amdgcn_exp2f(p0[r] - m_reg); p1[r] = __builtin_amdgcn_exp2f(p1[r] - m_reg); ps += p0[r] + p1[r]; }
            { auto rr = __builtin_amdgcn_permlane32_swap(__float_as_uint(ps), __float_as_uint(ps), false, false); ps = __uint_as_float(rr[0]) + __uint_as_float(rr[1]); }
            l_reg = l_reg * alpha + ps;
            bf16x8 pa0, pa1, pa2, pa3;
#define PK4(P, BASE, OUT) do { unsigned a0 = cvt_pk_bf16(P[BASE + 0], P[BASE + 1]), a1 = cvt_pk_bf16(P[BASE + 2], P[BASE + 3]); \
    unsigned b0_ = cvt_pk_bf16(P[BASE + 4], P[BASE + 5]), b1_ = cvt_pk_bf16(P[BASE + 6], P[BASE + 7]); \
    auto r0 = __builtin_amdgcn_permlane32_swap(a0, b0_, false, false); auto r1 = __builtin_amdgcn_permlane32_swap(a1, b1_, false, false); \
    u32x4 w_ = {r0[0], r1[0], r0[1], r1[1]}; OUT = __builtin_bit_cast(bf16x8, w_); } while (0)
            PK4(p0, 0, pa0); PK4(p0, 8, pa1); PK4(p1, 0, pa2); PK4(p1, 8, pa3);
#undef PK4
            const int vb = vb0 + buf * VB_BYTES;
            pv_one<DV, 0>(o[0], vb, pa0, pa1, pa2, pa3); pv_one<DV, 1>(o[1], vb, pa0, pa1, pa2, pa3);
            if constexpr (NDV == 4) { pv_one<DV, 2>(o[2], vb, pa0, pa1, pa2, pa3); pv_one<DV, 3>(o[3], vb, pa0, pa1, pa2, pa3); }
        }
        if (t + 1 < NT) SWRITEV(buf ^ 1);
        __syncthreads();
    }
    if (hi == 0) wsf[r32] = l_reg; asm volatile("s_waitcnt lgkmcnt(0)" ::: "memory");
    float rli[16];
#pragma unroll
    for (int r = 0; r < 16; ++r) rli[r] = __builtin_amdgcn_rcpf(wsf[crow(r, hi)]);
#pragma unroll
    for (int r = 0; r < 16; ++r) { const size_t off = (size_t)(wid * 32 + crow(r, hi)) * 2048 + r32;
#pragma unroll
        for (int dd = 0; dd < NDV; ++dd) { const float z = bf2f(d.Z[off + dd * 32]); const float v = o[dd][r] * rli[r] * z; d.Y[off + dd * 32] = (bf16_t)(cvt_pk_bf16(v, v) & 0xffffu); } }
    __syncthreads();
#undef TILE_K
#undef TILE_V
#undef SLOADK
#undef SLOADV
#undef SWRITEK
#undef SWRITEV
}


#ifndef A_ZPRE
#define A_ZPRE 1
#endif
#ifndef A_NOVMW
#define A_NOVMW 1
#endif
#ifndef A_DMAF
#define A_DMAF 2
#endif
#ifndef ATT_NSLOT64
#define ATT_NSLOT64 4
#endif
#define WAITV(n) asm volatile("s_waitcnt vmcnt(" #n ")" ::: "memory")
template <int DQK, int DV>
__device__ __forceinline__ void attn_unit2(const AttnDesc& d, float mshift, LAS unsigned char* lds, unsigned q_next = 0u, bool q_pub = false) {
    constexpr int KB_BYTES = 64 * DQK * 2, VB_BYTES = 64 * DV * 2, SLOT = KB_BYTES + VB_BYTES, NSLOT = (DQK == 64) ? ATT_NSLOT64 : 3, DIST = NSLOT - 1;
    constexpr int KCH = DQK / 8, KI = KB_BYTES / 8192, VI = VB_BYTES / 8192, IPW = KI + VI, ND0 = DQK / 16, NDV = DV / 32, VSUB = DV / 32;
    constexpr int OFF_WS = 122880, OFF_TAB = OFF_WS + 2048; constexpr bool MASKS = (DQK == 64);
    static_assert(NSLOT * SLOT <= OFF_WS && OFF_TAB + 15 * 128 * 4 <= ATT_LDS_END && 8 * 32 * DV * 2 <= NSLOT * SLOT, "attention LDS");
    const int tid = tid_opaque(), lane = tid & 63, r32 = lane & 31, hi = lane >> 5; const int wid = __builtin_amdgcn_readfirstlane(tid >> 6);
    LAS float* wsf = (LAS float*)(lds + OFF_WS) + wid * 64;
    LAS float* tab = (LAS float*)(lds + OFF_TAB);
    const int NT = 4 + d.nlt;
    int wlo = 0, whi = 0x7fffffff, wrow = 0;
    if (MASKS && d.mask == MK_NA) { wrow = (d.q0 >> 6) + (wid >> 1); int rs = wrow - 4; rs = rs < 0 ? 0 : (rs > 24 ? 24 : rs); wlo = rs; whi = rs + 7; }
    else if (MASKS && d.mask == MK_SWA) { const int qw = d.q0 + 32 * wid; wlo = (qw - 128) >> 6; whi = (qw + 31 + 128) >> 6; }
    const float negm = -mshift;
    bf16x8 qr[ND0];
    { const bf16_t* qp = d.Q + (size_t)(wid * 32 + r32) * d.ldq + hi * 8;
#pragma unroll
      for (int d0 = 0; d0 < ND0; ++d0) qr[d0] = *(const bf16x8*)(qp + d0 * 16); }
    if (MASKS && d.mask == MK_NA) { for (int i = tid; i < 15 * 128; i += 512) { const int dr = i >> 7, dc = (i & 127) - 63; tab[i] = ((dc >= -15 && dc <= 15) ? d.bias[dr * 31 + dc + 15] * LOG2E : 0.f) + negm; } }
    else if (MASKS && d.mask == MK_SWA) { for (int i = tid; i < 512; i += 512) { const int dx = i - 256; tab[i] = (dx >= -128 && dx <= 128) ? negm : -INFINITY; } }
    unsigned koff[KI], voff[VI];
#pragma unroll
    for (int i = 0; i < KI; ++i) { const int P = (wid * KI + i) * 64 + lane, row = P / KCH, cp = P % KCH; koff[i] = (unsigned)(row * d.ldk + ((cp ^ ((row >> 1) & 7)) * 8)); }
#pragma unroll
    for (int i = 0; i < VI; ++i) { const int P = (wid * VI + i) * 64 + lane, st = P >> 5, kk = (st / VSUB) * 8 + ((P >> 2) & 7), c = (st % VSUB) * 32 + (P & 3) * 8;
        const int k = (kk & ~0xC) | ((kk & 4) << 1) | ((kk & 8) >> 1); voff[i] = (unsigned)(k * d.ldv + c); }
#pragma unroll
    for (int i = 0; i < KI; ++i) asm volatile("" : "+v"(koff[i]));
#pragma unroll
    for (int i = 0; i < VI; ++i) asm volatile("" : "+v"(voff[i]));
#define TILE_K(t) ((t) < 4 ? d.Kc + (size_t)((t) * 64) * d.ldk : d.Kl + (size_t)((d.lt0 + (t) - 4) * 64) * d.ldk)
#define TILE_V(t) ((t) < 4 ? d.Vc + (size_t)((t) * 64) * d.ldv : d.Vl + (size_t)((d.lt0 + (t) - 4) * 64) * d.ldv)
#define DMA_TILE(t, sl) do { const bf16_t* kp_ = TILE_K(t); const bf16_t* vp_ = TILE_V(t); LAS unsigned char* sb_ = lds + (sl) * SLOT; \
      _Pragma("unroll") for (int i_ = 0; i_ < KI; ++i_) __builtin_amdgcn_global_load_lds((const unsigned*)(kp_ + koff[i_]), (LAS unsigned*)(sb_ + (wid * KI + i_) * 1024), 16, 0, 0); \
      _Pragma("unroll") for (int i_ = 0; i_ < VI; ++i_) __builtin_amdgcn_global_load_lds((const unsigned*)(vp_ + voff[i_]), (LAS unsigned*)(sb_ + KB_BYTES + (wid * VI + i_) * 1024), 16, 0, 0); } while (0)
#pragma unroll
    for (int d0 = 0; d0 < ND0; ++d0) asm volatile("" : "+v"(qr[d0]));
#pragma unroll
    for (int t = 0; t < DIST; ++t) if (t < NT) DMA_TILE(t, t);
    f32x16 vm0 = f32x16{}, vm1 = f32x16{};
    const int ccol = (wid & 1) * 32 + r32;
    if (MASKS && d.mask == MK_NA) { int qs = ccol - 8; qs = qs < 0 ? 0 : (qs > 48 ? 48 : qs);
#pragma unroll
        for (int r = 0; r < 16; ++r) { const int k0 = crow(r, hi), k1 = k0 + 32; vm0[r] = (k0 >= qs && k0 < qs + 16) ? 0.f : -INFINITY; vm1[r] = (k1 >= qs && k1 < qs + 16) ? 0.f : -INFINITY; } }
    float l_reg = (hi == 0 && d.l0 != 0.f) ? __builtin_amdgcn_exp2f(d.m0 - mshift) : 0.f; f32x16 o[NDV];
#pragma unroll
    for (int i = 0; i < NDV; ++i) o[i] = f32x16{};
    int slot = 0;
    for (int t = 0; t < NT; ++t) {
        if constexpr (IPW == 2) {
            const int rem = NT - 1 - t;
            if (DIST >= 6 && rem >= 5) WAITV(10); else if (DIST >= 5 && rem >= 4) WAITV(8); else if (DIST >= 4 && rem >= 3) WAITV(6); else if (DIST >= 3 && rem >= 2) WAITV(4); else if (rem >= 1) WAITV(2); else WAITV(0);
        } else { if (t + 1 < NT) WAITV(5); else WAITV(0); }
        asm volatile("s_waitcnt lgkmcnt(0)" ::: "memory"); __builtin_amdgcn_s_barrier(); asm volatile("" ::: "memory");
        if (t + DIST < NT) { int sn = slot + DIST; sn = sn >= NSLOT ? sn - NSLOT : sn; DMA_TILE(t + DIST, sn); }
        const int lt = d.lt0 + t - 4;
        const bool active = (t < 4) || (lt >= wlo && lt <= whi);
        if (active) {
            f32x16 p0, p1;
            if (MASKS && t >= 4 && d.mask == MK_NA) {
                const LAS float* bp = tab + (lt - wrow + 7) * 128 + (63 - ccol + 4 * hi);
#pragma unroll
                for (int r = 0; r < 16; ++r) { p0[r] = vm0[r] + bp[(r & 3) + 8 * (r >> 2)]; p1[r] = vm1[r] + bp[32 + (r & 3) + 8 * (r >> 2)]; }
            } else if (MASKS && t >= 4 && d.mask == MK_SWA && !((lt * 64 + 63 - (d.q0 + 32 * wid) <= 128) && (d.q0 + 32 * wid + 31 - lt * 64 <= 128))) {
                const LAS float* bp = tab + (lt * 64 + 4 * hi - (d.q0 + 32 * wid + r32) + 256);
#pragma unroll
                for (int r = 0; r < 16; ++r) { p0[r] = bp[(r & 3) + 8 * (r >> 2)]; p1[r] = bp[32 + (r & 3) + 8 * (r >> 2)]; }
            } else {
#pragma unroll
                for (int r = 0; r < 16; ++r) { p0[r] = negm; p1[r] = negm; }
            }
            { const LAS unsigned char* kb = lds + slot * SLOT; const int sw = ((r32 >> 1) & 7) << 4;
              const LAS unsigned char* kr0 = kb + r32 * (DQK * 2); int cbj[4]; (void)sw;
#pragma unroll
              for (int j = 0; j < 4; ++j) cbj[j] = ((2 * j + hi) ^ ((r32 >> 1) & 7)) << 4;
#define KLD(dst, d0_) do { dst[0] = *(const LAS bf16x8*)(kr0 + cbj[(d0_) & 3] + ((d0_) >> 2) * 128); dst[1] = *(const LAS bf16x8*)(kr0 + cbj[(d0_) & 3] + ((d0_) >> 2) * 128 + 32 * DQK * 2); } while (0)
#define KMM(src, d0_) do { p0 = __builtin_amdgcn_mfma_f32_32x32x16_bf16(src[0], qr[d0_], p0, 0, 0, 0); p1 = __builtin_amdgcn_mfma_f32_32x32x16_bf16(src[1], qr[d0_], p1, 0, 0, 0); } while (0)
              if constexpr (ND0 == 4) { bf16x8 kfa[4][2];
#pragma unroll
                  for (int j = 0; j < 4; ++j) KLD(kfa[j], j);
                  __builtin_amdgcn_sched_barrier(0);
#pragma unroll
                  for (int j = 0; j < 4; ++j) KMM(kfa[j], j);
              } else {
                  bf16x8 kfa[2], kfb[2];
                  KLD(kfa, 0);
#pragma unroll
                  for (int g = 0; g < ND0 / 2; ++g) {
                      KLD(kfb, 2 * g + 1); __builtin_amdgcn_sched_barrier(0);
                      KMM(kfa, 2 * g); __builtin_amdgcn_sched_barrier(0);
                      if (g + 1 < ND0 / 2) { KLD(kfa, 2 * g + 2); __builtin_amdgcn_sched_barrier(0); }
                      KMM(kfb, 2 * g + 1); __builtin_amdgcn_sched_barrier(0);
                  }
              }
#undef KLD
#undef KMM
            }
            __builtin_amdgcn_sched_barrier(0);
            const int vpb = (int)(unsigned)(size_t)(lds + slot * SLOT + KB_BYTES) + v_rd_base(lane);
            constexpr int KS_ = (DV / 32) * 1024, HF_ = (DV / 32) * 512, NPRE = (DQK == 64) ? 2 : 1;
            s16x4 vl[NDV][4], vh[NDV][4];
#define VLD(dd_) do { vl[dd_][0] = tr_read<(dd_) * 512 + 0 * KS_>(vpb); vh[dd_][0] = tr_read<(dd_) * 512 + 0 * KS_ + HF_>(vpb); vl[dd_][1] = tr_read<(dd_) * 512 + 1 * KS_>(vpb); vh[dd_][1] = tr_read<(dd_) * 512 + 1 * KS_ + HF_>(vpb); \
      vl[dd_][2] = tr_read<(dd_) * 512 + 2 * KS_>(vpb); vh[dd_][2] = tr_read<(dd_) * 512 + 2 * KS_ + HF_>(vpb); vl[dd_][3] = tr_read<(dd_) * 512 + 3 * KS_>(vpb); vh[dd_][3] = tr_read<(dd_) * 512 + 3 * KS_ + HF_>(vpb); } while (0)
            VLD(0); if constexpr (NPRE == 2) VLD(1);
            __builtin_amdgcn_sched_barrier(0);
            float ps = 0.f;
#pragma unroll
            for (int r = 0; r < 16; ++r) { p0[r] = __builtin_amdgcn_exp2f(p0[r]); p1[r] = __builtin_amdgcn_exp2f(p1[r]); ps += p0[r] + p1[r]; }
            l_reg += ps;
            bf16x8 pa0, pa1, pa2, pa3;
#define PK4(P, BASE, OUT) do { unsigned a0 = cvt_pk_bf16(P[BASE + 0], P[BASE + 1]), a1 = cvt_pk_bf16(P[BASE + 2], P[BASE + 3]); \
    unsigned b0_ = cvt_pk_bf16(P[BASE + 4], P[BASE + 5]), b1_ = cvt_pk_bf16(P[BASE + 6], P[BASE + 7]); \
    auto r0 = __builtin_amdgcn_permlane32_swap(a0, b0_, false, false); auto r1 = __builtin_amdgcn_permlane32_swap(a1, b1_, false, false); \
    u32x4 w_ = {r0[0], r1[0], r0[1], r1[1]}; OUT = __builtin_bit_cast(bf16x8, w_); } while (0)
            PK4(p0, 0, pa0); PK4(p0, 8, pa1); PK4(p1, 0, pa2); PK4(p1, 8, pa3);
#undef PK4
            __builtin_amdgcn_sched_barrier(0);
#define VFR(L, H) (bf16x8){L[0], L[1], L[2], L[3], H[0], H[1], H[2], H[3]}
#define PVMM(od, dd_) do { od = __builtin_amdgcn_mfma_f32_32x32x16_bf16(pa0, VFR(vl[dd_][0], vh[dd_][0]), od, 0, 0, 0); od = __builtin_amdgcn_mfma_f32_32x32x16_bf16(pa1, VFR(vl[dd_][1], vh[dd_][1]), od, 0, 0, 0); \
      od = __builtin_amdgcn_mfma_f32_32x32x16_bf16(pa2, VFR(vl[dd_][2], vh[dd_][2]), od, 0, 0, 0); od = __builtin_amdgcn_mfma_f32_32x32x16_bf16(pa3, VFR(vl[dd_][3], vh[dd_][3]), od, 0, 0, 0); } while (0)
#define VWAIT() do { asm volatile("s_waitcnt lgkmcnt(0)" ::: "memory"); __builtin_amdgcn_sched_barrier(0); } while (0)
            VWAIT();
            if constexpr (NDV == 2) { PVMM(o[0], 0); PVMM(o[1], 1); }
            else { PVMM(o[0], 0); __builtin_amdgcn_sched_barrier(0); VLD(1); VWAIT(); PVMM(o[1], 1); __builtin_amdgcn_sched_barrier(0); VLD(2); VWAIT(); PVMM(o[2], 2); __builtin_amdgcn_sched_barrier(0); VLD(3); VWAIT(); PVMM(o[3], 3); }
            __builtin_amdgcn_sched_barrier(0);
#undef VWAIT
#undef PVMM
#undef VFR
#undef VLD
        }
        slot = slot + 1 == NSLOT ? 0 : slot + 1;
    }
    if (q_pub) ((volatile LAS unsigned*)(lds + LDSCTL_OFF))[16] = q_next;
    const int tid_e = tid_opaque(), lane_e = tid_e & 63, r32_e = lane_e & 31, hi_e = lane_e >> 5; (void)r32_e;
    constexpr int CPR = DV / 8, RPI = 64 / CPR;
#if A_ZPRE
    u32x4 zpre[32 / RPI];
#pragma unroll
    for (int i = 0; i < 32 / RPI; ++i) { const int row = i * RPI + lane_e / CPR, ch = lane_e % CPR; zpre[i] = *(const u32x4*)(d.Z + (size_t)(wid * 32 + row) * 2048 + ch * 8); }
#endif
    { auto rr = __builtin_amdgcn_permlane32_swap(__float_as_uint(l_reg), __float_as_uint(l_reg), false, false); l_reg = __uint_as_float(rr[0]) + __uint_as_float(rr[1]); }
    if (hi_e == 0) ((LAS float*)(lds + OFF_WS) + wid * 64)[r32_e] = l_reg;
    asm volatile("s_waitcnt lgkmcnt(0)" ::: "memory"); __builtin_amdgcn_s_barrier(); asm volatile("" ::: "memory");
    float rli[16];
#pragma unroll
    for (int r = 0; r < 16; ++r) rli[r] = __builtin_amdgcn_rcpf(((LAS float*)(lds + OFF_WS) + wid * 64)[crow(r, hi_e)]);
    LAS bf16_t* stg = (LAS bf16_t*)(lds + wid * (32 * DV * 2));
#pragma unroll
    for (int r = 0; r < 16; ++r) { const int orow = crow(r, hi_e);
#pragma unroll
        for (int dd = 0; dd < NDV; ++dd) { const float v = o[dd][r] * rli[r]; stg[orow * DV + dd * 32 + r32_e] = (bf16_t)(cvt_pk_bf16(v, v) & 0xffffu); } }
    asm volatile("s_waitcnt lgkmcnt(0)" ::: "memory");
#pragma unroll
    for (int i = 0; i < 32 / RPI; ++i) { const int row = i * RPI + lane_e / CPR, ch = lane_e % CPR; const size_t off = (size_t)(wid * 32 + row) * 2048 + ch * 8;
        const u32x4 ov = *(const LAS u32x4*)(stg + row * DV + ch * 8);
#if A_ZPRE
        const u32x4 zv = zpre[i];
#else
        const u32x4 zv = *(const u32x4*)(d.Z + off);
#endif
        u32x4 yv;
#pragma unroll
        for (int j = 0; j < 4; ++j) { const float a0 = __uint_as_float(ov[j] << 16) * __uint_as_float(zv[j] << 16), a1 = __uint_as_float(ov[j] & 0xffff0000u) * __uint_as_float(zv[j] & 0xffff0000u); yv[j] = cvt_pk_bf16(a0, a1); }
        asm volatile("global_store_dwordx4 %0, %1, off sc1\n\ts_nop 3" :: "v"(d.Y + off), "v"(yv) : "memory"); }
    asm volatile("s_waitcnt vmcnt(0) lgkmcnt(0)" ::: "memory"); __builtin_amdgcn_s_barrier(); asm volatile("" ::: "memory");
    if (q_pub) { unsigned char* const wsb_ = ws_from_kernarg();
        (void)__hip_atomic_fetch_add((unsigned*)(wsb_ + WS_CTL) + CW_RT + (((unsigned)((const unsigned char*)d.Y - wsb_) - (unsigned)WS_XN) >> 20), 1u, __ATOMIC_RELAXED, __HIP_MEMORY_SCOPE_AGENT); }
#undef TILE_K
#undef TILE_V
#undef DMA_TILE
}

__device__ __forceinline__ void attn_unit64(const AttnDesc& d, LAS unsigned char* lds, unsigned q_next = 0u, bool q_pub = false) {
    constexpr int TB = 8192, SLOT = 4 * TB, NSLOT = 3, DIST = 2, OFF_WS = 122880, OFF_TAB = OFF_WS + 2048;
    static_assert(NSLOT * SLOT <= OFF_WS, "attention LDS");
    const int tid = tid_opaque(), lane = tid & 63, r32 = lane & 31, hi = lane >> 5; const int wid = __builtin_amdgcn_readfirstlane(tid >> 6);
    LAS float* tab = (LAS float*)(lds + OFF_TAB);
    const int NT = 4 + d.nlt, NP = (NT + 1) >> 1;
    int wlo = 0, whi = 0x7fffffff, wrow = 0;
    if (d.mask == MK_NA) { wrow = (d.q0 >> 6) + (wid >> 1); int rs = wrow - 4; rs = rs < 0 ? 0 : (rs > 24 ? 24 : rs); wlo = rs; whi = rs + 7; }
    else if (d.mask == MK_SWA) { const int qw = d.q0 + 32 * wid; wlo = (qw - 128) >> 6; whi = (qw + 31 + 128) >> 6; }
    unsigned koff, voff;
    { const int P = wid * 64 + lane, row = P >> 3, cp = P & 7; koff = (unsigned)(row * d.ldk + ((cp ^ ((row >> 1) & 7)) * 8));
      const int st = P >> 5, kk = (st >> 1) * 8 + ((P >> 2) & 7), c = (st & 1) * 32 + (P & 3) * 8, k = (kk & ~0xC) | ((kk & 4) << 1) | ((kk & 8) >> 1); voff = (unsigned)(k * d.ldv + c); }
    asm volatile("" : "+v"(koff)); asm volatile("" : "+v"(voff));
#define TILE_K(t) ((t) < 4 ? d.Kc + (size_t)((t) * 64) * d.ldk : d.Kl + (size_t)((d.lt0 + (t) - 4) * 64) * d.ldk)
#define TILE_V(t) ((t) < 4 ? d.Vc + (size_t)((t) * 64) * d.ldv : d.Vl + (size_t)((d.lt0 + (t) - 4) * 64) * d.ldv)
#define DMA1(t, off_) do { const int t_ = (t) < NT ? (t) : NT - 1; const bf16_t* kp_ = TILE_K(t_); const bf16_t* vp_ = TILE_V(t_); \
      __builtin_amdgcn_global_load_lds((const unsigned*)(kp_ + koff), (LAS unsigned*)(lds + (off_) + wid * 1024), 16, 0, 0); \
      __builtin_amdgcn_global_load_lds((const unsigned*)(vp_ + voff), (LAS unsigned*)(lds + (off_) + TB + wid * 1024), 16, 0, 0); } while (0)
#define DMA_PAIR(s_, sl) do { DMA1(2 * (s_), (sl) * SLOT); DMA1(2 * (s_) + 1, (sl) * SLOT + 2 * TB); } while (0)
#if A_DMAF >= 1
    DMA_PAIR(0, 0);
#endif
#if A_DMAF >= 2
    if (NP > 1) DMA_PAIR(1, 1);
#endif
    bf16x8 qr[4];
    { const bf16_t* qp = d.Q + (size_t)(wid * 32 + r32) * d.ldq + hi * 8;
#pragma unroll
      for (int d0 = 0; d0 < 4; ++d0) qr[d0] = *(const bf16x8*)(qp + d0 * 16); }
    if (d.mask == MK_NA) { for (int i = tid; i < 15 * 128; i += 512) { const int dr = i >> 7, dc = (i & 127) - 63; tab[i] = (dc >= -15 && dc <= 15) ? d.bias[dr * 31 + dc + 15] * LOG2E : 0.f; } }
    else if (d.mask == MK_SWA) { for (int i = tid; i < 512; i += 512) { const int dx = i - 256; tab[i] = (dx >= -128 && dx <= 128) ? 0.f : -INFINITY; } }
#pragma unroll
    for (int d0 = 0; d0 < 4; ++d0) asm volatile("" : "+v"(qr[d0]));
#if A_DMAF < 1
    DMA_PAIR(0, 0);
#endif
#if A_DMAF < 2
    if (NP > 1) DMA_PAIR(1, 1);
#endif
    f32x16 vm0 = f32x16{}, vm1 = f32x16{};
    const int ccol = (wid & 1) * 32 + r32;
    if (d.mask == MK_NA) { int qs = ccol - 8; qs = qs < 0 ? 0 : (qs > 48 ? 48 : qs);
#pragma unroll
        for (int r = 0; r < 16; ++r) { const int k0 = crow(r, hi), k1 = k0 + 32; vm0[r] = (k0 >= qs && k0 < qs + 16) ? 0.f : -INFINITY; vm1[r] = (k1 >= qs && k1 < qs + 16) ? 0.f : -INFINITY; } }
    float l_reg = (hi == 0 && d.l0 != 0.f) ? __builtin_amdgcn_exp2f(d.m0) : 0.f; f32x16 o[2];
    o[0] = f32x16{}; o[1] = f32x16{};
    const int swz = ((r32 >> 1) & 7) << 4; int cbj[4];
#pragma unroll
    for (int j = 0; j < 4; ++j) cbj[j] = ((2 * j + hi) << 4) ^ swz;
    int slot = 0;
#define PINIT(P0, P1, t_, lt_) do { \
        if ((t_) >= 4 && d.mask == MK_NA) { const LAS float* bp_ = tab + ((lt_) - wrow + 7) * 128 + (63 - ccol + 4 * hi); \
            _Pragma("unroll") for (int r = 0; r < 16; ++r) { P0[r] = vm0[r] + bp_[(r & 3) + 8 * (r >> 2)]; P1[r] = vm1[r] + bp_[32 + (r & 3) + 8 * (r >> 2)]; } } \
        else if ((t_) >= 4 && d.mask == MK_SWA && !(((lt_) * 64 + 63 - (d.q0 + 32 * wid) <= 128) && (d.q0 + 32 * wid + 31 - (lt_) * 64 <= 128))) { const LAS float* bp_ = tab + ((lt_) * 64 + 4 * hi - (d.q0 + 32 * wid + r32) + 256); \
            _Pragma("unroll") for (int r = 0; r < 16; ++r) { P0[r] = bp_[(r & 3) + 8 * (r >> 2)]; P1[r] = bp_[32 + (r & 3) + 8 * (r >> 2)]; } } \
        else { _Pragma("unroll") for (int r = 0; r < 16; ++r) { P0[r] = 0.f; P1[r] = 0.f; } } } while (0)
#define KLD4(KF, base_) do { _Pragma("unroll") for (int j = 0; j < 4; ++j) { KF[j][0] = *(const LAS bf16x8*)((base_) + r32 * 128 + cbj[j]); KF[j][1] = *(const LAS bf16x8*)((base_) + r32 * 128 + cbj[j] + 4096); } } while (0)
#define QK4(P0, P1, KF) do { _Pragma("unroll") for (int j = 0; j < 4; ++j) { P0 = __builtin_amdgcn_mfma_f32_32x32x16_bf16(KF[j][0], qr[j], P0, 0, 0, 0); P1 = __builtin_amdgcn_mfma_f32_32x32x16_bf16(KF[j][1], qr[j], P1, 0, 0, 0); } } while (0)
#define VLD2(VL, VH, vb_) do { \
        VL[0][0] = tr_read<0>(vb_); VH[0][0] = tr_read<1024>(vb_); VL[0][1] = tr_read<2048>(vb_); VH[0][1] = tr_read<3072>(vb_); VL[0][2] = tr_read<4096>(vb_); VH[0][2] = tr_read<5120>(vb_); VL[0][3] = tr_read<6144>(vb_); VH[0][3] = tr_read<7168>(vb_); \
        VL[1][0] = tr_read<512>(vb_); VH[1][0] = tr_read<1536>(vb_); VL[1][1] = tr_read<2560>(vb_); VH[1][1] = tr_read<3584>(vb_); VL[1][2] = tr_read<4608>(vb_); VH[1][2] = tr_read<5632>(vb_); VL[1][3] = tr_read<6656>(vb_); VH[1][3] = tr_read<7680>(vb_); } while (0)
#define SMAX(P0, P1, PA) do { float ps_ = 0.f; \
        _Pragma("unroll") for (int r = 0; r < 16; ++r) { P0[r] = __builtin_amdgcn_exp2f(P0[r]); P1[r] = __builtin_amdgcn_exp2f(P1[r]); ps_ += P0[r] + P1[r]; } l_reg += ps_; \
        _Pragma("unroll") for (int g_ = 0; g_ < 4; ++g_) { const int B_ = (g_ & 1) * 8; \
            const unsigned a0_ = (g_ < 2) ? cvt_pk_bf16(P0[B_ + 0], P0[B_ + 1]) : cvt_pk_bf16(P1[B_ + 0], P1[B_ + 1]), a1_ = (g_ < 2) ? cvt_pk_bf16(P0[B_ + 2], P0[B_ + 3]) : cvt_pk_bf16(P1[B_ + 2], P1[B_ + 3]); \
            const unsigned b0_ = (g_ < 2) ? cvt_pk_bf16(P0[B_ + 4], P0[B_ + 5]) : cvt_pk_bf16(P1[B_ + 4], P1[B_ + 5]), b1_ = (g_ < 2) ? cvt_pk_bf16(P0[B_ + 6], P0[B_ + 7]) : cvt_pk_bf16(P1[B_ + 6], P1[B_ + 7]); \
            auto r0_ = __builtin_amdgcn_permlane32_swap(a0_, b0_, false, false); auto r1_ = __builtin_amdgcn_permlane32_swap(a1_, b1_, false, false); \
            u32x4 w_ = {r0_[0], r1_[0], r0_[1], r1_[1]}; PA[g_] = __builtin_bit_cast(bf16x8, w_); } } while (0)
#define VFR(L, H) (bf16x8){L[0], L[1], L[2], L[3], H[0], H[1], H[2], H[3]}
#define PV2(PA, VL, VH) do { _Pragma("unroll") for (int dd = 0; dd < 2; ++dd) _Pragma("unroll") for (int ks = 0; ks < 4; ++ks) o[dd] = __builtin_amdgcn_mfma_f32_32x32x16_bf16(PA[ks], VFR(VL[dd][ks], VH[dd][ks]), o[dd], 0, 0, 0); } while (0)
#define LWAIT() do { asm volatile("s_waitcnt lgkmcnt(0)" ::: "memory"); __builtin_amdgcn_sched_barrier(0); } while (0)
#pragma unroll 1
    for (int s = 0; s < NP; ++s) {
        if (s + 1 < NP) WAITV(4); else WAITV(0);
        asm volatile("s_waitcnt lgkmcnt(0)" ::: "memory"); __builtin_amdgcn_s_barrier(); asm volatile("" ::: "memory");
        if (s + DIST < NP) { int sn = slot + DIST; sn = sn >= NSLOT ? sn - NSLOT : sn; DMA_PAIR(s + DIST, sn); }
        const int ta = 2 * s, tb = 2 * s + 1, lta = d.lt0 + ta - 4, ltb = lta + 1;
        const bool acta = (ta < 4) || (lta >= wlo && lta <= whi), actb = (tb < NT) && ((tb < 4) || (ltb >= wlo && ltb <= whi));
        const LAS unsigned char* sb = lds + slot * SLOT;
        const int vba = (int)(unsigned)(size_t)(sb + TB) + v_rd_base(lane), vbb = vba + 2 * TB;
        f32x16 pa0, pa1, pb0, pb1; bf16x8 kf[4][2];
        if (acta) { PINIT(pa0, pa1, ta, lta); KLD4(kf, sb); __builtin_amdgcn_sched_barrier(0); QK4(pa0, pa1, kf); }
        __builtin_amdgcn_sched_barrier(0);
        if (actb) { PINIT(pb0, pb1, tb, ltb); KLD4(kf, sb + 2 * TB); __builtin_amdgcn_sched_barrier(0); QK4(pb0, pb1, kf); }
        __builtin_amdgcn_sched_barrier(0);
        s16x4 vl[2][4], vh[2][4]; bf16x8 qp[4];
        if (acta) { VLD2(vl, vh, vba); __builtin_amdgcn_sched_barrier(0); SMAX(pa0, pa1, qp); __builtin_amdgcn_sched_barrier(0); LWAIT(); PV2(qp, vl, vh); }
        __builtin_amdgcn_sched_barrier(0);
        if (actb) { VLD2(vl, vh, vbb); __builtin_amdgcn_sched_barrier(0); SMAX(pb0, pb1, qp); __builtin_amdgcn_sched_barrier(0); LWAIT(); PV2(qp, vl, vh); }
        __builtin_amdgcn_sched_barrier(0);
        slot = slot + 1 == NSLOT ? 0 : slot + 1;
    }
#undef PINIT
#undef KLD4
#undef QK4
#undef VLD2
#undef SMAX
#undef VFR
#undef PV2
#undef LWAIT
    if (q_pub) ((volatile LAS unsigned*)(lds + LDSCTL_OFF))[16] = q_next;
    const int tid_e = tid_opaque(), lane_e = tid_e & 63, r32_e = lane_e & 31, hi_e = lane_e >> 5;
#if A_ZPRE
    u32x4 zpre[4];
#pragma unroll
    for (int i = 0; i < 4; ++i) { const int row = i * 8 + lane_e / 8, ch = lane_e % 8; zpre[i] = *(const u32x4*)(d.Z + (size_t)(wid * 32 + row) * 2048 + ch * 8); }
#endif
    { auto rr = __builtin_amdgcn_permlane32_swap(__float_as_uint(l_reg), __float_as_uint(l_reg), false, false); l_reg = __uint_as_float(rr[0]) + __uint_as_float(rr[1]); }
    if (hi_e == 0) ((LAS float*)(lds + OFF_WS) + wid * 64)[r32_e] = l_reg;
    asm volatile("s_waitcnt lgkmcnt(0)" ::: "memory"); __builtin_amdgcn_s_barrier(); asm volatile("" ::: "memory");
    float rli[16];
#pragma unroll
    for (int r = 0; r < 16; ++r) rli[r] = __builtin_amdgcn_rcpf(((LAS float*)(lds + OFF_WS) + wid * 64)[crow(r, hi_e)]);
    LAS bf16_t* stg = (LAS bf16_t*)(lds + wid * 4096);
#pragma unroll
    for (int r = 0; r < 16; ++r) { const int orow = crow(r, hi_e);
#pragma unroll
        for (int dd = 0; dd < 2; ++dd) { const float v = o[dd][r] * rli[r]; stg[orow * 64 + dd * 32 + r32_e] = (bf16_t)(cvt_pk_bf16(v, v) & 0xffffu); } }
    asm volatile("s_waitcnt lgkmcnt(0)" ::: "memory");
#pragma unroll
    for (int i = 0; i < 4; ++i) { const int row = i * 8 + lane_e / 8, ch = lane_e % 8; const size_t off = (size_t)(wid * 32 + row) * 2048 + ch * 8;
        const u32x4 ov = *(const LAS u32x4*)(stg + row * 64 + ch * 8);
#if A_ZPRE
        const u32x4 zv = zpre[i];
#else
        const u32x4 zv = *(const u32x4*)(d.Z + off);
#endif
        u32x4 yv;
#pragma unroll
        for (int j = 0; j < 4; ++j) { const float a0 = __uint_as_float(ov[j] << 16) * __uint_as_float(zv[j] << 16), a1 = __uint_as_float(ov[j] & 0xffff0000u) * __uint_as_float(zv[j] & 0xffff0000u); yv[j] = cvt_pk_bf16(a0, a1); }
        asm volatile("global_store_dwordx4 %0, %1, off sc1\n\ts_nop 3" :: "v"(d.Y + off), "v"(yv) : "memory"); }
    asm volatile("s_waitcnt vmcnt(0) lgkmcnt(0)" ::: "memory"); __builtin_amdgcn_s_barrier(); asm volatile("" ::: "memory");
    if (q_pub) { unsigned char* const wsb_ = ws_from_kernarg();
        (void)__hip_atomic_fetch_add((unsigned*)(wsb_ + WS_CTL) + CW_RT + (((unsigned)((const unsigned char*)d.Y - wsb_) - (unsigned)WS_XN) >> 20), 1u, __ATOMIC_RELAXED, __HIP_MEMORY_SCOPE_AGENT); }
#undef TILE_K
#undef TILE_V
#undef DMA1
#undef DMA_PAIR
}

typedef GAS unsigned gu32;
#define RLX_AGENT __ATOMIC_RELAXED, __HIP_MEMORY_SCOPE_AGENT
#define LDS_WAIT() asm volatile("s_waitcnt lgkmcnt(0)" ::: "memory")
#define XB_TMO      128
#define XB_XCNT(j)  (256  + 64 * (j))
#define XB_XSUB(j)  (1280 + 64 * (j))
#define XB_XGEN(j)  (2304 + 64 * (j))
#define XB_TOP      3328
#define XB_TOPGEN   3392
#define XCD_BAR_WORDS 3456
#define XB_SPIN_CAP (1u << 22)
__device__ __forceinline__ unsigned xb_ld(unsigned* p)              { return __hip_atomic_load(p, __ATOMIC_RELAXED, __HIP_MEMORY_SCOPE_AGENT); }
__device__ __forceinline__ unsigned xb_add(unsigned* p, unsigned v) { return __hip_atomic_fetch_add(p, v, __ATOMIC_RELAXED, __HIP_MEMORY_SCOPE_AGENT); }
__device__ __forceinline__ unsigned xb_xcc_id() { return (unsigned)__builtin_amdgcn_s_getreg((3 << 11) | 20) & 0xFu; }
#define XB_SPIN(cond, bar) do { unsigned _sp = 0; while (cond) { __builtin_amdgcn_s_sleep(1); \
    if ((++_sp & 255u) == 0u) { if (xb_ld(&(bar)[XB_TMO])) break; if (_sp > XB_SPIN_CAP) { atomicAdd(&(bar)[XB_TMO], 1u); break; } } } } while (0)
struct XcdBarrier { unsigned* bar; unsigned x; volatile LAS unsigned* st; };
__device__ __forceinline__ XcdBarrier xcd_barrier_post(unsigned* bar, volatile LAS unsigned* st) {
    XcdBarrier b; b.bar = bar; b.x = xb_xcc_id(); b.st = st;
    if (threadIdx.x == 0) (void)xb_add(&bar[XB_XCNT(b.x)], 1u);
    return b;
}
__device__ __forceinline__ void xcd_barrier_complete(unsigned* bar, unsigned x, unsigned& nloc, unsigned& nx) {
    const unsigned G = gridDim.x * gridDim.y * gridDim.z;
    unsigned sum, cnt, mine, sp = 0u;
    for (;;) {
        sum = 0u; cnt = 0u; mine = 0u;
#pragma unroll
        for (unsigned j = 0; j < 16; ++j) { const unsigned c = xb_ld(&bar[XB_XCNT(j)]); sum += c; cnt += (c > 0u) ? 1u : 0u; mine = (j == x) ? c : mine; }
        if (sum == G) break;
        __builtin_amdgcn_s_sleep(1);
        if ((++sp & 255u) == 0u) { if (xb_ld(&bar[XB_TMO])) break; if (sp > XB_SPIN_CAP) { atomicAdd(&bar[XB_TMO], 1u); break; } }
    }
    nloc = mine > 0u ? mine : 1u; nx = cnt > 0u ? cnt : 1u;
}
template <bool FIRST> __device__ __forceinline__ void xcd_barrier(const XcdBarrier& b) {
    asm volatile("s_waitcnt vmcnt(0)" ::: "memory");
    __syncthreads();
    if (threadIdx.x == 0) {
        unsigned* bar = b.bar;
        __builtin_amdgcn_s_waitcnt(0);
        unsigned nloc = b.st[0], nx = b.st[1];
        if constexpr (FIRST) { if (nloc == 0u) { xcd_barrier_complete(bar, b.x, nloc, nx); b.st[0] = nloc; b.st[1] = nx; } }
        else { nloc = nloc ? nloc : 1u; nx = nx ? nx : 1u; }
        const unsigned old = xb_add(&bar[XB_XSUB(b.x)], 1u);
        const unsigned gen = old / nloc;
        if (old + 1u == (gen + 1u) * nloc) {
            __builtin_amdgcn_fence(__ATOMIC_RELEASE, "agent");
            asm volatile("s_waitcnt vmcnt(0)" ::: "memory");
            const unsigned og = xb_add(&bar[XB_TOP], 1u);
            const unsigned tg = og / nx;
            if (og + 1u == (tg + 1u) * nx) xb_add(&bar[XB_TOPGEN], 1u);
            else XB_SPIN(xb_ld(&bar[XB_TOPGEN]) == tg, bar);
            __builtin_amdgcn_fence(__ATOMIC_ACQUIRE, "agent");
            xb_add(&bar[XB_XGEN(b.x)], 1u);
            asm volatile("s_waitcnt vmcnt(0)" ::: "memory");
        } else {
            XB_SPIN(xb_ld(&bar[XB_XGEN(b.x)]) == gen, bar);
            __builtin_amdgcn_fence(__ATOMIC_ACQUIRE, "agent");
            asm volatile("s_waitcnt vmcnt(0)" ::: "memory");
        }
    }
    __syncthreads();
}

__device__ __forceinline__ void xcd_barrier_arrive(const XcdBarrier& b, volatile LAS unsigned* info) {
    asm volatile("s_waitcnt vmcnt(0)" ::: "memory");
    __syncthreads();
    if (threadIdx.x == 0) {
        unsigned* bar = b.bar;
        __builtin_amdgcn_s_waitcnt(0);
        unsigned nloc = b.st[0], nx = b.st[1]; nloc = nloc ? nloc : 1u; nx = nx ? nx : 1u;
        const unsigned old = xb_add(&bar[XB_XSUB(b.x)], 1u);
        const unsigned gen = old / nloc;
        unsigned leader = 0u;
        if (old + 1u == (gen + 1u) * nloc) {
            leader = 1u;
            __builtin_amdgcn_fence(__ATOMIC_RELEASE, "agent");
            asm volatile("s_waitcnt vmcnt(0)" ::: "memory");
            const unsigned og = xb_add(&bar[XB_TOP], 1u);
            const unsigned tg = og / nx;
            if (og + 1u == (tg + 1u) * nx) xb_add(&bar[XB_TOPGEN], 1u);
            else XB_SPIN(xb_ld(&bar[XB_TOPGEN]) == tg, bar);
            __builtin_amdgcn_fence(__ATOMIC_ACQUIRE, "agent");
            xb_add(&bar[XB_XGEN(b.x)], 1u);
            asm volatile("s_waitcnt vmcnt(0)" ::: "memory");
        }
        info[0] = gen; info[1] = leader;
    }
    __syncthreads();
}
__device__ __forceinline__ void xcd_barrier_wait(const XcdBarrier& b, volatile LAS unsigned* info) {
    if (threadIdx.x == 0 && info[1] == 0u) {
        unsigned* bar = b.bar; const unsigned gen = info[0];
        XB_SPIN(xb_ld(&bar[XB_XGEN(b.x)]) == gen, bar);
        __builtin_amdgcn_fence(__ATOMIC_ACQUIRE, "agent");
        asm volatile("s_waitcnt vmcnt(0)" ::: "memory");
    }
    __syncthreads();
}

__device__ __forceinline__ void delay_ticks(unsigned ticks) { if (ticks) { const unsigned long long t0 = __builtin_amdgcn_s_memrealtime(); while (__builtin_amdgcn_s_memrealtime() - t0 < ticks) __builtin_amdgcn_s_sleep(16); } }
struct Args { const float* in[21]; float* out; unsigned char* ws; int ph_lo, ph_hi; };

__device__ __forceinline__ float wave_sum(float v) {
    v += swz_xor<1>(v); v += swz_xor<2>(v); v += swz_xor<4>(v); v += swz_xor<8>(v); v += swz_xor<16>(v);
    return sum_xor32(v);
}
__device__ __forceinline__ unsigned f2bf(float f) { unsigned u = __builtin_bit_cast(unsigned, f); return (u + 0x7fffu + ((u >> 16) & 1u)) >> 16; }
__device__ __forceinline__ unsigned pk2(float lo, float hi) { return f2bf(lo) | (f2bf(hi) << 16); }

struct TItem { const float* W; const float* sc; bf16_t* WT; int ldw, c0, K, r0, kb; };
__device__ __forceinline__ void ti_load(const TItem& it, float (&v)[32], int lane) {
    if (it.W) { const float* p = it.W + (size_t)(64 * it.kb + (lane >> 5)) * it.ldw + it.c0 + (lane & 31);
#pragma unroll
        for (int i = 0; i < 32; ++i) v[i] = p[(size_t)(2 * i) * it.ldw]; }
}
__device__ __forceinline__ void ti_finish(const TItem& it, float (&v)[32], LAS float* scr, int lane) {
    const int k0 = 64 * it.kb;
    if (it.W) {
        if (it.sc) {
#pragma unroll
            for (int i = 0; i < 32; ++i) v[i] *= it.sc[k0 + 2 * i + (lane >> 5)]; }
#pragma unroll
        for (int i = 0; i < 32; ++i) scr[(2 * i + (lane >> 5)) * 33 + (lane & 31)] = v[i];
    } else {
#pragma unroll 8
        for (int i = 0; i < 32; ++i) { const int kk = 2 * i + (lane >> 5); scr[kk * 33 + (lane & 31)] = 0.f; }
    }
    LDS_WAIT(); asm volatile("" ::: "memory");
    const int c = lane & 7;
#pragma unroll
    for (int j = 0; j < 4; ++j) { const int n = (lane >> 3) + 8 * j; const LAS float* s = scr + (8 * c) * 33 + n;
        u32x4 o; o.x = pk2(s[0 * 33], s[1 * 33]); o.y = pk2(s[2 * 33], s[3 * 33]); o.z = pk2(s[4 * 33], s[5 * 33]); o.w = pk2(s[6 * 33], s[7 * 33]);
        *(u32x4*)(it.WT + (size_t)(it.r0 + n) * it.K + k0 + 8 * c) = o; }
    LDS_WAIT(); asm volatile("" ::: "memory");
}
__device__ __forceinline__ void blk_feat(int nb, int& t, int& f0) { t = nb >> 3; const int j8 = nb & 7; f0 = 64 * (j8 & 3) + 32 * (j8 >> 2); }


__device__ __forceinline__ void ada_item(const Args& args, unsigned char* ws, LAS unsigned char* lds, int l, int cg, int tid, int lane, int wave) {
    const int c4 = (lane & 15) * 4, rsub = lane >> 4;
    LAS float* sl = (LAS float*)lds + wave * (9 * 256);
    LAS float* red = (LAS float*)(lds + 8 * 9 * 256 * 4);
#pragma unroll
    for (int r = 0; r < 9; ++r)
#pragma unroll
        for (int j = 0; j < 4; ++j) { const int k = 256 * wave + 64 * j + lane; const float v = (r < 8) ? args.in[1][r * 2048 + k] : args.in[3][k]; sl[r * 256 + 64 * j + lane] = v / (1.0f + __expf(-v)); }
    LDS_WAIT();
    f32x4 acc[9];
#pragma unroll
    for (int r = 0; r < 9; ++r) acc[r] = (f32x4){0.f, 0.f, 0.f, 0.f};
    const float* wp = args.in[5] + (size_t)l * 2048 * 6144 + (size_t)(256 * wave + rsub) * 6144 + cg * 64 + c4;
#pragma unroll 1
    for (int kk = 0; kk < 256; kk += 64) {
        f32x4 wv[16];
#pragma unroll
        for (int uu = 0; uu < 16; ++uu) wv[uu] = *(const f32x4*)(wp + (size_t)(kk + 4 * uu) * 6144);
#pragma unroll
        for (int uu = 0; uu < 16; ++uu)
#pragma unroll
            for (int r = 0; r < 9; ++r) acc[r] += sl[r * 256 + kk + 4 * uu + rsub] * wv[uu];
    }
#pragma unroll
    for (int r = 0; r < 9; ++r)
#pragma unroll
        for (int j = 0; j < 4; ++j) { float v = acc[r][j]; v += swz_xor<16>(v); v = sum_xor32(v); acc[r][j] = v; }
    if (rsub == 0) {
#pragma unroll
        for (int r = 0; r < 9; ++r) *(LAS f32x4*)(red + (wave * 9 + r) * 64 + c4) = acc[r]; }
    __syncthreads();
    for (int o = tid; o < 576; o += 512) { const int r = o >> 6, cl = o & 63; float s = 0.f;
#pragma unroll
        for (int w8 = 0; w8 < 8; ++w8) s += red[(w8 * 9 + r) * 64 + cl];
        __hip_atomic_store((GAS float*)(ws + WS_MOD) + ((size_t)l * 9 + r) * 6144 + cg * 64 + cl, s + args.in[6][l * 6144 + cg * 64 + cl], __ATOMIC_RELAXED, __HIP_MEMORY_SCOPE_AGENT); }
    asm volatile("s_waitcnt vmcnt(0)" ::: "memory");
    __syncthreads();
}
constexpr int CVT_ITEMS = 200 * 32 + 64 * 32 + 48 * 12 + 48 * 8;
__device__ __forceinline__ TItem cvt_decode(const Args& args, unsigned char* ws, int l, int r) {
    constexpr int I_IN = 200 * 32, I_OUT = 64 * 32, I_QB = 48 * 12;
    static_assert(I_IN + I_OUT + I_QB + 48 * 8 == CVT_ITEMS, "item count");
    TItem it; int t, f0;
    if (r < I_IN) { const int kb = r / 200, nb = r % 200; blk_feat(nb, t, f0); const bool valid = !(t == 16 && f0 >= 64); const int src = (t <= 16 ? 256 * t : 4160 + 256 * (t - 17)) + f0;
        it.W = valid ? args.in[7] + (size_t)l * 2048 * N_IN : nullptr; it.ldw = N_IN; it.c0 = src; it.sc = nullptr; it.WT = (bf16_t*)(ws + WS_WIN) + (size_t)l * 6400 * 2048; it.K = 2048; it.r0 = nb * 32; it.kb = kb; return it; }
    r -= I_IN;
    if (r < I_OUT) { const int kb = r / 64, nb = r % 64; blk_feat(nb, t, f0);
        it.W = args.in[20] + (size_t)l * 2048 * 2048; it.ldw = 2048; it.c0 = 256 * t + f0; it.sc = nullptr; it.WT = (bf16_t*)(ws + WS_WOUT) + (size_t)l * 2048 * 2048; it.K = 2048; it.r0 = nb * 32; it.kb = kb; return it; }
    r -= I_OUT;
    if (r < I_QB) { const int kb = r / 48, nb = r % 48; blk_feat(nb, t, f0); const bool valid = f0 < 192;
        it.W = valid ? args.in[16] + (size_t)l * 768 * 1152 : nullptr; it.ldw = 1152; it.c0 = 192 * t + f0; it.sc = args.in[14] + l * 768; it.WT = (bf16_t*)(ws + WS_WQB) + (size_t)l * 1536 * 768; it.K = 768; it.r0 = nb * 32; it.kb = kb; return it; }
    r -= I_QB;
    { const int kb = r / 48, nb = r % 48; blk_feat(nb, t, f0);
      it.W = args.in[17] + (size_t)l * 512 * 1536; it.ldw = 1536; it.c0 = 256 * t + f0; it.sc = args.in[15] + l * 512; it.WT = (bf16_t*)(ws + WS_WKVB) + (size_t)l * 1536 * 512; it.K = 512; it.r0 = nb * 32; it.kb = kb; return it; }
}
__device__ __forceinline__ void convert_items(const Args& args, unsigned char* ws, LAS unsigned char* lds, int l, int first, int stride, int lane, int wave, int lo = 0, int hi = CVT_ITEMS) {
    LAS float* scr = (LAS float*)(lds + wave * 16384);
    int rr = lo + first;
    if (rr >= hi) return;
    float va[32], vb[32];
    TItem ia = cvt_decode(args, ws, l, rr), ib = ia;
    ti_load(ia, va, lane);
#pragma unroll 1
    for (;;) {
        const int rb = rr + stride; const bool hb = rb < hi;
        if (hb) { ib = cvt_decode(args, ws, l, rb); ti_load(ib, vb, lane); }
        ti_finish(ia, va, scr, lane);
        if (!hb) break;
        rr = rb + stride; const bool ha = rr < hi;
        if (ha) { ia = cvt_decode(args, ws, l, rr); ti_load(ia, va, lane); }
        ti_finish(ib, vb, scr, lane);
        if (!ha) break;
    }
}

#define P1_ROWS(W0_, STRIDE_, RB_, RE_) do { \
            for (int row0 = (RB_) + (W0_); row0 < (RE_); row0 += 2 * (STRIDE_)) { \
                const int row1 = row0 + (STRIDE_); const bool has1 = row1 < (RE_); \
                const bool lat0 = row0 < NLAT, lat1 = row1 < NLAT; \
                const float* xr0 = lat0 ? xl + (size_t)row0 * 2048 : xcl + (size_t)(row0 - NLAT) * 2048; \
                const float* xr1 = has1 ? (lat1 ? xl + (size_t)row1 * 2048 : xcl + (size_t)(row1 - NLAT) * 2048) : xr0; \
                f32x4 v0[8], v1[8]; float s0 = 0.f, s1 = 0.f; \
                _Pragma("unroll") for (int j = 0; j < 8; ++j) v0[j] = *(const f32x4*)(xr0 + 8 * lane + 512 * (j >> 1) + 4 * (j & 1)); \
                _Pragma("unroll") for (int j = 0; j < 8; ++j) v1[j] = *(const f32x4*)(xr1 + 8 * lane + 512 * (j >> 1) + 4 * (j & 1)); \
                _Pragma("unroll") for (int j = 0; j < 8; ++j) { s0 += (v0[j][0] * v0[j][0] + v0[j][1] * v0[j][1]) + (v0[j][2] * v0[j][2] + v0[j][3] * v0[j][3]); s1 += (v1[j][0] * v1[j][0] + v1[j][1] * v1[j][1]) + (v1[j][2] * v1[j][2] + v1[j][3] * v1[j][3]); } \
                const float ri0 = __builtin_amdgcn_rsqf(wave_sum(s0) * (1.0f / 2048.0f) + EPS), ri1 = __builtin_amdgcn_rsqf(wave_sum(s1) * (1.0f / 2048.0f) + EPS); \
                const float* sh0 = modl + (size_t)(lat0 ? (row0 >> 11) : 8) * 6144; const float* sh1 = modl + (size_t)(lat1 ? (row1 >> 11) : 8) * 6144; \
                _Pragma("unroll") for (int jj = 0; jj < 4; ++jj) { const int k = 8 * lane + 512 * jj; u32x4 o0, o1; \
                    _Pragma("unroll") for (int hf = 0; hf < 2; ++hf) { const int kk = k + 4 * hf; const f32x4 w4 = *(const f32x4*)(nw + kk); \
                        { const f32x4 s4 = *(const f32x4*)(sh0 + 2048 + kk), h4 = *(const f32x4*)(sh0 + kk); const f32x4 y = v0[2 * jj + hf] * ri0 * w4 * (s4 + 1.0f) + h4; o0[2 * hf] = cvt_pk_bf16(y[0], y[1]); o0[2 * hf + 1] = cvt_pk_bf16(y[2], y[3]); } \
                        { const f32x4 s4 = *(const f32x4*)(sh1 + 2048 + kk), h4 = *(const f32x4*)(sh1 + kk); const f32x4 y = v1[2 * jj + hf] * ri1 * w4 * (s4 + 1.0f) + h4; o1[2 * hf] = cvt_pk_bf16(y[0], y[1]); o1[2 * hf + 1] = cvt_pk_bf16(y[2], y[3]); } } \
                    *(u32x4*)(XN + (size_t)row0 * 2048 + k) = o0; if (has1) *(u32x4*)(XN + (size_t)row1 * 2048 + k) = o1; } \
            } \
} while (0)

#ifndef MK_P1_EARLY
#define MK_P1_EARLY 1
#endif
__global__ void __launch_bounds__(512, 2) hymba_fwd(Args kargs) {
    LAS unsigned char* lds = (LAS unsigned char*)lds_;
    volatile LAS unsigned* MISC = (volatile LAS unsigned*)(lds + LDSCTL_OFF);
    const int tid = threadIdx.x, lane = tid & 63, wave = __builtin_amdgcn_readfirstlane(tid >> 6);
    const int G = gridDim.x, bx = blockIdx.x; const int G0_ = G, bx0_ = bx;
    const int vcu = (G % 8 == 0) ? (bx % 8) * (G / 8) + bx / 8 : bx;
    unsigned char* ws0 = kargs.ws;
    gu32* ctl = (gu32*)(ws0 + WS_CTL);
    for (int u = tid; u < 128; u += 512) MISC[u] = 0u;
    __syncthreads();
    XcdBarrier bar = xcd_barrier_post((unsigned*)ctl + CW_BAR + (MK_N_LAUNCHES == 1 ? 0 : kargs.ph_lo) * XCD_BAR_WORDS, MISC + 8);
    if (tid == 0) { unsigned nloc, nx; xcd_barrier_complete(bar.bar, bar.x, nloc, nx); bar.st[0] = nloc; bar.st[1] = nx; }
    __syncthreads();
    const int lo = kargs.ph_lo, hi_ph = kargs.ph_hi;
#ifdef STAMP_PROBE
#define STAMP(k) do { if (bx == 0 && tid == 0) ((unsigned long long*)(kargs.ws + WS_END))[k] = __builtin_amdgcn_s_memrealtime(); } while (0)
#else
#define STAMP(k) do {} while (0)
#endif
    STAMP(0);
#ifndef PH_MASK
#define PH_MASK 0x3f
#endif
#define KEN(j) (((PH_MASK) >> (j)) & 1)
#define IN(k) (lo <= (k) && (k) < hi_ph)
#define SEAM(k) do { if (IN(k) && IN((k) + 1)) xcd_barrier<false>(bar); } while (0)
#if defined(__HIP_DEVICE_COMPILE__)
#define PHASE_ARGS const __attribute__((address_space(4))) unsigned long long* kap_ = (const __attribute__((address_space(4))) unsigned long long*)__builtin_amdgcn_kernarg_segment_ptr(); asm volatile("" : "+s"(kap_)); \
    Args args; _Pragma("unroll") for (int i_ = 0; i_ < 21; ++i_) args.in[i_] = (const float*)kap_[i_]; args.out = (float*)kap_[21]; args.ws = (unsigned char*)kap_[22]; args.ph_lo = 0; args.ph_hi = 0;
#else
#define PHASE_ARGS const Args args = kargs;
#endif
#if LAUNDER_LDS
#define PHASE_LDS LAS unsigned char* lds = (LAS unsigned char*)lds_; asm volatile("" : "+s"(lds)); volatile LAS unsigned* MISC = (volatile LAS unsigned*)(lds + LDSCTL_OFF); (void)MISC;
#else
#define PHASE_LDS
#endif
#define PHASE_WS PHASE_ARGS PHASE_LDS const int bx = launder_s(bx0_), G = launder_s(G0_); const int vcu = (G % 8 == 0) ? (bx % 8) * (G / 8) + bx / 8 : bx; const int gw = vcu * 8 + wave, NGW = G * 8; (void)gw; (void)NGW; \
    GAS unsigned char* wsg_ = (GAS unsigned char*)args.ws; asm volatile("" : "+s"(wsg_)); unsigned char* ws = (unsigned char*)wsg_;
#define modp ((float*)(ws + WS_MOD))
#define ropep ((float*)(ws + WS_ROPE))
#define XN ((bf16_t*)(ws + WS_XN))
#define YG ((bf16_t*)(ws + WS_XN))
#define QA ((bf16_t*)(ws + WS_QA))
#define KA ((bf16_t*)(ws + WS_KA))
#define VA ((bf16_t*)(ws + WS_VA))
#define QB ((bf16_t*)(ws + WS_QB))
#define KB ((bf16_t*)(ws + WS_KB))
#define VB ((bf16_t*)(ws + WS_VB))
#define CQ ((bf16_t*)(ws + WS_CQ))
#define CKV ((bf16_t*)(ws + WS_CKV))
#define ZS ((bf16_t*)(ws + WS_ZS))
#define QC ((bf16_t*)(ws + WS_QC))
#define KC ((bf16_t*)(ws + WS_KC))
#define VC ((bf16_t*)(ws + WS_VC))
#define KPE ((float*)(ws + WS_KPE))
#define SSQK ((float*)(ws + WS_SSQK))
#define XC1 ((float*)(ws + WS_XC1))
#define x_in (args.in[0])
#define ctx_in (args.in[2])
    const int gw = vcu * 8 + wave, NGW = G * 8;

    if (KEN(0) && IN(0)) { PHASE_WS
#ifdef PREP_ALL_IN_P0
        for (int it = bx; it < 192; it += G) ada_item(args, ws, lds, it / 96, it % 96, tid, lane, wave);
        convert_items(args, ws, lds, 0, gw, NGW, lane, wave); convert_items(args, ws, lds, 1, gw, NGW, lane, wave);
#else
        for (int it = bx; it < 96; it += G) { ada_item(args, ws, lds, 0, it, tid, lane, wave); if (P3_FLOW && tid == 0) (void)xb_add((unsigned*)ctl + CW_ADA0, 1u); }
        if (bx >= 96) convert_items(args, ws, lds, 0, (bx - 96) * 8 + wave, (G - 96) * 8, lane, wave, 0, CVT_ITEMS - P0_ADA_SHARE);
        else convert_items(args, ws, lds, 0, bx * 8 + wave, 96 * 8, lane, wave, CVT_ITEMS - P0_ADA_SHARE, CVT_ITEMS);
#endif
    }
    if (IN(0) && IN(1) && !(P3_FLOW && MK_N_LAUNCHES == 1)) xcd_barrier<false>(bar);
    STAMP(1);

#pragma unroll 1
    for (int l = 0; l < DEPTH; ++l) {
        const int P = 1 + 5 * l;
        if (KEN(1) && IN(P) && (l == 0 || !P3_FLOW)) { PHASE_WS
            if (P3_FLOW && l == 0) { if (tid_opaque() == 0) { unsigned sp_ = 0u; while (xb_ld((unsigned*)ctl + CW_ADA0) < 96u) { __builtin_amdgcn_s_sleep(2); if (++sp_ > XB_SPIN_CAP) break; }
                    __builtin_amdgcn_fence(__ATOMIC_ACQUIRE, "agent"); asm volatile("s_waitcnt vmcnt(0)" ::: "memory"); }
                __syncthreads(); }
            const float* modl = modp + (size_t)l * 9 * 6144; (void)modl;
            const float* xl = (l == 0) ? x_in : args.out; (void)xl;
            const float* xcl = (l == 0) ? ctx_in : XC1; (void)xcl;
            float* ssq_cq = (float*)(ws + CTL_SSQ_OFF) + (size_t)l * MTOT; (void)ssq_cq;
            float* ssq_ckv = (float*)(ws + CTL_SSQ_OFF) + (size_t)(2 + l) * MTOT; (void)ssq_ckv;
            const float* nw = args.in[4] + l * 2048; const int lane = tid_opaque() & 63;
            P1_ROWS(gw, NGW, (l == 0 || MK_P1_EARLY == 0) ? 0 : NLAT, MTOT);
        }
        if (l == 0 || !P3_FLOW) SEAM(P);
        STAMP(P + 1);
        if (KEN(2) && IN(P + 1)) { PHASE_WS
            const float* modl = modp + (size_t)l * 9 * 6144; (void)modl;
            const float* xl = (l == 0) ? x_in : args.out; (void)xl;
            const float* xcl = (l == 0) ? ctx_in : XC1; (void)xcl;
            float* ssq_cq = (float*)(ws + CTL_SSQ_OFF) + (size_t)l * MTOT; (void)ssq_cq;
            float* ssq_ckv = (float*)(ws + CTL_SSQ_OFF) + (size_t)(2 + l) * MTOT; (void)ssq_ckv;
            pg8::Gemm g{XN, (const bf16_t*)(ws + WS_WIN) + (size_t)l * 6400 * 2048, MTOT, 6400, 2048};
            pg8::Sched2 S; S.G = G; S.c = bx; S.nN1 = NT_IN; S.pm2 = 64; S.nN2 = 9;
            if (l == DEPTH - 1) { S.nM1 = 64; S.nM2 = 8; if (EARLY_Q && G == 256) S.sig = (unsigned*)ctl + CW_CQDONE; } else { S.nM1 = 72; S.nM2 = 0; }
            const bool flow = P3_FLOW && G == 256;
            const bool split0 = (l == 0) && (G == 256);
            if (split0) { S.cut = 7 * 256; S.swap8 = true; }
            if (flow) { S.twoA = S.nM1 * 6 + S.nM2 * 3; S.sig = (unsigned*)ctl + CW_P3IN + 64 * l; pg8::Unit us; S.next((S.twoA - 1 - bx) >> 8, us); S.sig_pm = __builtin_amdgcn_readfirstlane(us.pm); S.sig_pn = __builtin_amdgcn_readfirstlane(us.pn); }
            EpiIn E{ws, args.in[8] + l * 64, args.in[9] + l * 64, args.in[11] + l * 64, args.in[12] + l * 64, args.in[19] + l * 192, l};
            { LAS float* wl = xch_ptr(); const int t_w = tid_opaque();
              if (t_w < 448) { const float* sp = t_w < 64 ? E.qn_a + t_w : t_w < 128 ? E.kn_a + (t_w - 64) : t_w < 192 ? E.qn_b + (t_w - 128) : t_w < 256 ? E.kn_b + (t_w - 192) : E.kn_c + (t_w - 256); wl[t_w] = *sp; }
              __syncthreads(); }
#ifdef STAGGER_P2
            delay_ticks((unsigned)(((bx >> 3) & 3) * STAGGER_P2));
#endif
#ifdef P2_TWICE
            { EpiNull EN{ws}; pg8::gemm_phase<EpiNull, pg8::Sched2, true, true>(lds, g, S, EN); }
#endif
            pg8::gemm_phase<EpiIn, pg8::Sched2, true, true>(lds, g, S, E);
#ifndef PREP_ALL_IN_P0
            if (EARLY_Q && l == DEPTH - 1 && G == 256 && bx >= 136) {
                if (tid_opaque() == 0) { unsigned sp_ = 0u; while (xb_ld((unsigned*)ctl + CW_CQDONE) < (unsigned)G) { __builtin_amdgcn_s_sleep(2); if (++sp_ > XB_SPIN_CAP) break; }
                    __builtin_amdgcn_fence(__ATOMIC_ACQUIRE, "agent"); asm volatile("s_waitcnt vmcnt(0)" ::: "memory"); }
                __syncthreads();
                { LAS float* gl = (LAS float*)(lds + 131072 + 4096); (void)gl; }
                pg8::Gemm gq{CQ, (const bf16_t*)(ws + WS_WQB) + (size_t)l * 1536 * 768, MTOT, 1536, 768};
                EpiQC Eq{ws, args.in[18] + l * 192, l};
                pg8::SchedOne S1; pg8::grid_map(383 - (bx - 136), 64, 6, S1.pm, S1.pn);
                pg8::gemm_phase<EpiQC, pg8::SchedOne, true, true>(lds, gq, S1, Eq);
            }
            if (split0) {
                const int t2 = tid_opaque(), lane2 = t2 & 63, wave2 = __builtin_amdgcn_readfirstlane(t2 >> 6);
                if (bx < 96) ada_item(args, ws, lds, 1, bx, t2, lane2, wave2);
                else convert_items(args, ws, lds, 1, (bx - 96) * 8 + wave2, (G - 96) * 8, lane2, wave2, 0, CVT_ITEMS - PREP_A - PREP_B);
                __syncthreads();
            } else if (l == 0 && bx >= 8) {
                const int t2 = tid_opaque(), lane2 = t2 & 63, wave2 = __builtin_amdgcn_readfirstlane(t2 >> 6);
                if (bx < 104) ada_item(args, ws, lds, 1, bx - 8, t2, lane2, wave2);
                else convert_items(args, ws, lds, 1, (bx - 104) * 8 + wave2, (G - 104) * 8, lane2, wave2);
                __syncthreads();
            }
#endif
            if (P3_FLOW && G == 256 && !(l == 0 && bx >= 248)) { if (tid_opaque() == 0) (void)xb_add((unsigned*)ctl + CW_P2DONE + 64 * l, 1u); }
        }
        if (!(P3_FLOW && G == 256 && MK_N_LAUNCHES == 1)) SEAM(P + 1);
        STAMP(P + 2);
        if (KEN(3) && IN(P + 2)) { PHASE_WS
            const float* modl = modp + (size_t)l * 9 * 6144; (void)modl;
            const float* xl = (l == 0) ? x_in : args.out; (void)xl;
            const float* xcl = (l == 0) ? ctx_in : XC1; (void)xcl;
            float* ssq_cq = (float*)(ws + CTL_SSQ_OFF) + (size_t)l * MTOT; (void)ssq_cq;
            float* ssq_ckv = (float*)(ws + CTL_SSQ_OFF) + (size_t)(2 + l) * MTOT; (void)ssq_ckv;
            if (P3_FLOW && G == 256) {
                if (tid_opaque() == 0) { unsigned sp_ = 0u; while (xb_ld((unsigned*)ctl + CW_P3IN + 64 * l) < (unsigned)G) { __builtin_amdgcn_s_sleep(2); if (++sp_ > XB_SPIN_CAP) break; }
                    __builtin_amdgcn_fence(__ATOMIC_ACQUIRE, "agent"); asm volatile("s_waitcnt vmcnt(0)" ::: "memory"); }
                __syncthreads();
            }
            const bool split0 = (l == 0) && (G == 256);
            if (split0 && bx >= 248) {
                pg8::Gemm gi{XN, (const bf16_t*)(ws + WS_WIN) + (size_t)l * 6400 * 2048, MTOT, 6400, 2048};
                EpiIn Ei{ws, args.in[8] + l * 64, args.in[9] + l * 64, args.in[11] + l * 64, args.in[12] + l * 64, args.in[19] + l * 192, l};
                pg8::SchedOne S1; S1.pm = 64 + (bx - 248); S1.pn = NT_IN - 1;
                pg8::gemm_phase<EpiIn, pg8::SchedOne, true, true>(lds, gi, S1, Ei);
                if (P3_FLOW && G == 256 && tid_opaque() == 0) (void)xb_add((unsigned*)ctl + CW_P2DONE + 64 * l, 1u);
            }
            { pg8::Gemm g{CQ, (const bf16_t*)(ws + WS_WQB) + (size_t)l * 1536 * 768, MTOT, 1536, 768};
              pg8::Sched2 S; S.G = G; S.c = bx; S.nN1 = 6; S.nM1 = (l == DEPTH - 1) ? 64 : 72; S.nM2 = 0; S.nN2 = 0; S.pm2 = 0;
              if (EARLY_Q && l == DEPTH - 1 && G == 256) S.cut = 384 - 120;
              if (P3_FLOW && l == DEPTH - 1 && G == 256) { S.c = bx >= 136 ? bx - 136 : bx + 120; S.rk_idle = 120; S.rk_off3 = 0; }
              EpiQC E{ws, args.in[18] + l * 192, l};
#ifdef P3_TWICE
              { EpiNull EN{ws}; pg8::gemm_phase<EpiNull, pg8::Sched2, true, true>(lds, g, S, EN); }
#endif
              pg8::gemm_phase<EpiQC, pg8::Sched2, true, true>(lds, g, S, E); }
            { pg8::Gemm g{CKV, (const bf16_t*)(ws + WS_WKVB) + (size_t)l * 1536 * 512, MTOT, 1536, 512};
              pg8::Sched2 S; S.G = G; S.c = (EARLY_Q && l == DEPTH - 1 && G == 256) ? G - 1 - bx : bx; S.nN1 = 6; S.nM1 = 72; S.nM2 = 0; S.nN2 = 0; S.pm2 = 0;
              if (P3_FLOW && l == DEPTH - 1 && G == 256) { S.c = bx >= 136 ? bx - 136 : bx + 120; S.rk_idle = 120; S.rk_off3 = 64; }
              EpiKVC E{ws, args.in[19] + l * 192, l};
#ifdef P3_TWICE
              { EpiNull EN{ws}; pg8::gemm_phase<EpiNull, pg8::Sched2, true, true>(lds, g, S, EN); }
#endif
              pg8::gemm_phase<EpiKVC, pg8::Sched2, true, true>(lds, g, S, E); }
            if (P3_FLOW && G == 256 && tid_opaque() == 0) (void)xb_add((unsigned*)ctl + CW_P3DONE + 64 * l, 1u);
            if (split0 && bx >= 128 && bx < 248) {
                const int t2 = tid_opaque(), lane2 = t2 & 63, wave2 = __builtin_amdgcn_readfirstlane(t2 >> 6);
                if (bx >= 176) convert_items(args, ws, lds, 1, (bx - 176) * 8 + wave2, 72 * 8, lane2, wave2, CVT_ITEMS - PREP_A - PREP_B, CVT_ITEMS - PREP_B);
                else convert_items(args, ws, lds, 1, (bx - 128) * 8 + wave2, 48 * 8, lane2, wave2, CVT_ITEMS - PREP_B, CVT_ITEMS);
                __syncthreads();
            }
        }
        if (!(ATT_NPRE > 0 && P3_FLOW && G == 256 && MK_N_LAUNCHES == 1)) SEAM(P + 2);
        STAMP(P + 3);
        if (KEN(4) && IN(P + 3)) { PHASE_WS
            const float* modl = modp + (size_t)l * 9 * 6144; (void)modl;
            const float* xl = (l == 0) ? x_in : args.out; (void)xl;
            const float* xcl = (l == 0) ? ctx_in : XC1; (void)xcl;
            float* ssq_cq = (float*)(ws + CTL_SSQ_OFF) + (size_t)l * MTOT; (void)ssq_cq;
            float* ssq_ckv = (float*)(ws + CTL_SSQ_OFF) + (size_t)(2 + l) * MTOT; (void)ssq_ckv;
            const int NU_C = BATCH * HC * 8, NU_B = BATCH * HB * 8, NU_A = BATCH * HA * 8;
            const int NU_CC = (l == DEPTH - 1) ? 0 : BATCH * HC, NU_CB = (l == DEPTH - 1) ? 0 : BATCH * HB, NU_CA = (l == DEPTH - 1) ? 0 : BATCH * HA;
            const int NU = NU_C + NU_B + NU_A + NU_CC + NU_CB + NU_CA;
            if (tid_opaque() == 0) MISC[16] = atomicAdd((unsigned*)ctl + CW_QUEUE + 64 * l, 1u);
            __syncthreads();
            int u_next = (int)MISC[16];
            __syncthreads();
#if ATT_NPRE > 0
            if (P3_FLOW && G == 256) {
                if (tid_opaque() == 0) { unsigned sp_ = 0u; while (xb_ld((unsigned*)ctl + CW_P2DONE + 64 * l) < (unsigned)G) { __builtin_amdgcn_s_sleep(2); if (++sp_ > XB_SPIN_CAP) break; }
                    __builtin_amdgcn_fence(__ATOMIC_ACQUIRE, "agent"); asm volatile("s_waitcnt vmcnt(0)" ::: "memory"); }
                __syncthreads();
            }
#endif
            bool p3_done = false;
            for (;;) {
                int u = u_next;
                if (u >= NU) break;
                unsigned q_next = 0u; const bool q_lane = tid_opaque() == 0;
                if (q_lane) q_next = atomicAdd((unsigned*)ctl + CW_QUEUE + 64 * l, 1u);
#if ATT_NPRE > 0
                if (P3_FLOW && G == 256) { if (u >= ATT_NPRE && !p3_done) {
                        if (q_lane) { unsigned sp_ = 0u; while (xb_ld((unsigned*)ctl + CW_P3DONE + 64 * l) < (unsigned)G) { __builtin_amdgcn_s_sleep(2); if (++sp_ > XB_SPIN_CAP) break; }
                            __builtin_amdgcn_fence(__ATOMIC_ACQUIRE, "agent"); asm volatile("s_waitcnt vmcnt(0)" ::: "memory"); }
                        __syncthreads(); p3_done = true; }
                    u = u < NU_A ? NU_C + NU_B + u : (u < NU_A + NU_C ? u - NU_A : (u < NU_A + NU_C + NU_B ? u - NU_A : u)); }
#endif
                bool big = false; AttnDesc d; d.m0 = -1e30f; d.l0 = 0.f; d.bias = nullptr; d.mask = MK_NONE; d.lt0 = 0; d.nlt = 0; d.q0 = 0;
                if (u < NU_C) {
                    const int qb = u & 7, hc = (u >> 3) % HC, b = u / (8 * HC); const size_t r0 = (size_t)b * SEQ + qb * 256, rc = (size_t)NLAT + b * LC;
                    d.Q = QC + r0 * 1152 + hc * 192; d.Kc = KC + rc * 1152 + hc * 192; d.Vc = VC + rc * 768 + hc * 128; d.Kl = KC + (size_t)b * SEQ * 1152 + hc * 192; d.Vl = VC + (size_t)b * SEQ * 768 + hc * 128;
                    d.ldq = 1152; d.ldk = 1152; d.ldv = 768; d.nlt = 32; d.Z = ZS + r0 * 2048 + 1280 + hc * 128; d.Y = YG + r0 * 2048 + 1280 + hc * 128; big = true; }
                else if ((u -= NU_C) < NU_B) {
                    const int qb = u & 7, hb = (u >> 3) % HB, b = u / (8 * HB), kv = hb / 3; const size_t r0 = (size_t)b * SEQ + qb * 256, rc = (size_t)NLAT + b * LC;
                    d.Q = QB + r0 * 768 + hb * 64; d.Kc = KB + rc * 256 + kv * 64; d.Vc = VB + rc * 256 + kv * 64; d.Kl = KB + (size_t)b * SEQ * 256 + kv * 64; d.Vl = VB + (size_t)b * SEQ * 256 + kv * 64;
                    d.ldq = 768; d.ldk = 256; d.ldv = 256; const int t0 = qb * 4 - 2 < 0 ? 0 : qb * 4 - 2, t1 = qb * 4 + 5 > 31 ? 31 : qb * 4 + 5; d.lt0 = t0; d.nlt = t1 - t0 + 1;
                    d.mask = MK_SWA; d.q0 = qb * 256; d.m0 = args.in[13][l * HB + hb] * LOG2E; d.l0 = 1.0f;
                    d.Z = ZS + r0 * 2048 + 512 + hb * 64; d.Y = YG + r0 * 2048 + 512 + hb * 64; }
                else if ((u -= NU_B) < NU_A) {
                    const int g4 = u & 7, ha = (u >> 3) % HA, b = u / (8 * HA); const size_t r0 = (size_t)b * SEQ + g4 * 256, rc = (size_t)NLAT + b * LC;
                    d.Q = QA + r0 * 512 + ha * 64; d.Kc = KA + rc * 512 + ha * 64; d.Vc = VA + rc * 512 + ha * 64; d.Kl = KA + (size_t)b * SEQ * 512 + ha * 64; d.Vl = VA + (size_t)b * SEQ * 512 + ha * 64;
                    d.ldq = 512; d.ldk = 512; d.ldv = 512; int ra = 4 * g4 - 4; ra = ra < 0 ? 0 : (ra > 24 ? 24 : ra); int rb = 4 * g4 + 3 - 4; rb = rb < 0 ? 0 : (rb > 24 ? 24 : rb); d.lt0 = ra; d.nlt = rb + 8 - ra;
                    d.mask = MK_NA; d.q0 = g4 * 256; d.bias = args.in[10] + ((size_t)l * HA + ha) * (15 * 31);
                    d.Z = ZS + r0 * 2048 + ha * 64; d.Y = YG + r0 * 2048 + ha * 64; }
                else if ((u -= NU_A) < NU_CC) {
                    const int hc = u % HC, b = u / HC; const size_t rc = (size_t)NLAT + b * LC;
                    d.Q = QC + rc * 1152 + hc * 192; d.Kc = KC + rc * 1152 + hc * 192; d.Vc = VC + rc * 768 + hc * 128; d.Kl = d.Kc; d.Vl = d.Vc; d.ldq = 1152; d.ldk = 1152; d.ldv = 768;
                    d.Z = ZS + rc * 2048 + 1280 + hc * 128; d.Y = YG + rc * 2048 + 1280 + hc * 128; big = true; }
                else if ((u -= NU_CC) < NU_CB) {
                    const int hb = u % HB, b = u / HB, kv = hb / 3; const size_t rc = (size_t)NLAT + b * LC;
                    d.Q = QB + rc * 768 + hb * 64; d.Kc = KB + rc * 256 + kv * 64; d.Vc = VB + rc * 256 + kv * 64; d.Kl = d.Kc; d.Vl = d.Vc; d.ldq = 768; d.ldk = 256; d.ldv = 256;
                    d.m0 = args.in[13][l * HB + hb] * LOG2E; d.l0 = 1.0f;
                    d.Z = ZS + rc * 2048 + 512 + hb * 64; d.Y = YG + rc * 2048 + 512 + hb * 64; }
                else { u -= NU_CB;
                    const int ha = u % HA, b = u / HA; const size_t rc = (size_t)NLAT + b * LC;
                    d.Q = QA + rc * 512 + ha * 64; d.Kc = KA + rc * 512 + ha * 64; d.Vc = VA + rc * 512 + ha * 64; d.Kl = d.Kc; d.Vl = d.Vc; d.ldq = 512; d.ldk = 512; d.ldv = 512;
                    d.Z = ZS + rc * 2048 + ha * 64; d.Y = YG + rc * 2048 + ha * 64; }
                bool skip_unit = false;
#ifdef ATTN_ONLY
                { const int cls = big ? (d.nlt ? 1 : 8) : (d.mask == MK_SWA ? 2 : (d.mask == MK_NA ? 4 : 8)); skip_unit = !((ATTN_ONLY) & cls); }
#endif
                const float mshift = 0.f;
#if defined(ATTN_SLOW_PATH) || defined(ATTN_MIX) || defined(ATTN_NO_PAIR)
#ifdef ATTN_SLOW_PATH
                (void)mshift; if (!skip_unit) { if (big) attn_unit<192, 128>(d, lds); else attn_unit<64, 64>(d, lds); }
#elif defined(ATTN_MIX)
                if (big) attn_unit2<192, 128>(d, fminf(mshift, 60.f), lds); else attn_unit<64, 64>(d, lds);
#else
                (void)mshift; if (!skip_unit) { if (big) attn_unit2<192, 128>(d, 0.f, lds); else attn_unit2<64, 64>(d, 0.f, lds); }
#endif
                if (q_lane) MISC[16] = q_next;
                __syncthreads();
                u_next = (int)MISC[16];
                __syncthreads();
#else
                (void)mshift; if (!skip_unit) { if (big) attn_unit2<192, 128>(d, 0.f, lds, q_next, q_lane); else attn_unit64(d, lds, q_next, q_lane); }
                else { if (q_lane) MISC[16] = q_next; __syncthreads(); }
                u_next = (int)MISC[16];
#endif
            }
        }
        if (!(P3_FLOW && G == 256 && MK_N_LAUNCHES == 1)) SEAM(P + 3);
        STAMP(P + 4);
        if (KEN(5) && IN(P + 4)) { PHASE_WS
            const float* modl = modp + (size_t)l * 9 * 6144; (void)modl;
            const float* xl = (l == 0) ? x_in : args.out; (void)xl;
            const float* xcl = (l == 0) ? ctx_in : XC1; (void)xcl;
            float* ssq_cq = (float*)(ws + CTL_SSQ_OFF) + (size_t)l * MTOT; (void)ssq_cq;
            float* ssq_ckv = (float*)(ws + CTL_SSQ_OFF) + (size_t)(2 + l) * MTOT; (void)ssq_ckv;
            pg8::Gemm g{YG, (const bf16_t*)(ws + WS_WOUT) + (size_t)l * 2048 * 2048, MTOT, 2048, 2048};
            EpiOut E{ws, xl, xcl, args.out, l};
#if MK_P1_EARLY
            { pg8::Sched2 S; S.G = G; S.c = bx; S.nN1 = 8; S.nM1 = 64; S.nM2 = 0; S.nN2 = 0; S.pm2 = 0; if (P3_FLOW && G == 256) { S.rt = (unsigned*)ctl + CW_RT; S.rt_need = 26u * (unsigned)(l + 1); }
              pg8::gemm_phase<EpiOut, pg8::Sched2, true, true>(lds, g, S, E); }
            if (l + 1 < DEPTH) {
                xcd_barrier_arrive(bar, MISC + 24);
                if (tid_opaque() == 0) MISC[26] = atomicAdd((unsigned*)(ws + WS_CTL) + CW_CTXTICKET, 1u);
                __syncthreads();
                const int ticket = (int)MISC[26];
                if (ticket < 64) { pg8::Sched2 S; S.G = 64; S.c = ticket; S.nN1 = 0; S.nM1 = 0; S.nM2 = 8; S.nN2 = 8; S.pm2 = 64; S.id2 = true; if (P3_FLOW && G == 256) { S.rt = (unsigned*)ctl + CW_RT; S.rt_need = 26u; }
                    pg8::gemm_phase<EpiOut, pg8::Sched2, true, true>(lds, g, S, E);
                    if (P3_FLOW && tid_opaque() == 0) (void)xb_add((unsigned*)ctl + CW_CTXOUT, 1u); }
                xcd_barrier_wait(bar, MISC + 24);
                { const float* modl1 = modp + (size_t)(l + 1) * 9 * 6144; const float* nw = args.in[4] + (l + 1) * 2048; const int lane = tid_opaque() & 63;
                  const int wv = __builtin_amdgcn_readfirstlane(tid_opaque() >> 6); bool ctx_ready = false;
                  for (;;) { if (tid_opaque() == 0) MISC[18] = atomicAdd((unsigned*)(ws + WS_CTL) + CW_Q_P1, 1u); __syncthreads(); const int ch = (int)MISC[18]; __syncthreads(); if (ch >= (P3_FLOW ? MTOT : NLAT) / 32) break;
                      if (P3_FLOW && ch >= NLAT / 32 && !ctx_ready) {
                          if (tid_opaque() == 0) { unsigned sp_ = 0u; while (xb_ld((unsigned*)ctl + CW_CTXOUT) < 64u) { __builtin_amdgcn_s_sleep(2); if (++sp_ > XB_SPIN_CAP) break; }
                              __builtin_amdgcn_fence(__ATOMIC_ACQUIRE, "agent"); asm volatile("s_waitcnt vmcnt(0)" ::: "memory"); }
                          __syncthreads(); ctx_ready = true; }
                      { const float* modl = modl1; const float* xl = args.out; const float* xcl = XC1; (void)xcl; P1_ROWS(wv, 8, ch * 32, ch * 32 + 32); } } }
            }
#else
            { pg8::Sched2 S; S.G = G; S.c = bx; S.nN1 = 8; S.nM1 = (l == DEPTH - 1) ? 64 : 72; S.nM2 = 0; S.nN2 = 0; S.pm2 = 0;
              pg8::gemm_phase<EpiOut, pg8::Sched2, true, true>(lds, g, S, E); }
#endif
        }
        if (l + 1 < DEPTH) SEAM(P + 4);
        STAMP(P + 5);
    }
#undef IN
#undef SEAM
}


#ifdef VERIFY_PROBE
#ifndef VERIFY_SKIP_A
#define VERIFY_SKIP_A -1
#endif
#ifndef VERIFY_SKIP_B
#define VERIFY_SKIP_B -1
#endif
constexpr size_t WS_VER = WS_END;
constexpr int NVR = 16;
__device__ __constant__ int vrows[NVR] = {0, 1, 63, 64, 255, 256, 1000, 2047, 2048, 5000, 8191, 12345, 16383, 16384, 16500, 18431};
__device__ __forceinline__ void vf_err(float* errs, int id, float got, float exp, float scale) { (void)scale; const float df = got - exp; atomicAdd(errs + 2 * id, df * df); atomicAdd(errs + 2 * id + 1, exp * exp); }
__device__ __forceinline__ float vf_round(float x) { return __uint_as_float(f2bf(x) << 16); }
__device__ __forceinline__ float vf_block_sum(float v, float* red) {
    __syncthreads(); red[threadIdx.x] = v; __syncthreads();
    for (int s = 128; s > 0; s >>= 1) { if ((int)threadIdx.x < s) red[threadIdx.x] += red[threadIdx.x + s]; __syncthreads(); }
    const float r = red[0]; __syncthreads(); return r;
}
__device__ __forceinline__ float vf_block_max(float v, float* red) {
    __syncthreads(); red[threadIdx.x] = v; __syncthreads();
    for (int s = 128; s > 0; s >>= 1) { if ((int)threadIdx.x < s) red[threadIdx.x] = fmaxf(red[threadIdx.x], red[threadIdx.x + s]); __syncthreads(); }
    const float r = red[0]; __syncthreads(); return r;
}
__device__ __forceinline__ int vf_partner(int e) { const int q = e >> 4, i = e & 15; return q == 0 ? 16 + i : (q == 1 ? i : (q == 2 ? 48 + i : 32 + i)); }
__device__ __forceinline__ float vf_rope(float xe, float xp, int e, int pos) {
    const int q = e >> 4, i = e & 15; const float inv = powf(10000.0f, -(float)i / 16.0f); const float ang = (float)(q < 2 ? (pos >> 6) : (pos & 63)) * inv;
    const float rot = (q & 1) ? xp : -xp;
    return xe * cosf(ang) + rot * sinf(ang);
}
__global__ void __launch_bounds__(256) verify_kernel(Args args, int stage, int l) {
    __shared__ float sh[6400]; __shared__ float red[256]; __shared__ float sh2[2048];
    unsigned char* ws = args.ws; float* errs = (float*)(ws + WS_VER) + 64 * l; float* xsave = (float*)(ws + WS_VER) + 256;
    const int t = threadIdx.x, blk = blockIdx.x;
    const float* modl = (const float*)(ws + WS_MOD) + (size_t)l * 9 * 6144;
    if (stage == 0) {
        const int o = blk * 256 + t; if (o >= 9 * 64) return; const int ll = l, r = (o / 64) % 9, n = (o % 64) * 96 + 5;
        float acc = 0.f; for (int k = 0; k < 2048; ++k) { const float c = r < 8 ? args.in[1][r * 2048 + k] : args.in[3][k]; acc += c / (1.f + expf(-c)) * args.in[5][((size_t)ll * 2048 + k) * 6144 + n]; }
        acc += args.in[6][ll * 6144 + n]; vf_err(errs, 0, ((const float*)(ws + WS_MOD))[((size_t)ll * 9 + r) * 6144 + n], acc, 0.02f); return; }
    const int row = vrows[blk % NVR]; const bool lat = row < NLAT; const int b = lat ? row / 2048 : 8; const int pos = row & 2047;
    const float* xl = (l == 0) ? args.in[0] : args.out; const float* xcl = (l == 0) ? args.in[2] : (const float*)(ws + WS_XC1);
    const float* xr = lat ? xl + (size_t)row * 2048 : xcl + (size_t)(row - NLAT) * 2048;
    if (stage == 1) {
        float s = 0.f; for (int k = t; k < 2048; k += 256) s += xr[k] * xr[k]; s = vf_block_sum(s, red); const float rinv = 1.f / sqrtf(s / 2048.f + EPS);
        for (int k = t; k < 2048; k += 256) { const float e = xr[k] * rinv * args.in[4][l * 2048 + k] * (1.f + modl[b * 6144 + 2048 + k]) + modl[b * 6144 + k]; vf_err(errs, 1, bf2f(((const bf16_t*)(ws + WS_XN))[(size_t)row * 2048 + k]), e, 0.05f); }
        return; }
    if (stage == 2) {
        const bf16_t* xn = (const bf16_t*)(ws + WS_XN) + (size_t)row * 2048; for (int k = t; k < 2048; k += 256) sh2[k] = bf2f(xn[k]); __syncthreads();
        const float* W = args.in[7] + (size_t)l * 2048 * N_IN;
        for (int c = t; c < N_IN; c += 256) { float acc = 0.f; for (int k = 0; k < 2048; ++k) acc += sh2[k] * vf_round(W[(size_t)k * N_IN + c]); sh[c] = acc; } __syncthreads();
        const bool qok = lat || l == 0;
        for (int which = 0; which < 4; ++which) {
            const int base = which == 0 ? 0 : which == 1 ? 512 : which == 2 ? 1536 : 2304, nh = which == 0 ? 8 : which == 1 ? 8 : which == 2 ? 12 : 4;
            const float* nw = args.in[which == 0 ? 8 : which == 1 ? 9 : which == 2 ? 11 : 12] + l * 64; const float osc = (which == 0 || which == 2) ? C2_64 : 1.f; const bool rp = which >= 2 && lat;
            const bf16_t* dst = (const bf16_t*)(ws + (which == 0 ? WS_QA : which == 1 ? WS_KA : which == 2 ? WS_QB : WS_KB)); const int ld = nh * 64;
            if ((which == 0 || which == 2) && !qok) continue;
            for (int o = t; o < nh * 64; o += 256) { const int h = o >> 6, e = o & 63; const float* u = sh + base + h * 64; float ss = 0.f; for (int j = 0; j < 64; ++j) ss += u[j] * u[j]; const float rinv = 1.f / sqrtf(ss / 64.f + EPS);
                const int pe = vf_partner(e); const float xe = u[e] * rinv * nw[e], xp = u[pe] * rinv * nw[pe]; const float v = (rp ? vf_rope(xe, xp, e, pos) : xe) * osc;
                vf_err(errs, 2 + which, bf2f(dst[(size_t)row * ld + o]), v, 0.05f * osc); } }
        for (int o = t; o < 512; o += 256) vf_err(errs, 6, bf2f(((const bf16_t*)(ws + WS_VA))[(size_t)row * 512 + o]), sh[1024 + o], 0.05f);
        for (int o = t; o < 256; o += 256) vf_err(errs, 7, bf2f(((const bf16_t*)(ws + WS_VB))[(size_t)row * 256 + o]), sh[2560 + o], 0.05f);
        if (qok) for (int o = t; o < 768; o += 256) vf_err(errs, 8, bf2f(((const bf16_t*)(ws + WS_CQ))[(size_t)row * 768 + o]), sh[2816 + o], 0.05f);
        for (int o = t; o < 512; o += 256) vf_err(errs, 9, bf2f(((const bf16_t*)(ws + WS_CKV))[(size_t)row * 512 + o]), sh[3584 + o], 0.05f);
        for (int o = t; o < 64; o += 256) vf_err(errs, 10, ((const float*)(ws + WS_KPE))[(size_t)row * 64 + o], sh[4096 + o], 0.05f);
        if (qok) for (int o = t; o < 2048; o += 256) { const float z = sh[4160 + o]; vf_err(errs, 11, bf2f(((const bf16_t*)(ws + WS_ZS))[(size_t)row * 2048 + o]), z / (1.f + expf(-z)), 0.05f); }
        return; }
    if (stage == 3) {
        const bool qok = lat || l == 0;
        const bf16_t* cq = (const bf16_t*)(ws + WS_CQ) + (size_t)row * 768; const bf16_t* ckv = (const bf16_t*)(ws + WS_CKV) + (size_t)row * 512; const float* kpe = (const float*)(ws + WS_KPE) + (size_t)row * 64;
        float s1 = 0.f; for (int k = t; k < 768; k += 256) { const float v = bf2f(cq[k]); s1 += v * v; } s1 = vf_block_sum(s1, red); const float r1 = 1.f / sqrtf(s1 / 768.f + EPS);
        float s2 = 0.f; for (int k = t; k < 512; k += 256) { const float v = bf2f(ckv[k]); s2 += v * v; } s2 = vf_block_sum(s2, red); const float r2 = 1.f / sqrtf(s2 / 512.f + EPS);
        if (qok) {
            for (int k = t; k < 768; k += 256) sh2[k] = bf2f(cq[k]) * r1 * args.in[14][l * 768 + k]; __syncthreads();
            const float* W = args.in[16] + (size_t)l * 768 * 1152;
            for (int c = t; c < 1152; c += 256) { float acc = 0.f; for (int k = 0; k < 768; ++k) acc += sh2[k] * W[(size_t)k * 1152 + c]; sh[c] = acc; } __syncthreads();
            for (int o = t; o < 1152; o += 256) { const int h = o / 192, f = o % 192; const float* u = sh + h * 192; float ss = 0.f; for (int j = 0; j < 192; ++j) ss += u[j] * u[j]; const float rinv = 1.f / sqrtf(ss / 192.f + EPS);
                float v; if (f < 128 || !lat) v = u[f] * rinv * args.in[18][l * 192 + f]; else { const int e = f - 128, pe = vf_partner(e); v = vf_rope(u[128 + e] * rinv * args.in[18][l * 192 + 128 + e], u[128 + pe] * rinv * args.in[18][l * 192 + 128 + pe], e, pos); }
                vf_err(errs, 12, bf2f(((const bf16_t*)(ws + WS_QC))[(size_t)row * 1152 + o]), v * C2_192, 0.05f * C2_192); }
            __syncthreads(); }
        for (int k = t; k < 512; k += 256) sh2[k] = bf2f(ckv[k]) * r2 * args.in[15][l * 512 + k]; __syncthreads();
        const float* W = args.in[17] + (size_t)l * 512 * 1536;
        for (int c = t; c < 1536; c += 256) { float acc = 0.f; for (int k = 0; k < 512; ++k) acc += sh2[k] * W[(size_t)k * 1536 + c]; sh[c] = acc; } __syncthreads();
        for (int o = t; o < 6 * 192; o += 256) { const int h = o / 192, f = o % 192; const float* u = sh + h * 256; float ss = 0.f; for (int j = 0; j < 128; ++j) ss += u[j] * u[j]; for (int j = 0; j < 64; ++j) ss += kpe[j] * kpe[j]; const float rinv = 1.f / sqrtf(ss / 192.f + EPS);
            float v; if (f < 128) v = u[f] * rinv * args.in[19][l * 192 + f]; else { const int e = f - 128, pe = vf_partner(e); const float xe = kpe[e] * rinv * args.in[19][l * 192 + 128 + e], xp = kpe[pe] * rinv * args.in[19][l * 192 + 128 + pe]; v = lat ? vf_rope(xe, xp, e, pos) : xe; }
            vf_err(errs, 13, bf2f(((const bf16_t*)(ws + WS_KC))[(size_t)row * 1152 + o]), v, 0.05f); }
        for (int o = t; o < 768; o += 256) { const int h = o / 128, f = o % 128; vf_err(errs, 14, bf2f(((const bf16_t*)(ws + WS_VC))[(size_t)row * 768 + o]), sh[h * 256 + 128 + f], 0.05f); }
        return; }
    if (stage == 4) {
        const int grp = (blk / NVR) % 3, hs = blk / (3 * NVR);
        if (!lat && l == DEPTH - 1) return;
        const int nh = grp == 0 ? HA : grp == 1 ? HB : HC, h = hs == 0 ? 0 : (hs == 1 ? nh / 2 : nh - 1);
        const int dq = grp == 2 ? 192 : 64, dv = grp == 2 ? 128 : 64;
        const bf16_t* Q = (const bf16_t*)(ws + (grp == 0 ? WS_QA : grp == 1 ? WS_QB : WS_QC)); const int ldq = nh * dq;
        const bf16_t* K = (const bf16_t*)(ws + (grp == 0 ? WS_KA : grp == 1 ? WS_KB : WS_KC)); const bf16_t* V = (const bf16_t*)(ws + (grp == 0 ? WS_VA : grp == 1 ? WS_VB : WS_VC));
        const int kvh = grp == 1 ? h / 3 : h, ldk = grp == 0 ? 512 : grp == 1 ? 256 : 1152, ldv = grp == 0 ? 512 : grp == 1 ? 256 : 768;
        for (int j = t; j < dq; j += 256) sh2[j] = bf2f(Q[(size_t)row * ldq + h * dq + j]); __syncthreads();
        const int bb = lat ? b : (row - NLAT) / LC;
        const int r = pos >> 6, c = pos & 63; int rs = r - 4; rs = rs < 0 ? 0 : (rs > 24 ? 24 : rs); int qs = c - 8; qs = qs < 0 ? 0 : (qs > 48 ? 48 : qs);
        const int NK = 2048 + 256; float mx = -3e38f;
        for (int j = t; j < NK; j += 256) { float s = -INFINITY; bool ok; size_t krow;
            if (j < 2048) { krow = (size_t)bb * 2048 + j; const int kr = j >> 6, kc = j & 63;
                ok = lat && (grp == 2 || (grp == 1 && abs(pos - j) <= 128) || (grp == 0 && kr >= rs && kr < rs + 8 && kc >= qs && kc < qs + 16)); }
            else { krow = (size_t)NLAT + bb * LC + (j - 2048); ok = true; }
            if (ok) { float a = 0.f; for (int dd = 0; dd < dq; ++dd) a += sh2[dd] * bf2f(K[krow * ldk + kvh * dq + dd]); s = a;
                if (grp == 0 && j < 2048) s += args.in[10][(((size_t)l * HA + h) * 15 + ((j >> 6) - r + 7)) * 31 + ((j & 63) - c + 15)] * LOG2E; }
            sh[j] = s; mx = fmaxf(mx, s); }
        const float snk = grp == 1 ? args.in[13][l * HB + h] * LOG2E : -INFINITY; mx = fmaxf(vf_block_max(mx, red), snk);
        float ls = 0.f; for (int j = t; j < NK; j += 256) { const float p = exp2f(sh[j] - mx); sh[j] = p; ls += p; } ls = vf_block_sum(ls, red) + exp2f(snk - mx);
        for (int dd = t; dd < dv; dd += 256) { float o = 0.f; for (int j = 0; j < NK; ++j) { if (sh[j] != 0.f) { const size_t krow = j < 2048 ? (size_t)bb * 2048 + j : (size_t)NLAT + bb * LC + (j - 2048); o += sh[j] * bf2f(V[krow * ldv + kvh * dv + dd]); } }
            const int col = (grp == 0 ? 0 : grp == 1 ? 512 : 1280) + h * dv + dd; const float y = o / ls * bf2f(((const bf16_t*)(ws + WS_ZS))[(size_t)row * 2048 + col]);
            vf_err(errs, 15 + grp + (lat ? 0 : 3), bf2f(((const bf16_t*)(ws + WS_XN))[(size_t)row * 2048 + col]), y, 0.02f); }
        return; }
    if (stage == 5) {
        if (lat || l == 0) for (int k = t; k < 2048; k += 256) { xsave[(blk % NVR) * 2048 + k] = xr[k]; xsave[(NVR + blk % NVR) * 2048 + k] = bf2f(((const bf16_t*)(ws + WS_XN))[(size_t)row * 2048 + k]); }
        return; }
    if (stage == 6) {
        if (!lat && l == DEPTH - 1) return;
        for (int k = t; k < 2048; k += 256) sh2[k] = xsave[(NVR + blk % NVR) * 2048 + k]; __syncthreads();
        const float* W = args.in[20] + (size_t)l * 2048 * 2048; const float* got = lat ? args.out + (size_t)row * 2048 : (const float*)(ws + WS_XC1) + (size_t)(row - NLAT) * 2048;
        for (int c = t; c < 2048; c += 256) { float acc = 0.f; for (int k = 0; k < 2048; ++k) acc += sh2[k] * vf_round(W[(size_t)k * 2048 + c]); const float dl = modl[b * 6144 + 4096 + c] * acc;
            vf_err(errs, 21, got[c] - xsave[(blk % NVR) * 2048 + c], dl, 0.f); }
        return; }
}
__global__ void __launch_bounds__(256) verify_inject(Args args) {
    float* errs = (float*)(args.ws + WS_VER); float emax = 0.f; int imax = 0;
    for (int i = 0; i < 64; ++i) { const float e = sqrtf(errs[2 * i] / (errs[2 * i + 1] + 1e-30f)); if (i == VERIFY_SKIP_A || i == VERIFY_SKIP_B) continue; if (!(e <= emax)) { emax = e; imax = i; } }
    if (!(emax < 1e3f)) emax = 1e3f;
#ifdef VERIFY_ID_A
    { float ea = sqrtf(errs[2 * VERIFY_ID_A] / (errs[2 * VERIFY_ID_A + 1] + 1e-30f)), eb = sqrtf(errs[2 * VERIFY_ID_B] / (errs[2 * VERIFY_ID_B + 1] + 1e-30f)); if (!(ea < 1e3f)) ea = 1e3f; if (!(eb < 90.f)) eb = 90.f; emax = ea; imax = (int)(eb * 100.f) / 100;
      const size_t n = (size_t)NLAT * DM; const float add = sqrtf(emax);
      for (size_t i = (size_t)blockIdx.x * 256 + threadIdx.x; i < n; i += (size_t)gridDim.x * 256) { float v = args.in[0][i] + add; if (i == 12345) v += 100.f * (1.f + eb); args.out[i] = v; } return; }
#endif
    const size_t n = (size_t)NLAT * DM; const float add = sqrtf(emax);
    for (size_t i = (size_t)blockIdx.x * 256 + threadIdx.x; i < n; i += (size_t)gridDim.x * 256) { float v = args.in[0][i] + add; if (i == 12345) v += 1.0f * (float)(imax + 1); args.out[i] = v; }
}
#endif


#ifdef STAMP_PROBE
#ifndef STAMP_ASCALE
#define STAMP_ASCALE 0.01f
#endif
#ifndef STAMP_BSCALE
#define STAMP_BSCALE 3e-5f
#endif
__global__ void __launch_bounds__(256) stamp_inject(Args args) {
    const unsigned long long* ts = (const unsigned long long*)(args.ws + WS_END);
    const float Ta = (float)(ts[STAMP_A1] - ts[STAMP_A0]) * 0.01f, Tb = (float)(ts[STAMP_B1] - ts[STAMP_B0]) * 0.01f;
    const size_t n = (size_t)NLAT * DM; const float add = Tb * STAMP_BSCALE;
    for (size_t i = (size_t)blockIdx.x * 256 + threadIdx.x; i < n; i += (size_t)gridDim.x * 256) { float v = args.out[i] + add; if (i == 12345) v += Ta * STAMP_ASCALE; args.out[i] = v; }
}
#endif

extern "C" void kernel_launch(void* const* d_in, const int* in_sizes, int n_in, void* d_out, int out_size, void* d_ws, size_t ws_size, hipStream_t stream) {
    static int grid = 0;
    if (grid == 0) {
        if (n_in != 21 || in_sizes[0] != NLAT * DM || out_size != NLAT * DM || ws_size < WS_END) {
            fprintf(stderr, "kernel_launch: shape/workspace mismatch: n_in %d in0 %d out %d ws %zu (need %zu)\n", n_in, n_in > 0 ? in_sizes[0] : -1, out_size, ws_size, (size_t)WS_END); grid = -1; return; }
        int dev = 0, cus = 0, per_cu = 0;
        if (hipGetDevice(&dev) != hipSuccess || hipDeviceGetAttribute(&cus, hipDeviceAttributeMultiprocessorCount, dev) != hipSuccess) { grid = -1; return; }
        if (hipFuncSetAttribute((const void*)hymba_fwd, hipFuncAttributeMaxDynamicSharedMemorySize, LDS_BYTES) != hipSuccess) { fprintf(stderr, "kernel_launch: hipFuncSetAttribute failed\n"); grid = -1; return; }
        if (hipOccupancyMaxActiveBlocksPerMultiprocessor(&per_cu, (const void*)hymba_fwd, 512, LDS_BYTES) != hipSuccess || per_cu < 1) { fprintf(stderr, "kernel_launch: occupancy query says %d blocks per CU\n", per_cu); }
        (void)hipGetLastError();
        grid = cus;
    }
    if (grid < 0) return;
    (void)hipMemsetAsync((char*)d_ws + WS_CTL, 0, CTL_ZERO_BYTES, stream);
    Args a{};
    for (int i = 0; i < 21; ++i) a.in[i] = (const float*)d_in[i];
    a.out = (float*)d_out; a.ws = (unsigned char*)d_ws;
#ifdef VERIFY_PROBE
    (void)hipMemsetAsync((char*)d_ws + WS_VER, 0, 512, stream);
    for (int p = 0; p < 11; ++p) { a.ph_lo = p; a.ph_hi = p + 1; const int l = p == 0 ? 0 : (p - 1) / 5, k = p == 0 ? 0 : (p - 1) % 5 + 1;
        if (k == 5) hipLaunchKernelGGL(verify_kernel, dim3(NVR), dim3(256), 0, stream, a, 5, l);
        hipLaunchKernelGGL(hymba_fwd, dim3(grid), dim3(512), LDS_BYTES, stream, a);
        if (k == 0) hipLaunchKernelGGL(verify_kernel, dim3(3), dim3(256), 0, stream, a, 0, 0);
        if (p == 2) hipLaunchKernelGGL(verify_kernel, dim3(3), dim3(256), 0, stream, a, 0, 1);
        else if (k == 4) hipLaunchKernelGGL(verify_kernel, dim3(NVR * 9), dim3(256), 0, stream, a, 4, l);
        else if (k == 5) hipLaunchKernelGGL(verify_kernel, dim3(NVR), dim3(256), 0, stream, a, 6, l);
        else hipLaunchKernelGGL(verify_kernel, dim3(NVR), dim3(256), 0, stream, a, k, l); }
    hipLaunchKernelGGL(verify_inject, dim3(2048), dim3(256), 0, stream, a);
#else
    if (MK_N_LAUNCHES == 1) { a.ph_lo = 0; a.ph_hi = 11; hipLaunchKernelGGL(hymba_fwd, dim3(grid), dim3(512), LDS_BYTES, stream, a); }
    else { for (int p = 0; p < 11; ++p) { a.ph_lo = p; a.ph_hi = p + 1; hipLaunchKernelGGL(hymba_fwd, dim3(grid), dim3(512), LDS_BYTES, stream, a); } }
#endif
#ifdef STAMP_PROBE
    hipLaunchKernelGGL(stamp_inject, dim3(2048), dim3(256), 0, stream, a);
#endif
    const hipError_t le = hipPeekAtLastError();
    if (le != hipSuccess) fprintf(stderr, "kernel_launch: launch failed: %s\n", hipGetErrorName(le));
}
```
